# Optimizing an MI355X kernel written in HIP

```python
import jax, jax.numpy as jnp
from jax import lax
import numpy as np

D_MODEL = 1024
BATCH = 8
SEQ = 8192
DEPTH = 2

GRID_W = 64
ROPE_THETA = 10000.0
Q_BLOCK = 128
EPS = 1e-6
N_MIXERS = 2

N_MEM = 256
MEM_HEADS = 4
MEM_HEAD_DIM = 128
MEM_W = MEM_HEADS * MEM_HEAD_DIM

MLA_HEADS = 8
MLA_Q_RANK = 384
MLA_KV_RANK = 256
MLA_NOPE = 128
MLA_ROPE = 64
MLA_V = 128
MLA_IN_W = MLA_Q_RANK + MLA_KV_RANK + MLA_ROPE

GQA_HEADS = 8
GQA_KV_HEADS = 2
GQA_HEAD_DIM = 128
GQA_Q_W = GQA_HEADS * GQA_HEAD_DIM
GQA_KV_W = GQA_KV_HEADS * GQA_HEAD_DIM
GQA_IN_W = GQA_Q_W + 2 * GQA_KV_W

MIX_W = MLA_HEADS * MLA_V + MEM_W

D_FF = -(-8 * D_MODEL // (3 * 256)) * 256

kernel_name = "hybrid_mla_gqa_memory_encoder"


def _rmsnorm(x, g):
    x32 = x.astype(jnp.float32)
    y = x32 * lax.rsqrt(jnp.mean(x32 * x32, axis=-1, keepdims=True) + EPS)
    return (y * g.astype(jnp.float32)).astype(x.dtype)


def _axial_rope_tables(seq, dim, dtype):
    rows = seq // GRID_W
    row = jnp.repeat(jnp.arange(rows, dtype=jnp.float32), GRID_W)
    col = jnp.tile(jnp.arange(GRID_W, dtype=jnp.float32), rows)
    axis_dim = dim // 2
    inv = ROPE_THETA ** (-jnp.arange(0, axis_dim, 2, dtype=jnp.float32) / axis_dim)
    ang_r = row[:, None] * inv
    ang_c = col[:, None] * inv
    tabs = (jnp.cos(ang_r), jnp.sin(ang_r), jnp.cos(ang_c), jnp.sin(ang_c))
    return tuple(t[:, None, :].astype(dtype) for t in tabs)


def _rope_1d(x, cos, sin):
    x1, x2 = jnp.split(x, 2, axis=-1)
    return jnp.concatenate([x1 * cos - x2 * sin, x2 * cos + x1 * sin], axis=-1)


def _apply_axial_rope(x, tabs):
    cos_r, sin_r, cos_c, sin_c = tabs
    xr, xc = jnp.split(x, 2, axis=-1)
    return jnp.concatenate([_rope_1d(xr, cos_r, sin_r), _rope_1d(xc, cos_c, sin_c)], axis=-1)


def _blocked_attention(q_parts, k_parts, v, scale):
    B, S, Hk, Dv = v.shape
    H = q_parts[0].shape[2]
    G = H // Hk
    nb = S // Q_BLOCK
    qb = tuple(q.reshape(B, nb, Q_BLOCK, Hk, G, q.shape[-1]).transpose(1, 0, 2, 3, 4, 5)
               for q in q_parts)

    def one_block(qs):
        s = None
        for qp, kp in zip(qs, k_parts):
            eq = 'bqkgd,bskd->bkgqs' if kp.ndim == 4 else 'bqkgd,bsd->bkgqs'
            t = jnp.einsum(eq, qp, kp, preferred_element_type=jnp.float32)
            s = t if s is None else s + t
        p = jax.nn.softmax(s * scale, axis=-1).astype(v.dtype)
        return jnp.einsum('bkgqs,bskd->bqkgd', p, v)

    out = lax.map(one_block, qb)
    return out.transpose(1, 0, 2, 3, 4, 5).reshape(B, S, H, Dv)


def _mla_mixer(p, q_a_norm, w_q_b, kv_a_norm, w_kv_b, q_norm, k_norm, rope):
    B, S, _ = p.shape
    c_q = p[..., :MLA_Q_RANK]
    c_kv = p[..., MLA_Q_RANK:MLA_Q_RANK + MLA_KV_RANK]
    k_pe = p[..., MLA_Q_RANK + MLA_KV_RANK:]
    q = (_rmsnorm(c_q, q_a_norm) @ w_q_b).reshape(B, S, MLA_HEADS, MLA_NOPE + MLA_ROPE)
    kv = (_rmsnorm(c_kv, kv_a_norm) @ w_kv_b).reshape(B, S, MLA_HEADS, MLA_NOPE + MLA_V)
    q_nope = _rmsnorm(q[..., :MLA_NOPE], q_norm[:MLA_NOPE])
    q_pe = _apply_axial_rope(_rmsnorm(q[..., MLA_NOPE:], q_norm[MLA_NOPE:]), rope)
    k_nope = _rmsnorm(kv[..., :MLA_NOPE], k_norm[:MLA_NOPE])
    v = kv[..., MLA_NOPE:]
    k_pe = _apply_axial_rope(_rmsnorm(k_pe, k_norm[MLA_NOPE:])[:, :, None, :], rope)[:, :, 0, :]
    out = _blocked_attention([q_nope, q_pe], [k_nope, k_pe], v,
                             (MLA_NOPE + MLA_ROPE) ** -0.5)
    return out.reshape(B, S, MLA_HEADS * MLA_V)


def _gqa_mixer(p, q_norm, k_norm, rope):
    B, S, _ = p.shape
    q = p[..., :GQA_Q_W].reshape(B, S, GQA_HEADS, GQA_HEAD_DIM)
    k = p[..., GQA_Q_W:GQA_Q_W + GQA_KV_W].reshape(B, S, GQA_KV_HEADS, GQA_HEAD_DIM)
    v = p[..., GQA_Q_W + GQA_KV_W:].reshape(B, S, GQA_KV_HEADS, GQA_HEAD_DIM)
    q = _apply_axial_rope(_rmsnorm(q, q_norm), rope)
    k = _apply_axial_rope(_rmsnorm(k, k_norm), rope)
    out = _blocked_attention([q], [k], v, GQA_HEAD_DIM ** -0.5)
    return out.reshape(B, S, GQA_Q_W)


def _memory_attention(q, mem_n, w_kv, q_norm, k_norm):
    B, S, _ = q.shape
    M = mem_n.shape[1]
    q = _rmsnorm(q.reshape(B, S, MEM_HEADS, MEM_HEAD_DIM), q_norm)
    kv = (mem_n @ w_kv).reshape(B, M, 2, MEM_HEADS, MEM_HEAD_DIM)
    k = _rmsnorm(kv[:, :, 0], k_norm)
    v = kv[:, :, 1]
    s = jnp.einsum('bqhd,bmhd->bhqm', q, k, preferred_element_type=jnp.float32)
    p = jax.nn.softmax(s * (MEM_HEAD_DIM ** -0.5), axis=-1).astype(v.dtype)
    return jnp.einsum('bhqm,bmhd->bqhd', p, v).reshape(B, S, MEM_W)


def _swiglu(h, w_gate_up, w_down):
    gu = h @ w_gate_up
    g, u = gu[..., :D_FF], gu[..., D_FF:]
    return (jax.nn.silu(g) * u) @ w_down


def setup_inputs(seed: int = 0) -> dict:
    key = jax.random.key(seed)
    ks = iter(jax.random.split(key, 32))
    n_mla = (DEPTH + 1) // 2
    n_gqa = DEPTH // 2

    def w(shape, fan_in):
        return jax.random.normal(next(ks), shape, jnp.float32) * (fan_in ** -0.5)

    def gain(shape):
        return 1.0 + 0.05 * jax.random.normal(next(ks), shape, jnp.float32)

    return {
        "x": jax.random.normal(next(ks), (BATCH, SEQ, D_MODEL), jnp.float32),
        "mem": jax.random.normal(next(ks), (BATCH, N_MEM, D_MODEL), jnp.float32),
        "mem_norm": gain((D_MODEL,)),
        "norm_mix": gain((DEPTH, D_MODEL)),
        "norm_ffn": gain((DEPTH, D_MODEL)),
        "w_out": w((DEPTH, MIX_W, D_MODEL), MIX_W),
        "w_mem_kv": w((DEPTH, D_MODEL, 2 * MEM_W), D_MODEL),
        "memq_norm": gain((DEPTH, MEM_HEAD_DIM)),
        "memk_norm": gain((DEPTH, MEM_HEAD_DIM)),
        "w_gate_up": w((DEPTH, D_MODEL, 2 * D_FF), D_MODEL),
        "w_down": w((DEPTH, D_FF, D_MODEL), D_FF),
        "mla_w_in": w((n_mla, D_MODEL, MLA_IN_W + MEM_W), D_MODEL),
        "mla_q_a_norm": gain((n_mla, MLA_Q_RANK)),
        "mla_w_q_b": w((n_mla, MLA_Q_RANK, MLA_HEADS * (MLA_NOPE + MLA_ROPE)), MLA_Q_RANK),
        "mla_kv_a_norm": gain((n_mla, MLA_KV_RANK)),
        "mla_w_kv_b": w((n_mla, MLA_KV_RANK, MLA_HEADS * (MLA_NOPE + MLA_V)), MLA_KV_RANK),
        "mla_q_norm": gain((n_mla, MLA_NOPE + MLA_ROPE)),
        "mla_k_norm": gain((n_mla, MLA_NOPE + MLA_ROPE)),
        "gqa_w_in": w((n_gqa, D_MODEL, GQA_IN_W + MEM_W), D_MODEL),
        "gqa_q_norm": gain((n_gqa, GQA_HEAD_DIM)),
        "gqa_k_norm": gain((n_gqa, GQA_HEAD_DIM)),
    }


def reference(x, mem, mem_norm, norm_mix, norm_ffn, w_out, w_mem_kv, memq_norm, memk_norm,
              w_gate_up, w_down, mla_w_in, mla_q_a_norm, mla_w_q_b, mla_kv_a_norm, mla_w_kv_b,
              mla_q_norm, mla_k_norm, gqa_w_in, gqa_q_norm, gqa_k_norm):
    S = x.shape[1]
    rope_mla = _axial_rope_tables(S, MLA_ROPE, x.dtype)
    rope_gqa = _axial_rope_tables(S, GQA_HEAD_DIM, x.dtype)
    mem_n = _rmsnorm(mem, mem_norm)
    for i in range(DEPTH):
        j = i // N_MIXERS
        h = _rmsnorm(x, norm_mix[i])
        if i % N_MIXERS == 0:
            proj = h @ mla_w_in[j]
            mix = _mla_mixer(proj[..., :MLA_IN_W], mla_q_a_norm[j], mla_w_q_b[j],
                             mla_kv_a_norm[j], mla_w_kv_b[j], mla_q_norm[j], mla_k_norm[j],
                             rope_mla)
            q_mem = proj[..., MLA_IN_W:]
        else:
            proj = h @ gqa_w_in[j]
            mix = _gqa_mixer(proj[..., :GQA_IN_W], gqa_q_norm[j], gqa_k_norm[j], rope_gqa)
            q_mem = proj[..., GQA_IN_W:]
        mem_out = _memory_attention(q_mem, mem_n, w_mem_kv[i], memq_norm[i], memk_norm[i])
        x = x + jnp.concatenate([mix, mem_out], axis=-1) @ w_out[i]
        x = x + _swiglu(_rmsnorm(x, norm_ffn[i]), w_gate_up[i], w_down[i])
    return x
```

```cpp
#include <hip/hip_runtime.h>
#include <hip/hip_cooperative_groups.h>
#include <cstdio>
#include <cstdint>
namespace cg = cooperative_groups;

#ifndef MK_ONE_LAUNCH
#define MK_ONE_LAUNCH 1
#endif

typedef unsigned short bf16_t;
typedef short bf16x8 __attribute__((ext_vector_type(8)));
typedef short s16x4 __attribute__((ext_vector_type(4)));
typedef float f32x4 __attribute__((ext_vector_type(4)));
typedef float f32x16 __attribute__((ext_vector_type(16)));
typedef unsigned u32x4 __attribute__((ext_vector_type(4)));
typedef unsigned u32x2 __attribute__((ext_vector_type(2)));
#define LAS __attribute__((address_space(3)))

constexpr int NTOK = 65536, SEQ = 8192, DM = 1024, DFF = 2816, NMEMROWS = 2048;
constexpr float EPS = 1e-6f;
constexpr float LOG2_THETA = 13.287712379549449f;
constexpr float INV2PI = 0.15915494309189535f;
constexpr size_t MiB = 1ull << 20;
constexpr size_t WS_WT_IN0 = 0;
constexpr size_t WS_WT_QB = WS_WT_IN0 + 1280ull * 1024 * 2;
constexpr size_t WS_WT_KVB = WS_WT_QB + 1536ull * 384 * 2;
constexpr size_t WS_WT_OUT = WS_WT_KVB + 2048ull * 256 * 2;
constexpr size_t WS_WT_MEMKV = WS_WT_OUT + 2ull * 1024 * 1536 * 2;
constexpr size_t WS_WT_GU = WS_WT_MEMKV + 2ull * 1024 * 1024 * 2;
constexpr size_t WS_WT_DN = WS_WT_GU + 2ull * 5632 * 1024 * 2;
constexpr size_t WS_WT_IN1 = WS_WT_DN + 2ull * 1024 * 2816 * 2;
constexpr size_t WS_WT_END = WS_WT_IN1 + 2048ull * 1024 * 2;
static_assert(WS_WT_END <= 56 * MiB, "weights region");
constexpr size_t WS_MEMN = 56 * MiB;
constexpr size_t WS_MEMKV = 60 * MiB;
constexpr size_t WS_HM = 72 * MiB;
constexpr size_t WS_R = 264 * MiB;
constexpr size_t WS_Q = WS_R + 160 * MiB;
constexpr size_t WS_KV = WS_Q + 192 * MiB;
constexpr size_t WS_END = WS_KV + 256 * MiB;

struct Params { const float* in[21]; float* out; unsigned char* ws; int ph_lo, ph_hi; };

__device__ __forceinline__ float bf2f(bf16_t v) { return __uint_as_float(((unsigned)v) << 16); }
__device__ __forceinline__ bf16_t f2bf(float f) { unsigned u = __float_as_uint(f); u += 0x7FFFu + ((u >> 16) & 1u); return (bf16_t)(u >> 16); }
__device__ __forceinline__ unsigned cvtpk(float lo, float hi) { unsigned r; asm volatile("v_cvt_pk_bf16_f32 %0, %1, %2" : "=v"(r) : "v"(lo), "v"(hi)); return r; }
__device__ __forceinline__ float wave_sum(float v) {
#pragma unroll
  for (int o = 32; o > 0; o >>= 1) v += __shfl_xor(v, o, 64);
  return v;
}

__device__ __forceinline__ int opaque_tid() { int t = threadIdx.x; asm volatile("" : "+v"(t)); return t; }

namespace pg8 {
constexpr int BM = 256, BK = 64, HALF = 128, HTB = HALF * BK * 2, STAGE_BYTES = 8 * HTB, NXCD = 8, WGM = 8;
__device__ __forceinline__ int lds_byte(int r, int c) { const int st = (r >> 4) * 2 + (c >> 5), rr = r & 15, cc = c & 31, ob = rr * 64 + cc * 2; return st * 1024 + (ob ^ (((ob >> 9) & 1) << 5)); }
__device__ __forceinline__ void stage_rc(int b, int& R, int& C) { const int st = b / 1024, sb = b % 1024, swz = sb ^ (((sb >> 9) & 1) << 5); R = (st >> 1) * 16 + swz / 64; C = (st & 1) * 32 + (swz % 64) / 2; }
__device__ __forceinline__ int perm32(int rho) { const int n = rho >> 4, i = rho & 15; return 8 * (i >> 2) + 4 * n + (i & 3); }
struct Unit { int pm, pn; };
struct Gemm { const bf16_t* A; const bf16_t* Bt; int M, N, K, lda; };
struct StaticOrder {
  int nM, nN, nwg, G, c;
  __device__ void init(int M, int N, int G_, int c_) { nM = M / BM; nN = N / BM; nwg = nM * nN; G = G_; c = c_; }
  __device__ bool next(int i, Unit& u) const {
    const long L = (long)i * G + c; if (L >= nwg) return false;
    int wgid = (int)L; { const int q = nwg / NXCD, r = nwg % NXCD, xcd = wgid % NXCD, off = wgid / NXCD; wgid = (xcd < r ? xcd * (q + 1) : r * (q + 1) + (xcd - r) * q) + off; }
    const int nig = WGM * nN, gid = wgid / nig, fm = gid * WGM, gsz = (nM - fm) < WGM ? (nM - fm) : WGM;
    u.pm = fm + ((wgid % nig) % gsz); u.pn = (wgid % nig) / gsz; return true;
  }
};

struct EpiBf16 {
  static constexpr bool PERM = true;
  bf16_t* O; int ldc;
  __device__ __forceinline__ void operator()(const f32x4 (&acc)[2][2][4][2], const Unit& u, int wr, int wc, int fr, int fq) const {
    const int row0 = u.pm * BM + wr * 64 + fr, col0 = u.pn * BM + wc * 32 + 8 * fq;
#pragma unroll
    for (int ai = 0; ai < 2; ++ai)
#pragma unroll
      for (int m = 0; m < 4; ++m) { bf16_t* rowp = O + (size_t)(row0 + ai * HALF + m * 16) * ldc + col0;
#pragma unroll
        for (int bj = 0; bj < 2; ++bj) { const f32x4 v0 = acc[ai][bj][m][0], v1 = acc[ai][bj][m][1];
          u32x4 w; w.x = cvtpk(v0[0], v0[1]); w.y = cvtpk(v0[2], v0[3]); w.z = cvtpk(v1[0], v1[1]); w.w = cvtpk(v1[2], v1[3]);
          *(u32x4*)(rowp + bj * HALF) = w; } }
  }
};
struct EpiResF32 {
  static constexpr bool PERM = false;
  float* out; const float* res;
  __device__ __forceinline__ void operator()(const f32x4 (&acc)[2][2][4][2], const Unit& u, int wr, int wc, int fr, int fq) const {
    const int row0 = u.pm * BM + wr * 64 + fr, col0 = u.pn * BM + wc * 32 + 4 * fq;
#pragma unroll
    for (int ai = 0; ai < 2; ++ai)
#pragma unroll
      for (int m = 0; m < 4; ++m) { const size_t off = (size_t)(row0 + ai * HALF + m * 16) * DM + col0;
#pragma unroll
        for (int bj = 0; bj < 2; ++bj)
#pragma unroll
          for (int n = 0; n < 2; ++n) { const f32x4 r = *(const f32x4*)(res + off + bj * HALF + n * 16); *(f32x4*)(out + off + bj * HALF + n * 16) = r + acc[ai][bj][m][n]; } }
  }
};
struct EpiSwiGLU {
  static constexpr bool PERM = true;
  bf16_t* O;
  __device__ __forceinline__ void operator()(const f32x4 (&acc)[2][2][4][2], const Unit& u, int wr, int wc, int fr, int fq) const {
    const int row0 = u.pm * BM + wr * 64 + fr, col0 = u.pn * HALF + wc * 32 + 8 * fq;
#pragma unroll
    for (int ai = 0; ai < 2; ++ai)
#pragma unroll
      for (int m = 0; m < 4; ++m) { bf16_t* rowp = O + (size_t)(row0 + ai * HALF + m * 16) * DFF + col0;
        float y[8];
#pragma unroll
        for (int n = 0; n < 2; ++n)
#pragma unroll
          for (int j = 0; j < 4; ++j) { const float g = acc[ai][0][m][n][j], up = acc[ai][1][m][n][j];
            const float e = __builtin_amdgcn_exp2f(-g * 1.4426950408889634f);
            y[n * 4 + j] = g * __builtin_amdgcn_rcpf(1.0f + e) * up; }
        u32x4 w; w.x = cvtpk(y[0], y[1]); w.y = cvtpk(y[2], y[3]); w.z = cvtpk(y[4], y[5]); w.w = cvtpk(y[6], y[7]);
        *(u32x4*)rowp = w; }
  }
};

template <class Epi>
__device__ __forceinline__ void gemm_phase(LAS unsigned char* lds, const Gemm g, const StaticOrder& S, const Epi& E) {
  const int tid = opaque_tid(), wid = __builtin_amdgcn_readfirstlane(tid >> 6), lane = tid & 63, wr = wid >> 2, wc = wid & 3, fr = lane & 15, fq = lane >> 4;
  const int K = g.K, nt = K / BK, lda = g.lda;
  unsigned voffA[2], voffB[2];
#pragma unroll
  for (int i = 0; i < 2; ++i) { int R, C; stage_rc(tid * 16 + i * 8192, R, C); const int Rb = Epi::PERM ? ((R & ~31) + perm32(R & 31)) : R;
    voffA[i] = (unsigned)(R * lda + C) * 2u; voffB[i] = (unsigned)(Rb * K + C) * 2u; }
  const size_t kstep = (size_t)(BK * 2);
  const size_t hstepA = (size_t)HALF * lda * 2, hstepB = (size_t)HALF * K * 2;
  const size_t tstepA = 2 * hstepA, tstepB = 2 * hstepB;
  const unsigned ldsw = (unsigned)wid * 1024u;
  const int aoff = lds_byte(wr * 64 + fr, fq * 8), boff = lds_byte(wc * 32 + fr, fq * 8);
#define PG8_SA(b, h) (((b) * 2 + (h)) * HTB)
#define PG8_SB(b, h) ((4 + (b) * 2 + (h)) * HTB)
#define PG8_STAGE(bufoff, gbase, voff) do { _Pragma("unroll") for (int _i = 0; _i < 2; ++_i) \
    __builtin_amdgcn_global_load_lds((const unsigned*)((const char*)(gbase) + (voff)[_i]), (LAS unsigned*)(lds + (bufoff) + ldsw + _i * 8192), 16, 0, 0); } while (0)
#define PG8_LDA(dst, b, h) do { _Pragma("unroll") for (int m = 0; m < 4; ++m) _Pragma("unroll") for (int k = 0; k < 2; ++k) dst[m][k] = *(const LAS bf16x8*)(lds + PG8_SA(b, h) + aoff + m * 2048 + k * 1024); } while (0)
#define PG8_LDB(dst, b, h) do { _Pragma("unroll") for (int n = 0; n < 2; ++n) _Pragma("unroll") for (int k = 0; k < 2; ++k) dst[n][k] = *(const LAS bf16x8*)(lds + PG8_SB(b, h) + boff + n * 2048 + k * 1024); } while (0)
#define PG8_MMA(ai, bj, At, Bt) do { __builtin_amdgcn_s_setprio(1); _Pragma("unroll") for (int m = 0; m < 4; ++m) _Pragma("unroll") for (int n = 0; n < 2; ++n) _Pragma("unroll") for (int k = 0; k < 2; ++k) \
    acc[ai][bj][m][n] = __builtin_amdgcn_mfma_f32_16x16x32_bf16(Bt[n][k], At[m][k], acc[ai][bj][m][n], 0, 0, 0); __builtin_amdgcn_s_setprio(0); } while (0)
#define PG8_WAIT_V(n) asm volatile("s_waitcnt vmcnt(" #n ")" ::: "memory")
#define PG8_WAIT_L(n) asm volatile("s_waitcnt lgkmcnt(" #n ")" ::: "memory")
#define PG8_BAR __builtin_amdgcn_s_barrier()
#define PG8_SCHED __builtin_amdgcn_sched_barrier(0)
  Unit cur, nxt; int ui = 0;
  if (!S.next(0, cur)) return;
  f32x4 acc[2][2][4][2];
#pragma unroll
  for (int a = 0; a < 2; ++a)
#pragma unroll
    for (int b = 0; b < 2; ++b)
#pragma unroll
      for (int m = 0; m < 4; ++m)
#pragma unroll
        for (int n = 0; n < 2; ++n) acc[a][b][m][n] = (f32x4){0.f, 0.f, 0.f, 0.f};
  bf16x8 At[4][2], B0[2][2], B1[2][2];
  const char* cA = (const char*)g.A + (size_t)cur.pm * tstepA; const char* cB = (const char*)g.Bt + (size_t)cur.pn * tstepB;
  PG8_STAGE(PG8_SB(0, 0), cB, voffB); PG8_STAGE(PG8_SA(0, 0), cA, voffA); PG8_STAGE(PG8_SB(0, 1), cB + hstepB, voffB); PG8_STAGE(PG8_SA(0, 1), cA + hstepA, voffA);
  if (wr == 1) PG8_BAR;
  PG8_WAIT_V(4); PG8_BAR;
  PG8_STAGE(PG8_SB(1, 0), cB + kstep, voffB); PG8_STAGE(PG8_SA(1, 0), cA + kstep, voffA); PG8_STAGE(PG8_SB(1, 1), cB + hstepB + kstep, voffB);
  PG8_WAIT_V(6); PG8_BAR;
  for (;;) {
    const bool has_next = S.next(ui + 1, nxt);
    const char* nA = has_next ? (const char*)g.A + (size_t)nxt.pm * tstepA : cA; const char* nB = has_next ? (const char*)g.Bt + (size_t)nxt.pn * tstepB : cB;
    for (int t = 0; t < nt; t += 2) {
      const bool last = (t == nt - 2);
      const char* a1 = cA + (size_t)(t + 1) * kstep;
      const char* a2 = last ? nA : cA + (size_t)(t + 2) * kstep; const char* b2 = last ? nB : cB + (size_t)(t + 2) * kstep;
      const char* a3 = a2 + kstep; const char* b3 = b2 + kstep;
      PG8_LDB(B0, 0, 0); PG8_SCHED; PG8_LDA(At, 0, 0); PG8_STAGE(PG8_SA(1, 1), a1 + hstepA, voffA);
      PG8_WAIT_L(8); PG8_BAR; PG8_WAIT_L(0); PG8_MMA(0, 0, At, B0); PG8_BAR; PG8_SCHED;
      PG8_LDB(B1, 0, 1); PG8_STAGE(PG8_SB(0, 0), b2, voffB);
      PG8_BAR; PG8_WAIT_L(0); PG8_MMA(0, 1, At, B1); PG8_BAR;
      PG8_LDA(At, 0, 1); PG8_STAGE(PG8_SA(0, 0), a2, voffA);
      PG8_BAR; PG8_WAIT_L(0); PG8_MMA(1, 0, At, B0); PG8_BAR; PG8_SCHED;
      PG8_STAGE(PG8_SB(0, 1), b2 + hstepB, voffB);
      PG8_WAIT_V(6); PG8_BAR; PG8_MMA(1, 1, At, B1); PG8_BAR;
      PG8_LDB(B0, 1, 0); PG8_SCHED; PG8_LDA(At, 1, 0); PG8_STAGE(PG8_SA(0, 1), a2 + hstepA, voffA);
      PG8_WAIT_L(8); PG8_BAR; PG8_WAIT_L(0); PG8_MMA(0, 0, At, B0); PG8_BAR; PG8_SCHED;
      PG8_LDB(B1, 1, 1); PG8_STAGE(PG8_SB(1, 0), b3, voffB);
      PG8_BAR; PG8_WAIT_L(0); PG8_MMA(0, 1, At, B1); PG8_BAR;
      PG8_LDA(At, 1, 1); PG8_STAGE(PG8_SA(1, 0), a3, voffA);
      PG8_BAR; PG8_WAIT_L(0); PG8_MMA(1, 0, At, B0); PG8_BAR; PG8_SCHED;
      PG8_STAGE(PG8_SB(1, 1), b3 + hstepB, voffB);
      PG8_WAIT_V(6); PG8_BAR; PG8_MMA(1, 1, At, B1); PG8_BAR;
    }
    E(acc, cur, wr, wc, fr, fq);
    if (!has_next) break;
#pragma unroll
    for (int a = 0; a < 2; ++a)
#pragma unroll
      for (int b = 0; b < 2; ++b)
#pragma unroll
        for (int m = 0; m < 4; ++m)
#pragma unroll
          for (int n = 0; n < 2; ++n) acc[a][b][m][n] = (f32x4){0.f, 0.f, 0.f, 0.f};
    cur = nxt; cA = nA; cB = nB; ++ui;
  }
  PG8_WAIT_V(0);
  if (wr == 0) PG8_BAR;
  PG8_BAR;
#undef PG8_SA
#undef PG8_SB
#undef PG8_STAGE
#undef PG8_LDA
#undef PG8_LDB
#undef PG8_MMA
#undef PG8_WAIT_V
#undef PG8_WAIT_L
#undef PG8_BAR
#undef PG8_SCHED
}
template <class Epi>
__device__ __forceinline__ void run_gemm(LAS unsigned char* lds, const bf16_t* A, int lda, const bf16_t* Bt, int M, int N, int K, const Epi& E, int coff) {
  Gemm g{A, Bt, M, N, K, lda};
  StaticOrder S; S.init(M, N, (int)gridDim.x, (int)((blockIdx.x + coff) % gridDim.x));
  gemm_phase<Epi>(lds, g, S, E);
}
}

namespace att {
constexpr int NW = 8, QBLK = 32, KVBLK = 64;
constexpr float THR = 8.f;
constexpr int SHM_V = KVBLK * 128 * 2, SHM_K = KVBLK * 128 * 2, SHM_K2 = KVBLK * 64 * 2;
constexpr int OFF_K = 2 * SHM_V, OFF_K2 = OFF_K + 2 * SHM_K, OFF_WS = OFF_K2 + 2 * SHM_K2, OFF_Q2 = OFF_WS + NW * 64 * 4, SHM_ATTN = OFF_Q2 + 32768;
#define KSWZ(row, colB) ((row) * 256 + ((colB) ^ (((row) & 7) << 4)))
#define K2SWZ(row, colB) ((row) * 128 + ((colB) ^ ((((row) >> 1) & 7) << 4)))
#define SBAR() __builtin_amdgcn_sched_barrier(0)
__device__ __forceinline__ int crow(int r, int hi) { return (r & 3) + 8 * (r >> 2) + 4 * hi; }
__device__ __forceinline__ void partialSM(f32x16& p0, f32x16& p1, float& m_reg, float& mn, float& alpha, float C, float thr_s) {
  float pmax = p0[0];
#pragma unroll
  for (int r = 1; r < 16; ++r) pmax = fmaxf(pmax, p0[r]);
#pragma unroll
  for (int r = 0; r < 16; ++r) pmax = fmaxf(pmax, p1[r]);
  { auto rr = __builtin_amdgcn_permlane32_swap(__float_as_uint(pmax), __float_as_uint(pmax), false, false);
    pmax = fmaxf(__uint_as_float(rr[0]), __uint_as_float(rr[1])); }
  if (__builtin_expect(__all(pmax - m_reg <= thr_s), 1)) { mn = m_reg; alpha = 1.f; }
  else { mn = fmaxf(m_reg, pmax); alpha = __builtin_amdgcn_exp2f((m_reg - mn) * C); m_reg = mn; }
  float mnC = -mn * C;
#pragma unroll
  for (int r = 0; r < 16; ++r) p0[r] = fmaf(p0[r], C, mnC);
#pragma unroll
  for (int r = 0; r < 16; ++r) p1[r] = fmaf(p1[r], C, mnC);
#pragma unroll
  for (int r = 0; r < 16; ++r) p0[r] = __builtin_amdgcn_exp2f(p0[r]);
}
__device__ __forceinline__ void finishSM(f32x16& p0, f32x16& p1, float alpha, float& l_reg, bf16x8& pa0, bf16x8& pa1, bf16x8& pa2, bf16x8& pa3) {
#pragma unroll
  for (int r = 0; r < 16; ++r) p1[r] = __builtin_amdgcn_exp2f(p1[r]);
  float ps = 0;
#pragma unroll
  for (int r = 0; r < 16; ++r) ps += p0[r];
#pragma unroll
  for (int r = 0; r < 16; ++r) ps += p1[r];
  { auto rr = __builtin_amdgcn_permlane32_swap(__float_as_uint(ps), __float_as_uint(ps), false, false);
    ps = __uint_as_float(rr[0]) + __uint_as_float(rr[1]); }
  l_reg = l_reg * alpha + ps;
#define PK4(P, BASE, OUT) do { unsigned a0 = cvtpk(P[BASE + 0], P[BASE + 1]), a1 = cvtpk(P[BASE + 2], P[BASE + 3]);   \
    unsigned b0 = cvtpk(P[BASE + 4], P[BASE + 5]), b1 = cvtpk(P[BASE + 6], P[BASE + 7]);                              \
    auto r0 = __builtin_amdgcn_permlane32_swap(a0, b0, false, false); auto r1 = __builtin_amdgcn_permlane32_swap(a1, b1, false, false); \
    u32x4 w = {r0[0], r1[0], r0[1], r1[1]}; OUT = *reinterpret_cast<bf16x8*>(&w); } while (0)
  PK4(p0, 0, pa0); PK4(p0, 8, pa1); PK4(p1, 0, pa2); PK4(p1, 8, pa3);
#undef PK4
}
template <int DQK>
__device__ __forceinline__ void qkt(f32x16& p0, f32x16& p1, const char* Ks, const char* K2s, const bf16x8* qr, const char* q2l, int r32, int hi) {
#pragma unroll
  for (int r = 0; r < 16; ++r) { p0[r] = 0.f; p1[r] = 0.f; }
#pragma unroll
  for (int d0 = 0; d0 < 8; ++d0) { int cb = (d0 * 16 + hi * 8) * 2;
    bf16x8 b0 = *reinterpret_cast<const bf16x8*>(Ks + KSWZ(r32, cb));
    bf16x8 b1 = *reinterpret_cast<const bf16x8*>(Ks + KSWZ(32 + r32, cb));
    p0 = __builtin_amdgcn_mfma_f32_32x32x16_bf16(b0, qr[d0], p0, 0, 0, 0);
    p1 = __builtin_amdgcn_mfma_f32_32x32x16_bf16(b1, qr[d0], p1, 0, 0, 0); }
  if constexpr (DQK == 192) {
#pragma unroll
    for (int d0 = 0; d0 < 4; ++d0) { int cb = (d0 * 16 + hi * 8) * 2;
      bf16x8 b0 = *reinterpret_cast<const bf16x8*>(K2s + K2SWZ(r32, cb));
      bf16x8 b1 = *reinterpret_cast<const bf16x8*>(K2s + K2SWZ(32 + r32, cb));
      const bf16x8 q2 = *reinterpret_cast<const bf16x8*>(q2l + d0 * 1024);
      p0 = __builtin_amdgcn_mfma_f32_32x32x16_bf16(b0, q2, p0, 0, 0, 0);
      p1 = __builtin_amdgcn_mfma_f32_32x32x16_bf16(b1, q2, p1, 0, 0, 0); }
  }
}
__device__ __forceinline__ int v_st(int k, int c) { const int kk = (k & ~0xC) | ((k & 4) << 1) | ((k & 8) >> 1); return ((kk >> 3) * 4 + (c >> 5)) * 512 + ((kk & 7) * 32 + (c & 31)) * 2; }
__device__ __forceinline__ int v_rd_base(int lane) { return ((lane & 3) << 3) | (((lane >> 2) & 3) << 6) | (((lane >> 4) & 1) << 5) | (((lane >> 5) & 1) << 8); }
constexpr int v_rd_off(int d0, int ks, int half) { return d0 * 512 + ks * 4096 + half * 2048; }
template <int OFF> __device__ __forceinline__ s16x4 tr_read(int vb) {
  s16x4 r; asm volatile("ds_read_b64_tr_b16 %0, %1 offset:%2" : "=&v"(r) : "v"(vb), "i"(OFF) : "memory"); return r;
}
template <int D0> __device__ __forceinline__ void pv_one(f32x16& od, int vb, bf16x8 pa0, bf16x8 pa1, bf16x8 pa2, bf16x8 pa3) {
  const s16x4 l0 = tr_read<v_rd_off(D0, 0, 0)>(vb), h0 = tr_read<v_rd_off(D0, 0, 1)>(vb), l1 = tr_read<v_rd_off(D0, 1, 0)>(vb), h1 = tr_read<v_rd_off(D0, 1, 1)>(vb);
  const s16x4 l2 = tr_read<v_rd_off(D0, 2, 0)>(vb), h2 = tr_read<v_rd_off(D0, 2, 1)>(vb), l3 = tr_read<v_rd_off(D0, 3, 0)>(vb), h3 = tr_read<v_rd_off(D0, 3, 1)>(vb);
  asm volatile("s_waitcnt lgkmcnt(0)" ::: "memory"); SBAR();
#define PK(L, H) (bf16x8){L[0], L[1], L[2], L[3], H[0], H[1], H[2], H[3]}
  od = __builtin_amdgcn_mfma_f32_32x32x16_bf16(pa0, PK(l0, h0), od, 0, 0, 0);
  od = __builtin_amdgcn_mfma_f32_32x32x16_bf16(pa1, PK(l1, h1), od, 0, 0, 0);
  od = __builtin_amdgcn_mfma_f32_32x32x16_bf16(pa2, PK(l2, h2), od, 0, 0, 0);
  od = __builtin_amdgcn_mfma_f32_32x32x16_bf16(pa3, PK(l3, h3), od, 0, 0, 0);
#undef PK
}
__device__ __forceinline__ void pv_d0(f32x16* o, int vb, bf16x8 pa0, bf16x8 pa1, bf16x8 pa2, bf16x8 pa3) {
  pv_one<0>(o[0], vb, pa0, pa1, pa2, pa3); pv_one<1>(o[1], vb, pa0, pa1, pa2, pa3); pv_one<2>(o[2], vb, pa0, pa1, pa2, pa3); pv_one<3>(o[3], vb, pa0, pa1, pa2, pa3);
}

template <int DQK, int SDEPTH>
__device__ __forceinline__ void attn_body(const bf16_t* __restrict__ Qb, int ldq, const bf16_t* __restrict__ Kh, int ldk, const bf16_t* __restrict__ K2h, int ldk2,
                                          const bf16_t* __restrict__ Vh, int ldv, bf16_t* __restrict__ Ob, int ldo, int seq, float scale, char* lds) {
  constexpr int ND = 8;
  const int tid = opaque_tid(), wid = tid >> 6, lane = tid & 63, r32 = lane & 31, hi = lane >> 5;
  const float C = scale * 1.4426950408889634f, thr_s = THR / scale;
  char* V_lds = lds; char* K_lds = lds + OFF_K; char* K2_lds = lds + OFF_K2;
  float* ws = (float*)(lds + OFF_WS) + wid * 64; float* li_l = ws; float* al_l = ws + 32;
  float m_reg = -1e30f, l_reg = 0; f32x16 o[4]; bf16x8 qr[ND];
#pragma unroll
  for (int d = 0; d < 4; ++d)
#pragma unroll
    for (int r = 0; r < 16; ++r) o[d][r] = 0.f;
  const bf16_t* Qw = Qb + (long)(wid * QBLK + r32) * ldq + hi * 8;
#pragma unroll
  for (int d0 = 0; d0 < ND; ++d0) qr[d0] = *reinterpret_cast<const bf16x8*>(Qw + d0 * 16);
  char* q2l = lds + OFF_Q2 + (wid * 4 * 64 + lane) * 16;
  __syncthreads();
  if constexpr (DQK == 192) {
#pragma unroll
    for (int d0 = 0; d0 < 4; ++d0) *reinterpret_cast<bf16x8*>(q2l + d0 * 1024) = *reinterpret_cast<const bf16x8*>(Qw + (8 + d0) * 16);
  }
  const int sr = tid >> 4, sc = (tid & 15) * 8, vst0 = v_st(sr, sc), vst1 = v_st(32 + sr, sc);
  const int sr2 = tid >> 3, sc2 = (tid & 7) * 8;
  const unsigned voffV = (unsigned)(sr * ldv + sc) * 2u, voffK = (unsigned)(sr * ldk + sc) * 2u, voffK2 = (unsigned)(sr2 * ldk2 + sc2) * 2u;
  const size_t tsV = (size_t)ldv * 2, tsK = (size_t)ldk * 2, tsK2 = (size_t)ldk2 * 2;
  const int vb0 = (int)(uintptr_t)V_lds + v_rd_base(lane);
  struct { bf16x8 vs0, vs1, ks0, ks1, k2; } sr_[SDEPTH];
#define SLOAD(i, k0) do { const char* vb_ = (const char*)Vh + (size_t)(k0) * tsV; const char* kb_ = (const char*)Kh + (size_t)(k0) * tsK; \
    sr_[i].vs0 = *(const bf16x8*)(vb_ + voffV); sr_[i].vs1 = *(const bf16x8*)(vb_ + 32 * tsV + voffV); \
    sr_[i].ks0 = *(const bf16x8*)(kb_ + voffK); sr_[i].ks1 = *(const bf16x8*)(kb_ + 32 * tsK + voffK); \
    if constexpr (DQK == 192) sr_[i].k2 = *(const bf16x8*)((const char*)K2h + (size_t)(k0) * tsK2 + voffK2); } while (0)
#define SWRITE(b, i) do { *(bf16x8*)(V_lds + (b) * SHM_V + vst0) = sr_[i].vs0;          \
    *(bf16x8*)(V_lds + (b) * SHM_V + vst1) = sr_[i].vs1; int kc = sc * 2;               \
    *(bf16x8*)(K_lds + (b) * SHM_K + KSWZ(sr, kc)) = sr_[i].ks0;                       \
    *(bf16x8*)(K_lds + (b) * SHM_K + KSWZ(32 + sr, kc)) = sr_[i].ks1;                  \
    if constexpr (DQK == 192) *(bf16x8*)(K2_lds + (b) * SHM_K2 + K2SWZ(sr2, sc2 * 2)) = sr_[i].k2; } while (0)
#define SWAIT() do { if constexpr (SDEPTH == 1) asm volatile("s_waitcnt vmcnt(0)" ::: "memory"); else if constexpr (DQK == 192) asm volatile("s_waitcnt vmcnt(5)" ::: "memory"); else asm volatile("s_waitcnt vmcnt(4)" ::: "memory"); } while (0)
#define RESC(a) do { if (__any((a) < 1.f)) { if (hi == 0) al_l[r32] = (a); asm volatile("s_waitcnt lgkmcnt(0)" ::: "memory"); \
    _Pragma("unroll") for (int d = 0; d < 4; ++d) _Pragma("unroll") for (int r = 0; r < 16; ++r) o[d][r] *= al_l[crow(r, hi)]; } } while (0)
  f32x16 pA0, pA1, pB0, pB1; float mnA, mnB, alA, alB; bf16x8 pa0, pa1, pa2, pa3; const int NT = seq / KVBLK;
  constexpr int SE = 0, SO = SDEPTH - 1;
  SLOAD(SE, 0); asm volatile("s_waitcnt vmcnt(0)" ::: "memory"); SWRITE(0, SE); __syncthreads();
  qkt<DQK>(pA0, pA1, K_lds, K2_lds, qr, q2l, r32, hi); partialSM(pA0, pA1, m_reg, mnA, alA, C, thr_s);
  SLOAD(SO, KVBLK); if constexpr (SDEPTH == 2) { if (2 < NT) SLOAD(SE, 2 * KVBLK); }
  SWAIT(); SWRITE(1, SO); __syncthreads();
  for (int j = 1; j + 1 < NT; j += 2) {
    SBAR(); qkt<DQK>(pB0, pB1, K_lds + SHM_K, K2_lds + SHM_K2, qr, q2l, r32, hi);
    finishSM(pA0, pA1, alA, l_reg, pa0, pa1, pa2, pa3); SBAR();
    SLOAD(SO, (j + SDEPTH) * KVBLK); SBAR();
    pv_d0(o, vb0, pa0, pa1, pa2, pa3); partialSM(pB0, pB1, m_reg, mnB, alB, C, thr_s);
    __syncthreads(); SWAIT(); SWRITE(0, SE);
    RESC(alB); __syncthreads();
    SBAR(); qkt<DQK>(pA0, pA1, K_lds, K2_lds, qr, q2l, r32, hi);
    finishSM(pB0, pB1, alB, l_reg, pa0, pa1, pa2, pa3); SBAR();
    if (SDEPTH == 1 || j + 3 < NT) SLOAD(SE, (j + 1 + SDEPTH) * KVBLK); SBAR();
    pv_d0(o, vb0 + SHM_V, pa0, pa1, pa2, pa3); partialSM(pA0, pA1, m_reg, mnA, alA, C, thr_s);
    __syncthreads(); SWAIT(); SWRITE(1, SO);
    RESC(alA); __syncthreads();
  }
  SBAR(); qkt<DQK>(pB0, pB1, K_lds + SHM_K, K2_lds + SHM_K2, qr, q2l, r32, hi);
  finishSM(pA0, pA1, alA, l_reg, pa0, pa1, pa2, pa3); SBAR();
  pv_d0(o, vb0, pa0, pa1, pa2, pa3); partialSM(pB0, pB1, m_reg, mnB, alB, C, thr_s);
  __syncthreads(); RESC(alB);
  finishSM(pB0, pB1, alB, l_reg, pa0, pa1, pa2, pa3); SBAR();
  pv_d0(o, vb0 + SHM_V, pa0, pa1, pa2, pa3);
  if (hi == 0) li_l[r32] = l_reg; asm volatile("s_waitcnt lgkmcnt(0)" ::: "memory");
  float rli[16];
#pragma unroll
  for (int r = 0; r < 16; ++r) rli[r] = __builtin_amdgcn_rcpf(li_l[crow(r, hi)]);
  bf16_t* Ow = Ob + (long)(wid * QBLK) * ldo;
#pragma unroll
  for (int r = 0; r < 16; ++r) { int orow = crow(r, hi);
#pragma unroll
    for (int d0 = 0; d0 < 4; ++d0) Ow[(long)orow * ldo + d0 * 32 + r32] = f2bf(o[d0][r] * rli[r]); }
#undef SLOAD
#undef SWRITE
#undef SWAIT
#undef RESC
}
struct AttnJob { const bf16_t* Q; int ldq, qhs; const bf16_t* K; int ldk, khs; long kbs; const bf16_t* K2; int ldk2; const bf16_t* V; int ldv; bf16_t* O; int H, gshift, seq, nunits; float scale; };
template <int DQK, int SDEPTH>
__device__ __forceinline__ void run_attn(const AttnJob& a, char* lds) {
  for (int u = blockIdx.x; u < a.nunits; u += gridDim.x) {
    const int per_b = a.H * 32, b = u / per_b, rest = u - b * per_b, h = rest % a.H, qb = rest / a.H, kh = h >> a.gshift;
    const long tok0 = (long)b * SEQ + qb * 256;
    attn_body<DQK, SDEPTH>(a.Q + tok0 * a.ldq + h * a.qhs, a.ldq, a.K + (long)b * a.kbs + kh * a.khs, a.ldk, a.K2 + (long)b * SEQ * a.ldk2, a.ldk2,
                           a.V + (long)b * a.kbs + kh * a.khs, a.ldv, a.O + tok0 * 1536 + h * 128, 1536, a.seq, a.scale, lds);
  }
}
}

__device__ __forceinline__ void rms_rows(const float* __restrict__ src, const float* __restrict__ gain, bf16_t* __restrict__ dst, int nrows) {
  const int tid_ = opaque_tid(), wid = tid_ >> 6, lane = tid_ & 63;
  for (int row = blockIdx.x * 8 + wid; row < nrows; row += gridDim.x * 8) {
    const f32x4* s = (const f32x4*)(src + (size_t)row * DM);
    f32x4 v[4]; float ss = 0.f;
#pragma unroll
    for (int j = 0; j < 4; ++j) { v[j] = s[lane + 64 * j]; ss += v[j][0] * v[j][0] + v[j][1] * v[j][1] + v[j][2] * v[j][2] + v[j][3] * v[j][3]; }
    ss = wave_sum(ss);
    const float rs = rsqrtf(ss * (1.f / DM) + EPS);
#pragma unroll
    for (int j = 0; j < 4; ++j) { const f32x4 g = ((const f32x4*)gain)[lane + 64 * j];
      u32x2 w; w.x = cvtpk(v[j][0] * rs * g[0], v[j][1] * rs * g[1]); w.y = cvtpk(v[j][2] * rs * g[2], v[j][3] * rs * g[3]);
      *(u32x2*)(dst + (size_t)row * DM + (lane + 64 * j) * 4) = w; }
  }
}
template <int MODE>
__device__ __forceinline__ void prep_w(const float* __restrict__ src, int K, int Nsrc, bf16_t* __restrict__ dst, int Ndst) {
  const long total = (long)Ndst * (K / 8);
  for (long i = (long)blockIdx.x * 512 + opaque_tid(); i < total; i += (long)gridDim.x * 512) {
    const int n = (int)(i % Ndst), k8 = (int)(i / Ndst);
    int ns = n;
    if (MODE == 1) { const int pn = n >> 8, r = n & 255, bj = r >> 7, ii = r & 127; ns = bj * DFF + pn * 128 + ii; }
    float x[8];
#pragma unroll
    for (int j = 0; j < 8; ++j) x[j] = (ns < Nsrc) ? src[(size_t)(k8 * 8 + j) * Nsrc + ns] : 0.f;
    u32x4 w; w.x = cvtpk(x[0], x[1]); w.y = cvtpk(x[2], x[3]); w.z = cvtpk(x[4], x[5]); w.w = cvtpk(x[6], x[7]);
    *(u32x4*)(dst + (size_t)n * K + k8 * 8) = w;
  }
}
template <int NE> __device__ __forceinline__ void ld_seg(float* v, const bf16_t* p, int lane) {
#pragma unroll
  for (int j = 0; j < NE; ++j) v[j] = bf2f(p[lane + 64 * j]);
}
template <int NE> __device__ __forceinline__ void st_seg(const float* v, bf16_t* p, int lane) {
#pragma unroll
  for (int j = 0; j < NE; ++j) p[lane + 64 * j] = f2bf(v[j]);
}
template <int NE, int ROPE> __device__ __forceinline__ void norm_seg(float* v, const float* __restrict__ gain, int lane, int prow, int pcol) {
  float ss = 0.f;
#pragma unroll
  for (int j = 0; j < NE; ++j) ss += v[j] * v[j];
  ss = wave_sum(ss);
  const float rs = rsqrtf(ss * (1.f / (64 * NE)) + EPS);
#pragma unroll
  for (int j = 0; j < NE; ++j) v[j] = v[j] * rs * gain[lane + 64 * j];
  if constexpr (ROPE && NE == 2) {
    const int f = lane & 31; const float inv = exp2f(-(float)(2 * f) * (1.f / 64.f) * LOG2_THETA);
#pragma unroll
    for (int j = 0; j < 2; ++j) {
      const float partner = __shfl_xor(v[j], 32, 64);
      const float ang = (float)(j == 0 ? prow : pcol) * inv;
      float rev = ang * INV2PI; rev -= floorf(rev);
      const float c = __builtin_amdgcn_cosf(rev), s = __builtin_amdgcn_sinf(rev);
      v[j] = (lane < 32) ? v[j] * c - partner * s : v[j] * c + partner * s;
    }
  }
  if constexpr (ROPE && NE == 1) {
    const int f = lane & 15; const float inv = exp2f(-(float)(2 * f) * (1.f / 32.f) * LOG2_THETA);
    const float partner = __shfl_xor(v[0], 16, 64);
    const float ang = (float)(lane < 32 ? prow : pcol) * inv;
    float rev = ang * INV2PI; rev -= floorf(rev);
    const float c = __builtin_amdgcn_cosf(rev), s = __builtin_amdgcn_sinf(rev);
    v[0] = (lane & 16) ? v[0] * c + partner * s : v[0] * c - partner * s;
  }
}

constexpr int LDS_BYTES = pg8::STAGE_BYTES;
static_assert(att::SHM_ATTN <= LDS_BYTES, "lds");
constexpr int NPHASE = 18;
#ifndef PHMASK
#define PHMASK 0xf
#endif
#ifndef A128_SD
#define A128_SD 1
#endif
#ifndef KARG
#define KARG 0
#endif
#define wt_in0 ((bf16_t*)(p.ws + WS_WT_IN0))
#define wt_qb ((bf16_t*)(p.ws + WS_WT_QB))
#define wt_kvb ((bf16_t*)(p.ws + WS_WT_KVB))
#define wt_out ((bf16_t*)(p.ws + WS_WT_OUT))
#define wt_memkv ((bf16_t*)(p.ws + WS_WT_MEMKV))
#define wt_gu ((bf16_t*)(p.ws + WS_WT_GU))
#define wt_dn ((bf16_t*)(p.ws + WS_WT_DN))
#define wt_in1 ((bf16_t*)(p.ws + WS_WT_IN1))
#define memn ((bf16_t*)(p.ws + WS_MEMN))
#define memkv ((bf16_t*)(p.ws + WS_MEMKV))
#define hbuf ((bf16_t*)(p.ws + WS_HM))
#define mix ((bf16_t*)(p.ws + WS_HM))
#define proj ((bf16_t*)(p.ws + WS_R))
#define act ((bf16_t*)(p.ws + WS_R))
#define qbuf ((bf16_t*)(p.ws + WS_Q))
#define kvbuf ((bf16_t*)(p.ws + WS_KV))

struct GemmJob { const bf16_t* A; int lda; const bf16_t* Bt; int M, N, K; int kind; bf16_t* O; int ldc; const float* res; int coff; };

__device__ __forceinline__ int gemm_jobs(const Params& p, int ph, int gi, GemmJob& j) {
  const float* x = p.in[0];
  j.M = NTOK; j.res = nullptr; j.coff = 0; j.O = nullptr; j.ldc = 0;
  switch (ph) {
  case 1:
    if (gi == 0) { j.A = hbuf; j.lda = 1024; j.Bt = wt_in0; j.N = 1280; j.K = 1024; j.kind = 0; j.O = proj; j.ldc = 1280; }
    else { j.A = memn; j.lda = 1024; j.Bt = wt_memkv + (size_t)(gi - 1) * 1024 * 1024; j.M = NMEMROWS; j.N = 1024; j.K = 1024; j.kind = 0; j.O = memkv + (size_t)(gi - 1) * NMEMROWS * 1024; j.ldc = 1024; j.coff = (gi - 1) * 128; }
    return 3;
  case 3:
    if (gi == 0) { j.A = proj; j.lda = 1280; j.Bt = wt_qb; j.N = 1536; j.K = 384; j.kind = 0; j.O = qbuf; j.ldc = 1536; }
    else { j.A = proj + 384; j.lda = 1280; j.Bt = wt_kvb; j.N = 2048; j.K = 256; j.kind = 0; j.O = kvbuf; j.ldc = 2048; }
    return 2;
  case 6: case 14: { const int L = ph == 6 ? 0 : 1;
    j.A = mix; j.lda = 1536; j.Bt = wt_out + (size_t)L * 1024 * 1536; j.N = 1024; j.K = 1536; j.kind = 1; j.res = L == 0 ? x : p.out; return 1; }
  case 8: case 16: { const int L = ph == 8 ? 0 : 1;
    j.A = hbuf; j.lda = 1024; j.Bt = wt_gu + (size_t)L * 5632 * 1024; j.N = 5632; j.K = 1024; j.kind = 2; j.O = act; return 1; }
  case 9: case 17: { const int L = ph == 9 ? 0 : 1;
    j.A = act; j.lda = DFF; j.Bt = wt_dn + (size_t)L * 1024 * 2816; j.N = 1024; j.K = DFF; j.kind = 1; j.res = p.out; return 1; }
  case 11:
    j.A = hbuf; j.lda = 1024; j.Bt = wt_in1; j.N = 2048; j.K = 1024; j.kind = 0; j.O = proj; j.ldc = 2048; return 1;
  default: return 0;
  }
}

__global__ __launch_bounds__(512) void mega(Params p_) {
  extern __shared__ __attribute__((aligned(16))) unsigned char shm[];
  LAS unsigned char* glds = (LAS unsigned char*)shm;
  char* alds = (char*)shm;
  const Params* pp = (const Params*)__builtin_amdgcn_kernarg_segment_ptr();
  const int ph_lo = p_.ph_lo, ph_hi = p_.ph_hi;

  for (int ph = ph_lo; ph < ph_hi; ++ph) {
#if KARG
    asm volatile("" : "+s"(pp));
    const Params& p = *pp;
#else
    const Params& p = p_;
#endif
    const float* x = p.in[0];
    const int tid_ = opaque_tid(), wid = tid_ >> 6, lane = tid_ & 63;
    const int gw = blockIdx.x * 8 + wid, nw = gridDim.x * 8;
    if (PHMASK & 1) switch (ph) {
    case 0: {
      prep_w<0>(p.in[11], 1024, 1216, wt_in0, 1280);
      prep_w<0>(p.in[13], 384, 1536, wt_qb, 1536);
      prep_w<0>(p.in[15], 256, 2048, wt_kvb, 2048);
      for (int i = 0; i < 2; ++i) {
        prep_w<0>(p.in[5] + (size_t)i * 1536 * 1024, 1536, 1024, wt_out + (size_t)i * 1024 * 1536, 1024);
        prep_w<0>(p.in[6] + (size_t)i * 1024 * 1024, 1024, 1024, wt_memkv + (size_t)i * 1024 * 1024, 1024);
        prep_w<1>(p.in[9] + (size_t)i * 1024 * 5632, 1024, 5632, wt_gu + (size_t)i * 5632 * 1024, 5632);
        prep_w<0>(p.in[10] + (size_t)i * 2816 * 1024, 2816, 1024, wt_dn + (size_t)i * 1024 * 2816, 1024);
      }
      prep_w<0>(p.in[18], 1024, 2048, wt_in1, 2048);
      rms_rows(p.in[1], p.in[2], memn, NMEMROWS);
      rms_rows(x, p.in[3], hbuf, NTOK);
    } break;
    case 2: {
      for (int t = gw; t < NTOK; t += nw) {
        const int s = t & (SEQ - 1), prow = s >> 6, pcol = s & 63;
        bf16_t* row = proj + (size_t)t * 1280;
        float cq[6], ckv[4], kpe[1], qm[4][2];
        ld_seg<6>(cq, row, lane); ld_seg<4>(ckv, row + 384, lane); ld_seg<1>(kpe, row + 640, lane);
#pragma unroll
        for (int h = 0; h < 4; ++h) ld_seg<2>(qm[h], row + 704 + h * 128, lane);
        norm_seg<6, 0>(cq, p.in[12], lane, 0, 0); norm_seg<4, 0>(ckv, p.in[14], lane, 0, 0); norm_seg<1, 1>(kpe, p.in[17] + 128, lane, prow, pcol);
#pragma unroll
        for (int h = 0; h < 4; ++h) norm_seg<2, 0>(qm[h], p.in[7], lane, 0, 0);
        st_seg<6>(cq, row, lane); st_seg<4>(ckv, row + 384, lane); st_seg<1>(kpe, row + 640, lane);
#pragma unroll
        for (int h = 0; h < 4; ++h) st_seg<2>(qm[h], row + 704 + h * 128, lane);
      }
      for (int r = gw; r < 2 * NMEMROWS; r += nw) {
        const int i = r / NMEMROWS;
        bf16_t* row = memkv + (size_t)r * 1024;
        float k[4][2];
#pragma unroll
        for (int h = 0; h < 4; ++h) ld_seg<2>(k[h], row + h * 128, lane);
#pragma unroll
        for (int h = 0; h < 4; ++h) norm_seg<2, 0>(k[h], p.in[8] + i * 128, lane, 0, 0);
#pragma unroll
        for (int h = 0; h < 4; ++h) st_seg<2>(k[h], row + h * 128, lane);
      }
    } break;
    case 4: {
      for (int t = gw; t < NTOK; t += nw) {
        const int s = t & (SEQ - 1), prow = s >> 6, pcol = s & 63;
        bf16_t* qrow = qbuf + (size_t)t * 1536; bf16_t* kvrow = kvbuf + (size_t)t * 2048;
        float qn[8][2], qp[8][1], kn[8][2];
#pragma unroll
        for (int h = 0; h < 8; ++h) { ld_seg<2>(qn[h], qrow + h * 192, lane); ld_seg<1>(qp[h], qrow + h * 192 + 128, lane); ld_seg<2>(kn[h], kvrow + h * 256, lane); }
#pragma unroll
        for (int h = 0; h < 8; ++h) { norm_seg<2, 0>(qn[h], p.in[16], lane, 0, 0); norm_seg<1, 1>(qp[h], p.in[16] + 128, lane, prow, pcol); norm_seg<2, 0>(kn[h], p.in[17], lane, 0, 0); }
#pragma unroll
        for (int h = 0; h < 8; ++h) { st_seg<2>(qn[h], qrow + h * 192, lane); st_seg<1>(qp[h], qrow + h * 192 + 128, lane); st_seg<2>(kn[h], kvrow + h * 256, lane); }
      }
    } break;
    case 7: case 15: rms_rows(p.out, p.in[4] + (ph == 7 ? 0 : 1024), hbuf, NTOK); break;
    case 10: rms_rows(p.out, p.in[3] + 1024, hbuf, NTOK); break;
    case 12: {
      for (int t = gw; t < NTOK; t += nw) {
        const int s = t & (SEQ - 1), prow = s >> 6, pcol = s & 63;
        bf16_t* row = proj + (size_t)t * 2048;
        float q[8][2], k[2][2], qm[4][2];
#pragma unroll
        for (int h = 0; h < 8; ++h) ld_seg<2>(q[h], row + h * 128, lane);
#pragma unroll
        for (int h = 0; h < 2; ++h) ld_seg<2>(k[h], row + 1024 + h * 128, lane);
#pragma unroll
        for (int h = 0; h < 4; ++h) ld_seg<2>(qm[h], row + 1536 + h * 128, lane);
#pragma unroll
        for (int h = 0; h < 8; ++h) norm_seg<2, 1>(q[h], p.in[19], lane, prow, pcol);
#pragma unroll
        for (int h = 0; h < 2; ++h) norm_seg<2, 1>(k[h], p.in[20], lane, prow, pcol);
#pragma unroll
        for (int h = 0; h < 4; ++h) norm_seg<2, 0>(qm[h], p.in[7] + 128, lane, 0, 0);
#pragma unroll
        for (int h = 0; h < 8; ++h) st_seg<2>(q[h], row + h * 128, lane);
#pragma unroll
        for (int h = 0; h < 2; ++h) st_seg<2>(k[h], row + 1024 + h * 128, lane);
#pragma unroll
        for (int h = 0; h < 4; ++h) st_seg<2>(qm[h], row + 1536 + h * 128, lane);
      }
    } break;
    default: break;
    }
    if (PHMASK & 2) {
      GemmJob j; const int ng = gemm_jobs(p, ph, 0, j);
      for (int gi = 0; gi < ng; ++gi) {
        if (gi) gemm_jobs(p, ph, gi, j);
        if (j.kind == 0) pg8::run_gemm(glds, j.A, j.lda, j.Bt, j.M, j.N, j.K, pg8::EpiBf16{j.O, j.ldc}, j.coff);
        else if (j.kind == 1) pg8::run_gemm(glds, j.A, j.lda, j.Bt, j.M, j.N, j.K, pg8::EpiResF32{p.out, j.res}, j.coff);
        else pg8::run_gemm(glds, j.A, j.lda, j.Bt, j.M, j.N, j.K, pg8::EpiSwiGLU{j.O}, j.coff);
      }
    }
    if ((PHMASK & 12) && (ph == 5 || ph == 13)) {
      const int L = ph == 5 ? 0 : 1;
      att::AttnJob a;
      if (L == 0) {
        a.Q = qbuf; a.ldq = 1536; a.qhs = 192; a.K = kvbuf; a.ldk = 2048; a.khs = 256; a.kbs = (long)SEQ * 2048; a.K2 = proj + 640; a.ldk2 = 1280;
        a.V = kvbuf + 128; a.ldv = 2048; a.O = mix; a.H = 8; a.gshift = 0; a.seq = SEQ; a.nunits = 2048; a.scale = 0.072168783648703220f;
        if (PHMASK & 4) att::run_attn<192, 1>(a, alds);
      } else {
        a.Q = proj; a.ldq = 2048; a.qhs = 128; a.K = proj + 1024; a.ldk = 2048; a.khs = 128; a.kbs = (long)SEQ * 2048; a.K2 = proj; a.ldk2 = 0;
        a.V = proj + 1280; a.ldv = 2048; a.O = mix; a.H = 8; a.gshift = 2; a.seq = SEQ; a.nunits = 2048; a.scale = 0.088388347648318440f;
      }
      for (int pass = (L == 0 ? 1 : 0); pass < 2; ++pass) {
        if (pass == 1) {
          a.Q = L == 0 ? proj + 704 : proj + 1536; a.ldq = L == 0 ? 1280 : 2048; a.qhs = 128;
          a.K = memkv + (size_t)L * NMEMROWS * 1024; a.ldk = 1024; a.khs = 128; a.kbs = 256 * 1024; a.K2 = a.K; a.ldk2 = 0;
          a.V = a.K + 512; a.ldv = 1024; a.O = mix + 1024; a.H = 4; a.gshift = 0; a.seq = 256; a.nunits = 1024; a.scale = 0.088388347648318440f;
        }
        if (PHMASK & 8) att::run_attn<128, A128_SD>(a, alds);
      }
    }
    if (ph + 1 < ph_hi) cg::this_grid().sync();
  }
}

extern "C" void kernel_launch(void* const* d_in, const int* in_sizes, int n_in, void* d_out, int out_size, void* d_ws, size_t ws_size, hipStream_t stream) {
  static int grid = 0;
  if (grid == 0) {
    if (n_in != 21 || in_sizes[0] != NTOK * DM || out_size != NTOK * DM || ws_size < WS_END) {
      fprintf(stderr, "kernel_launch: shape/workspace mismatch (n_in %d, in0 %d, out %d, ws %zu, need %zu)\n", n_in, n_in > 0 ? in_sizes[0] : -1, out_size, ws_size, (size_t)WS_END);
      grid = -1; return; }
    int dev = 0, cus = 0, per_cu = 0;
    (void)hipGetDevice(&dev); (void)hipDeviceGetAttribute(&cus, hipDeviceAttributeMultiprocessorCount, dev);
    if (hipFuncSetAttribute((const void*)mega, hipFuncAttributeMaxDynamicSharedMemorySize, LDS_BYTES) != hipSuccess) { fprintf(stderr, "kernel_launch: hipFuncSetAttribute failed\n"); grid = -1; return; }
    if (hipOccupancyMaxActiveBlocksPerMultiprocessor(&per_cu, (const void*)mega, 512, LDS_BYTES) != hipSuccess || per_cu < 1) { fprintf(stderr, "kernel_launch: occupancy query says %d\n", per_cu); per_cu = 1; }
    (void)hipGetLastError();
    grid = cus * 1;
    if (grid <= 0) grid = 256;
  }
  if (grid < 0) return;
  Params p{};
  for (int i = 0; i < 21; ++i) p.in[i] = (const float*)d_in[i];
  p.out = (float*)d_out; p.ws = (unsigned char*)d_ws;
#if MK_ONE_LAUNCH
  p.ph_lo = 0; p.ph_hi = NPHASE;
  void* args[] = {&p};
  hipError_t e = hipLaunchCooperativeKernel((const void*)mega, dim3(grid), dim3(512), args, LDS_BYTES, stream);
  if (e != hipSuccess) fprintf(stderr, "kernel_launch: cooperative launch failed: %s (grid %d)\n", hipGetErrorString(e), grid);
#else
  for (int ph = 0; ph < NPHASE; ++ph) {
    p.ph_lo = ph; p.ph_hi = ph + 1;
    hipLaunchKernelGGL(mega, dim3(grid), dim3(512), LDS_BYTES, stream, p);
  }
#endif
}
```

```cpp
#include <hip/hip_runtime.h>
#include <hip/hip_cooperative_groups.h>
#include <cstdio>
#include <cstdint>
namespace cg = cooperative_groups;

#ifndef MK_ONE_LAUNCH
#define MK_ONE_LAUNCH 1
#endif

typedef unsigned short bf16_t;
typedef short bf16x8 __attribute__((ext_vector_type(8)));
typedef short s16x4 __attribute__((ext_vector_type(4)));
typedef float f32x4 __attribute__((ext_vector_type(4)));
typedef float f32x16 __attribute__((ext_vector_type(16)));
typedef unsigned u32x4 __attribute__((ext_vector_type(4)));
typedef unsigned u32x2 __attribute__((ext_vector_type(2)));
#define LAS __attribute__((address_space(3)))

constexpr int NTOK = 65536, SEQ = 8192, DM = 1024, DFF = 2816, NMEMROWS = 2048;
constexpr float EPS = 1e-6f;
constexpr float LOG2_THETA = 13.287712379549449f;
constexpr float INV2PI = 0.15915494309189535f;
constexpr size_t MiB = 1ull << 20;
constexpr size_t WS_WT_IN0 = 0;
constexpr size_t WS_WT_QB = WS_WT_IN0 + 1280ull * 1024 * 2;
constexpr size_t WS_WT_KVB = WS_WT_QB + 1536ull * 384 * 2;
constexpr size_t WS_WT_OUT = WS_WT_KVB + 2048ull * 256 * 2;
constexpr size_t WS_WT_MEMKV = WS_WT_OUT + 2ull * 1024 * 1536 * 2;
constexpr size_t WS_WT_GU = WS_WT_MEMKV + 2ull * 1024 * 1024 * 2;
constexpr size_t WS_WT_DN = WS_WT_GU + 2ull * 5632 * 1024 * 2;
constexpr size_t WS_WT_IN1 = WS_WT_DN + 2ull * 1024 * 2816 * 2;
constexpr size_t WS_WT_END = WS_WT_IN1 + 2048ull * 1024 * 2;
static_assert(WS_WT_END <= 56 * MiB, "weights region");
constexpr size_t WS_MEMN = 56 * MiB;
constexpr size_t WS_MEMKV = 60 * MiB;
constexpr size_t WS_HM = 72 * MiB;
constexpr size_t WS_R = 264 * MiB;
constexpr size_t WS_Q = WS_R + 160 * MiB;
constexpr size_t WS_KV = WS_Q + 192 * MiB;
constexpr size_t WS_END = WS_KV + 256 * MiB;

struct Params { const float* in[21]; float* out; unsigned char* ws; int ph_lo, ph_hi; };

__device__ __forceinline__ float bf2f(bf16_t v) { return __uint_as_float(((unsigned)v) << 16); }
__device__ __forceinline__ bf16_t f2bf(float f) { unsigned u = __float_as_uint(f); u += 0x7FFFu + ((u >> 16) & 1u); return (bf16_t)(u >> 16); }
__device__ __forceinline__ unsigned cvtpk(float lo, float hi) { unsigned r; asm volatile("v_cvt_pk_bf16_f32 %0, %1, %2" : "=v"(r) : "v"(lo), "v"(hi)); return r; }
__device__ __forceinline__ float wave_sum(float v) {
#pragma unroll
  for (int o = 32; o > 0; o >>= 1) v += __shfl_xor(v, o, 64);
  return v;
}

__device__ __forceinline__ int opaque_tid() { int t = threadIdx.x; asm volatile("" : "+v"(t)); return t; }

namespace pg8 {
constexpr int BM = 256, BK = 64, HALF = 128, HTB = HALF * BK * 2, STAGE_BYTES = 8 * HTB, NXCD = 8, WGM = 8;
__device__ __forceinline__ int lds_byte(int r, int c) { const int st = (r >> 4) * 2 + (c >> 5), rr = r & 15, cc = c & 31, ob = rr * 64 + cc * 2; return st * 1024 + (ob ^ (((ob >> 9) & 1) << 5)); }
__device__ __forceinline__ void stage_rc(int b, int& R, int& C) { const int st = b / 1024, sb = b % 1024, swz = sb ^ (((sb >> 9) & 1) << 5); R = (st >> 1) * 16 + swz / 64; C = (st & 1) * 32 + (swz % 64) / 2; }
__device__ __forceinline__ int perm32(int rho) { const int n = rho >> 4, i = rho & 15; return 8 * (i >> 2) + 4 * n + (i & 3); }
struct Unit { int pm, pn; };
struct Gemm { const bf16_t* A; const bf16_t* Bt; int M, N, K, lda; };
struct StaticOrder {
  int nM, nN, nwg, G, c;
  __device__ void init(int M, int N, int G_, int c_) { nM = M / BM; nN = N / BM; nwg = nM * nN; G = G_; c = c_; }
  __device__ bool next(int i, Unit& u) const {
    const long L = (long)i * G + c; if (L >= nwg) return false;
    int wgid = (int)L; { const int q = nwg / NXCD, r = nwg % NXCD, xcd = wgid % NXCD, off = wgid / NXCD; wgid = (xcd < r ? xcd * (q + 1) : r * (q + 1) + (xcd - r) * q) + off; }
    const int nig = WGM * nN, gid = wgid / nig, fm = gid * WGM, gsz = (nM - fm) < WGM ? (nM - fm) : WGM;
    u.pm = fm + ((wgid % nig) % gsz); u.pn = (wgid % nig) / gsz; return true;
  }
};

struct EpiBf16 {
  static constexpr bool PERM = true;
  bf16_t* O; int ldc;
  __device__ __forceinline__ void operator()(const f32x4 (&acc)[2][2][4][2], const Unit& u, int wr, int wc, int fr, int fq) const {
    const int row0 = u.pm * BM + wr * 64 + fr, col0 = u.pn * BM + wc * 32 + 8 * fq;
#pragma unroll
    for (int ai = 0; ai < 2; ++ai)
#pragma unroll
      for (int m = 0; m < 4; ++m) { bf16_t* rowp = O + (size_t)(row0 + ai * HALF + m * 16) * ldc + col0;
#pragma unroll
        for (int bj = 0; bj < 2; ++bj) { const f32x4 v0 = acc[ai][bj][m][0], v1 = acc[ai][bj][m][1];
          u32x4 w; w.x = cvtpk(v0[0], v0[1]); w.y = cvtpk(v0[2], v0[3]); w.z = cvtpk(v1[0], v1[1]); w.w = cvtpk(v1[2], v1[3]);
          *(u32x4*)(rowp + bj * HALF) = w; } }
  }
};
struct EpiResF32 {
  static constexpr bool PERM = false;
  float* out; const float* res;
  __device__ __forceinline__ void operator()(const f32x4 (&acc)[2][2][4][2], const Unit& u, int wr, int wc, int fr, int fq) const {
    const int row0 = u.pm * BM + wr * 64 + fr, col0 = u.pn * BM + wc * 32 + 4 * fq;
#pragma unroll
    for (int ai = 0; ai < 2; ++ai)
#pragma unroll
      for (int m = 0; m < 4; ++m) { const size_t off = (size_t)(row0 + ai * HALF + m * 16) * DM + col0;
#pragma unroll
        for (int bj = 0; bj < 2; ++bj)
#pragma unroll
          for (int n = 0; n < 2; ++n) { const f32x4 r = *(const f32x4*)(res + off + bj * HALF + n * 16); *(f32x4*)(out + off + bj * HALF + n * 16) = r + acc[ai][bj][m][n]; } }
  }
};
struct EpiSwiGLU {
  static constexpr bool PERM = true;
  bf16_t* O;
  __device__ __forceinline__ void operator()(const f32x4 (&acc)[2][2][4][2], const Unit& u, int wr, int wc, int fr, int fq) const {
    const int row0 = u.pm * BM + wr * 64 + fr, col0 = u.pn * HALF + wc * 32 + 8 * fq;
#pragma unroll
    for (int ai = 0; ai < 2; ++ai)
#pragma unroll
      for (int m = 0; m < 4; ++m) { bf16_t* rowp = O + (size_t)(row0 + ai * HALF + m * 16) * DFF + col0;
        float y[8];
#pragma unroll
        for (int n = 0; n < 2; ++n)
#pragma unroll
          for (int j = 0; j < 4; ++j) { const float g = acc[ai][0][m][n][j], up = acc[ai][1][m][n][j];
            const float e = __builtin_amdgcn_exp2f(-g * 1.4426950408889634f);
            y[n * 4 + j] = g * __builtin_amdgcn_rcpf(1.0f + e) * up; }
        u32x4 w; w.x = cvtpk(y[0], y[1]); w.y = cvtpk(y[2], y[3]); w.z = cvtpk(y[4], y[5]); w.w = cvtpk(y[6], y[7]);
        *(u32x4*)rowp = w; }
  }
};

template <class Epi>
__device__ __forceinline__ void gemm_phase(LAS unsigned char* lds, const Gemm g, const StaticOrder& S, const Epi& E) {
  const int tid = opaque_tid(), wid = __builtin_amdgcn_readfirstlane(tid >> 6), lane = tid & 63, wr = wid >> 2, wc = wid & 3, fr = lane & 15, fq = lane >> 4;
  const int K = g.K, nt = K / BK, lda = g.lda;
  unsigned voffA[2], voffB[2];
#pragma unroll
  for (int i = 0; i < 2; ++i) { int R, C; stage_rc(tid * 16 + i * 8192, R, C); const int Rb = Epi::PERM ? ((R & ~31) + perm32(R & 31)) : R;
    voffA[i] = (unsigned)(R * lda + C) * 2u; voffB[i] = (unsigned)(Rb * K + C) * 2u; }
  const size_t kstep = (size_t)(BK * 2);
  const size_t hstepA = (size_t)HALF * lda * 2, hstepB = (size_t)HALF * K * 2;
  const size_t tstepA = 2 * hstepA, tstepB = 2 * hstepB;
  const unsigned ldsw = (unsigned)wid * 1024u;
  const int aoff = lds_byte(wr * 64 + fr, fq * 8), boff = lds_byte(wc * 32 + fr, fq * 8);
#define PG8_SA(b, h) (((b) * 2 + (h)) * HTB)
#define PG8_SB(b, h) ((4 + (b) * 2 + (h)) * HTB)
#define PG8_STAGE(bufoff, gbase, voff) do { _Pragma("unroll") for (int _i = 0; _i < 2; ++_i) \
    __builtin_amdgcn_global_load_lds((const unsigned*)((const char*)(gbase) + (voff)[_i]), (LAS unsigned*)(lds + (bufoff) + ldsw + _i * 8192), 16, 0, 0); } while (0)
#define PG8_LDA(dst, b, h) do { _Pragma("unroll") for (int m = 0; m < 4; ++m) _Pragma("unroll") for (int k = 0; k < 2; ++k) dst[m][k] = *(const LAS bf16x8*)(lds + PG8_SA(b, h) + aoff + m * 2048 + k * 1024); } while (0)
#define PG8_LDB(dst, b, h) do { _Pragma("unroll") for (int n = 0; n < 2; ++n) _Pragma("unroll") for (int k = 0; k < 2; ++k) dst[n][k] = *(const LAS bf16x8*)(lds + PG8_SB(b, h) + boff + n * 2048 + k * 1024); } while (0)
#define PG8_MMA(ai, bj, At, Bt) do { __builtin_amdgcn_s_setprio(1); _Pragma("unroll") for (int m = 0; m < 4; ++m) _Pragma("unroll") for (int n = 0; n < 2; ++n) _Pragma("unroll") for (int k = 0; k < 2; ++k) \
    acc[ai][bj][m][n] = __builtin_amdgcn_mfma_f32_16x16x32_bf16(Bt[n][k], At[m][k], acc[ai][bj][m][n], 0, 0, 0); __builtin_amdgcn_s_setprio(0); } while (0)
#define PG8_WAIT_V(n) asm volatile("s_waitcnt vmcnt(" #n ")" ::: "memory")
#define PG8_WAIT_L(n) asm volatile("s_waitcnt lgkmcnt(" #n ")" ::: "memory")
#define PG8_BAR __builtin_amdgcn_s_barrier()
#define PG8_SCHED __builtin_amdgcn_sched_barrier(0)
  Unit cur, nxt; int ui = 0;
  if (!S.next(0, cur)) return;
  f32x4 acc[2][2][4][2];
#pragma unroll
  for (int a = 0; a < 2; ++a)
#pragma unroll
    for (int b = 0; b < 2; ++b)
#pragma unroll
      for (int m = 0; m < 4; ++m)
#pragma unroll
        for (int n = 0; n < 2; ++n) acc[a][b][m][n] = (f32x4){0.f, 0.f, 0.f, 0.f};
  bf16x8 At[4][2], B0[2][2], B1[2][2];
  const char* cA = (const char*)g.A + (size_t)cur.pm * tstepA; const char* cB = (const char*)g.Bt + (size_t)cur.pn * tstepB;
  PG8_STAGE(PG8_SB(0, 0), cB, voffB); PG8_STAGE(PG8_SA(0, 0), cA, voffA); PG8_STAGE(PG8_SB(0, 1), cB + hstepB, voffB); PG8_STAGE(PG8_SA(0, 1), cA + hstepA, voffA);
  if (wr == 1) PG8_BAR;
  PG8_WAIT_V(4); PG8_BAR;
  PG8_STAGE(PG8_SB(1, 0), cB + kstep, voffB); PG8_STAGE(PG8_SA(1, 0), cA + kstep, voffA); PG8_STAGE(PG8_SB(1, 1), cB + hstepB + kstep, voffB);
  PG8_WAIT_V(6); PG8_BAR;
  for (;;) {
    const bool has_next = S.next(ui + 1, nxt);
    const char* nA = has_next ? (const char*)g.A + (size_t)nxt.pm * tstepA : cA; const char* nB = has_next ? (const char*)g.Bt + (size_t)nxt.pn * tstepB : cB;
    for (int t = 0; t < nt; t += 2) {
      const bool last = (t == nt - 2);
      const char* a1 = cA + (size_t)(t + 1) * kstep;
      const char* a2 = last ? nA : cA + (size_t)(t + 2) * kstep; const char* b2 = last ? nB : cB + (size_t)(t + 2) * kstep;
      const char* a3 = a2 + kstep; const char* b3 = b2 + kstep;
      PG8_LDB(B0, 0, 0); PG8_SCHED; PG8_LDA(At, 0, 0); PG8_STAGE(PG8_SA(1, 1), a1 + hstepA, voffA);
      PG8_WAIT_L(8); PG8_BAR; PG8_WAIT_L(0); PG8_MMA(0, 0, At, B0); PG8_BAR; PG8_SCHED;
      PG8_LDB(B1, 0, 1); PG8_STAGE(PG8_SB(0, 0), b2, voffB);
      PG8_BAR; PG8_WAIT_L(0); PG8_MMA(0, 1, At, B1); PG8_BAR;
      PG8_LDA(At, 0, 1); PG8_STAGE(PG8_SA(0, 0), a2, voffA);
      PG8_BAR; PG8_WAIT_L(0); PG8_MMA(1, 0, At, B0); PG8_BAR; PG8_SCHED;
      PG8_STAGE(PG8_SB(0, 1), b2 + hstepB, voffB);
      PG8_WAIT_V(6); PG8_BAR; PG8_MMA(1, 1, At, B1); PG8_BAR;
      PG8_LDB(B0, 1, 0); PG8_SCHED; PG8_LDA(At, 1, 0); PG8_STAGE(PG8_SA(0, 1), a2 + hstepA, voffA);
      PG8_WAIT_L(8); PG8_BAR; PG8_WAIT_L(0); PG8_MMA(0, 0, At, B0); PG8_BAR; PG8_SCHED;
      PG8_LDB(B1, 1, 1); PG8_STAGE(PG8_SB(1, 0), b3, voffB);
      PG8_BAR; PG8_WAIT_L(0); PG8_MMA(0, 1, At, B1); PG8_BAR;
      PG8_LDA(At, 1, 1); PG8_STAGE(PG8_SA(1, 0), a3, voffA);
      PG8_BAR; PG8_WAIT_L(0); PG8_MMA(1, 0, At, B0); PG8_BAR; PG8_SCHED;
      PG8_STAGE(PG8_SB(1, 1), b3 + hstepB, voffB);
      PG8_WAIT_V(6); PG8_BAR; PG8_MMA(1, 1, At, B1); PG8_BAR;
    }
    E(acc, cur, wr, wc, fr, fq);
    if (!has_next) break;
#pragma unroll
    for (int a = 0; a < 2; ++a)
#pragma unroll
      for (int b = 0; b < 2; ++b)
#pragma unroll
        for (int m = 0; m < 4; ++m)
#pragma unroll
          for (int n = 0; n < 2; ++n) acc[a][b][m][n] = (f32x4){0.f, 0.f, 0.f, 0.f};
    cur = nxt; cA = nA; cB = nB; ++ui;
  }
  PG8_WAIT_V(0);
  if (wr == 0) PG8_BAR;
  PG8_BAR;
#undef PG8_SA
#undef PG8_SB
#undef PG8_STAGE
#undef PG8_LDA
#undef PG8_LDB
#undef PG8_MMA
#undef PG8_WAIT_V
#undef PG8_WAIT_L
#undef PG8_BAR
#undef PG8_SCHED
}
template <class Epi>
__device__ __forceinline__ void run_gemm(LAS unsigned char* lds, const bf16_t* A, int lda, const bf16_t* Bt, int M, int N, int K, const Epi& E, int coff) {
  Gemm g{A, Bt, M, N, K, lda};
  StaticOrder S; S.init(M, N, (int)gridDim.x, (int)((blockIdx.x + coff) % gridDim.x));
  gemm_phase<Epi>(lds, g, S, E);
}
}

namespace att {
constexpr int NW = 8, QBLK = 32, KVBLK = 64;
constexpr float THR = 8.f;
constexpr int SHM_V = KVBLK * 128 * 2, SHM_K = KVBLK * 128 * 2, SHM_K2 = KVBLK * 64 * 2;
constexpr int OFF_K = 2 * SHM_V, OFF_K2 = OFF_K + 2 * SHM_K, OFF_WS = OFF_K2 + 2 * SHM_K2, OFF_Q2 = OFF_WS + NW * 64 * 4, SHM_ATTN = OFF_Q2 + 32768;
#define KSWZ(row, colB) ((row) * 256 + ((colB) ^ (((row) & 7) << 4)))
#define K2SWZ(row, colB) ((row) * 128 + ((colB) ^ ((((row) >> 1) & 7) << 4)))
#define SBAR() __builtin_amdgcn_sched_barrier(0)
__device__ __forceinline__ int crow(int r, int hi) { return (r & 3) + 8 * (r >> 2) + 4 * hi; }
__device__ __forceinline__ void partialSM(f32x16& p0, f32x16& p1, float& m_reg, float& mn, float& alpha, float C, float thr_s) {
  float pmax = p0[0];
#pragma unroll
  for (int r = 1; r < 16; ++r) pmax = fmaxf(pmax, p0[r]);
#pragma unroll
  for (int r = 0; r < 16; ++r) pmax = fmaxf(pmax, p1[r]);
  { auto rr = __builtin_amdgcn_permlane32_swap(__float_as_uint(pmax), __float_as_uint(pmax), false, false);
    pmax = fmaxf(__uint_as_float(rr[0]), __uint_as_float(rr[1])); }
  if (__builtin_expect(__all(pmax - m_reg <= thr_s), 1)) { mn = m_reg; alpha = 1.f; }
  else { mn = fmaxf(m_reg, pmax); alpha = __builtin_amdgcn_exp2f((m_reg - mn) * C); m_reg = mn; }
  float mnC = -mn * C;
#pragma unroll
  for (int r = 0; r < 16; ++r) p0[r] = fmaf(p0[r], C, mnC);
#pragma unroll
  for (int r = 0; r < 16; ++r) p1[r] = fmaf(p1[r], C, mnC);
#pragma unroll
  for (int r = 0; r < 16; ++r) p0[r] = __builtin_amdgcn_exp2f(p0[r]);
}
__device__ __forceinline__ void finishSM(f32x16& p0, f32x16& p1, float alpha, float& l_reg, bf16x8& pa0, bf16x8& pa1, bf16x8& pa2, bf16x8& pa3) {
#pragma unroll
  for (int r = 0; r < 16; ++r) p1[r] = __builtin_amdgcn_exp2f(p1[r]);
  float ps = 0;
#pragma unroll
  for (int r = 0; r < 16; ++r) ps += p0[r];
#pragma unroll
  for (int r = 0; r < 16; ++r) ps += p1[r];
  { auto rr = __builtin_amdgcn_permlane32_swap(__float_as_uint(ps), __float_as_uint(ps), false, false);
    ps = __uint_as_float(rr[0]) + __uint_as_float(rr[1]); }
  l_reg = l_reg * alpha + ps;
#define PK4(P, BASE, OUT) do { unsigned a0 = cvtpk(P[BASE + 0], P[BASE + 1]), a1 = cvtpk(P[BASE + 2], P[BASE + 3]);   \
    unsigned b0 = cvtpk(P[BASE + 4], P[BASE + 5]), b1 = cvtpk(P[BASE + 6], P[BASE + 7]);                              \
    auto r0 = __builtin_amdgcn_permlane32_swap(a0, b0, false, false); auto r1 = __builtin_amdgcn_permlane32_swap(a1, b1, false, false); \
    u32x4 w = {r0[0], r1[0], r0[1], r1[1]}; OUT = *reinterpret_cast<bf16x8*>(&w); } while (0)
  PK4(p0, 0, pa0); PK4(p0, 8, pa1); PK4(p1, 0, pa2); PK4(p1, 8, pa3);
#undef PK4
}
template <int DQK>
__device__ __forceinline__ void qkt(f32x16& p0, f32x16& p1, const char* Ks, const char* K2s, const bf16x8* qr, const char* q2l, int r32, int hi) {
#pragma unroll
  for (int r = 0; r < 16; ++r) { p0[r] = 0.f; p1[r] = 0.f; }
#pragma unroll
  for (int d0 = 0; d0 < 8; ++d0) { int cb = (d0 * 16 + hi * 8) * 2;
    bf16x8 b0 = *reinterpret_cast<const bf16x8*>(Ks + KSWZ(r32, cb));
    bf16x8 b1 = *reinterpret_cast<const bf16x8*>(Ks + KSWZ(32 + r32, cb));
    p0 = __builtin_amdgcn_mfma_f32_32x32x16_bf16(b0, qr[d0], p0, 0, 0, 0);
    p1 = __builtin_amdgcn_mfma_f32_32x32x16_bf16(b1, qr[d0], p1, 0, 0, 0); }
  if constexpr (DQK == 192) {
#pragma unroll
    for (int d0 = 0; d0 < 4; ++d0) { int cb = (d0 * 16 + hi * 8) * 2;
      bf16x8 b0 = *reinterpret_cast<const bf16x8*>(K2s + K2SWZ(r32, cb));
      bf16x8 b1 = *reinterpret_cast<const bf16x8*>(K2s + K2SWZ(32 + r32, cb));
      const bf16x8 q2 = *reinterpret_cast<const bf16x8*>(q2l + d0 * 1024);
      p0 = __builtin_amdgcn_mfma_f32_32x32x16_bf16(b0, q2, p0, 0, 0, 0);
      p1 = __builtin_amdgcn_mfma_f32_32x32x16_bf16(b1, q2, p1, 0, 0, 0); }
  }
}
__device__ __forceinline__ int v_st(int k, int c) { const int kk = (k & ~0xC) | ((k & 4) << 1) | ((k & 8) >> 1); return ((kk >> 3) * 4 + (c >> 5)) * 512 + ((kk & 7) * 32 + (c & 31)) * 2; }
__device__ __forceinline__ int v_rd_base(int lane) { return ((lane & 3) << 3) | (((lane >> 2) & 3) << 6) | (((lane >> 4) & 1) << 5) | (((lane >> 5) & 1) << 8); }
constexpr int v_rd_off(int d0, int ks, int half) { return d0 * 512 + ks * 4096 + half * 2048; }
template <int OFF> __device__ __forceinline__ s16x4 tr_read(int vb) {
  s16x4 r; asm volatile("ds_read_b64_tr_b16 %0, %1 offset:%2" : "=&v"(r) : "v"(vb), "i"(OFF) : "memory"); return r;
}
template <int D0> __device__ __forceinline__ void pv_one(f32x16& od, int vb, bf16x8 pa0, bf16x8 pa1, bf16x8 pa2, bf16x8 pa3) {
  const s16x4 l0 = tr_read<v_rd_off(D0, 0, 0)>(vb), h0 = tr_read<v_rd_off(D0, 0, 1)>(vb), l1 = tr_read<v_rd_off(D0, 1, 0)>(vb), h1 = tr_read<v_rd_off(D0, 1, 1)>(vb);
  const s16x4 l2 = tr_read<v_rd_off(D0, 2, 0)>(vb), h2 = tr_read<v_rd_off(D0, 2, 1)>(vb), l3 = tr_read<v_rd_off(D0, 3, 0)>(vb), h3 = tr_read<v_rd_off(D0, 3, 1)>(vb);
  asm volatile("s_waitcnt lgkmcnt(0)" ::: "memory"); SBAR();
#define PK(L, H) (bf16x8){L[0], L[1], L[2], L[3], H[0], H[1], H[2], H[3]}
  od = __builtin_amdgcn_mfma_f32_32x32x16_bf16(pa0, PK(l0, h0), od, 0, 0, 0);
  od = __builtin_amdgcn_mfma_f32_32x32x16_bf16(pa1, PK(l1, h1), od, 0, 0, 0);
  od = __builtin_amdgcn_mfma_f32_32x32x16_bf16(pa2, PK(l2, h2), od, 0, 0, 0);
  od = __builtin_amdgcn_mfma_f32_32x32x16_bf16(pa3, PK(l3, h3), od, 0, 0, 0);
#undef PK
}
__device__ __forceinline__ void pv_d0(f32x16* o, int vb, bf16x8 pa0, bf16x8 pa1, bf16x8 pa2, bf16x8 pa3) {
  pv_one<0>(o[0], vb, pa0, pa1, pa2, pa3); pv_one<1>(o[1], vb, pa0, pa1, pa2, pa3); pv_one<2>(o[2], vb, pa0, pa1, pa2, pa3); pv_one<3>(o[3], vb, pa0, pa1, pa2, pa3);
}

template <int DQK, int SDEPTH>
__device__ __forceinline__ void attn_body(const bf16_t* __restrict__ Qb, const bf16_t* __restrict__ Q2b, int ldq, const bf16_t* __restrict__ Kh, int ldk, const bf16_t* __restrict__ K2h, int ldk2,
                                          const bf16_t* __restrict__ Vh, int ldv, bf16_t* __restrict__ Ob, int ldo, int seq, float scale, char* lds) {
  constexpr int ND = 8;
  const int tid = opaque_tid(), wid = tid >> 6, lane = tid & 63, r32 = lane & 31, hi = lane >> 5;
  const float C = scale * 1.4426950408889634f, thr_s = THR / scale;
  char* V_lds = lds; char* K_lds = lds + OFF_K; char* K2_lds = lds + OFF_K2;
  float* ws = (float*)(lds + OFF_WS) + wid * 64; float* li_l = ws; float* al_l = ws + 32;
  float m_reg = -1e30f, l_reg = 0; f32x16 o[4]; bf16x8 qr[ND];
#pragma unroll
  for (int d = 0; d < 4; ++d)
#pragma unroll
    for (int r = 0; r < 16; ++r) o[d][r] = 0.f;
  const bf16_t* Qw = Qb + (long)(wid * QBLK + r32) * ldq + hi * 8;
#pragma unroll
  for (int d0 = 0; d0 < ND; ++d0) qr[d0] = *reinterpret_cast<const bf16x8*>(Qw + d0 * 16);
  char* q2l = lds + OFF_Q2 + (wid * 4 * 64 + lane) * 16;
  __syncthreads();
  if constexpr (DQK == 192) {
#pragma unroll
    for (int d0 = 0; d0 < 4; ++d0) *reinterpret_cast<bf16x8*>(q2l + d0 * 1024) = *reinterpret_cast<const bf16x8*>(Q2b + (long)(wid * QBLK + r32) * ldq + hi * 8 + d0 * 16);
  }
  const int sr = tid >> 4, sc = (tid & 15) * 8, vst0 = v_st(sr, sc), vst1 = v_st(32 + sr, sc);
  const int sr2 = tid >> 3, sc2 = (tid & 7) * 8;
  const unsigned voffV = (unsigned)(sr * ldv + sc) * 2u, voffK = (unsigned)(sr * ldk + sc) * 2u, voffK2 = (unsigned)(sr2 * ldk2 + sc2) * 2u;
  const size_t tsV = (size_t)ldv * 2, tsK = (size_t)ldk * 2, tsK2 = (size_t)ldk2 * 2;
  const int vb0 = (int)(uintptr_t)V_lds + v_rd_base(lane);
  struct { bf16x8 vs0, vs1, ks0, ks1, k2; } sr_[SDEPTH];
#define SLOAD(i, k0) do { const char* vb_ = (const char*)Vh + (size_t)(k0) * tsV; const char* kb_ = (const char*)Kh + (size_t)(k0) * tsK; \
    sr_[i].vs0 = *(const bf16x8*)(vb_ + voffV); sr_[i].vs1 = *(const bf16x8*)(vb_ + 32 * tsV + voffV); \
    sr_[i].ks0 = *(const bf16x8*)(kb_ + voffK); sr_[i].ks1 = *(const bf16x8*)(kb_ + 32 * tsK + voffK); \
    if constexpr (DQK == 192) sr_[i].k2 = *(const bf16x8*)((const char*)K2h + (size_t)(k0) * tsK2 + voffK2); } while (0)
#define SWRITE(b, i) do { *(bf16x8*)(V_lds + (b) * SHM_V + vst0) = sr_[i].vs0;          \
    *(bf16x8*)(V_lds + (b) * SHM_V + vst1) = sr_[i].vs1; int kc = sc * 2;               \
    *(bf16x8*)(K_lds + (b) * SHM_K + KSWZ(sr, kc)) = sr_[i].ks0;                       \
    *(bf16x8*)(K_lds + (b) * SHM_K + KSWZ(32 + sr, kc)) = sr_[i].ks1;                  \
    if constexpr (DQK == 192) *(bf16x8*)(K2_lds + (b) * SHM_K2 + K2SWZ(sr2, sc2 * 2)) = sr_[i].k2; } while (0)
#define SWAIT() do { if constexpr (SDEPTH == 1) asm volatile("s_waitcnt vmcnt(0)" ::: "memory"); else if constexpr (DQK == 192) asm volatile("s_waitcnt vmcnt(5)" ::: "memory"); else asm volatile("s_waitcnt vmcnt(4)" ::: "memory"); } while (0)
#define RESC(a) do { if (__any((a) < 1.f)) { if (hi == 0) al_l[r32] = (a); asm volatile("s_waitcnt lgkmcnt(0)" ::: "memory"); \
    _Pragma("unroll") for (int d = 0; d < 4; ++d) _Pragma("unroll") for (int r = 0; r < 16; ++r) o[d][r] *= al_l[crow(r, hi)]; } } while (0)
  f32x16 pA0, pA1, pB0, pB1; float mnA, mnB, alA, alB; bf16x8 pa0, pa1, pa2, pa3; const int NT = seq / KVBLK;
  constexpr int SE = 0, SO = SDEPTH - 1;
  SLOAD(SE, 0); asm volatile("s_waitcnt vmcnt(0)" ::: "memory"); SWRITE(0, SE); __syncthreads();
  qkt<DQK>(pA0, pA1, K_lds, K2_lds, qr, q2l, r32, hi); partialSM(pA0, pA1, m_reg, mnA, alA, C, thr_s);
  SLOAD(SO, KVBLK); if constexpr (SDEPTH == 2) { if (2 < NT) SLOAD(SE, 2 * KVBLK); }
  SWAIT(); SWRITE(1, SO); __syncthreads();
  for (int j = 1; j + 1 < NT; j += 2) {
    SBAR(); qkt<DQK>(pB0, pB1, K_lds + SHM_K, K2_lds + SHM_K2, qr, q2l, r32, hi);
    finishSM(pA0, pA1, alA, l_reg, pa0, pa1, pa2, pa3); SBAR();
    SLOAD(SO, (j + SDEPTH) * KVBLK); SBAR();
    pv_d0(o, vb0, pa0, pa1, pa2, pa3); partialSM(pB0, pB1, m_reg, mnB, alB, C, thr_s);
    __syncthreads(); SWAIT(); SWRITE(0, SE);
    RESC(alB); __syncthreads();
    SBAR(); qkt<DQK>(pA0, pA1, K_lds, K2_lds, qr, q2l, r32, hi);
    finishSM(pB0, pB1, alB, l_reg, pa0, pa1, pa2, pa3); SBAR();
    if (SDEPTH == 1 || j + 3 < NT) SLOAD(SE, (j + 1 + SDEPTH) * KVBLK); SBAR();
    pv_d0(o, vb0 + SHM_V, pa0, pa1, pa2, pa3); partialSM(pA0, pA1, m_reg, mnA, alA, C, thr_s);
    __syncthreads(); SWAIT(); SWRITE(1, SO);
    RESC(alA); __syncthreads();
  }
  SBAR(); qkt<DQK>(pB0, pB1, K_lds + SHM_K, K2_lds + SHM_K2, qr, q2l, r32, hi);
  finishSM(pA0, pA1, alA, l_reg, pa0, pa1, pa2, pa3); SBAR();
  pv_d0(o, vb0, pa0, pa1, pa2, pa3); partialSM(pB0, pB1, m_reg, mnB, alB, C, thr_s);
  __syncthreads(); RESC(alB);
  finishSM(pB0, pB1, alB, l_reg, pa0, pa1, pa2, pa3); SBAR();
  pv_d0(o, vb0 + SHM_V, pa0, pa1, pa2, pa3);
  if (hi == 0) li_l[r32] = l_reg; asm volatile("s_waitcnt lgkmcnt(0)" ::: "memory");
  float rli[16];
#pragma unroll
  for (int r = 0; r < 16; ++r) rli[r] = __builtin_amdgcn_rcpf(li_l[crow(r, hi)]);
  bf16_t* Ow = Ob + (long)(wid * QBLK) * ldo;
#pragma unroll
  for (int r = 0; r < 16; ++r) { int orow = crow(r, hi);
#pragma unroll
    for (int d0 = 0; d0 < 4; ++d0) Ow[(long)orow * ldo + d0 * 32 + r32] = f2bf(o[d0][r] * rli[r]); }
#undef SLOAD
#undef SWRITE
#undef SWAIT
#undef RESC
}
struct AttnJob { const bf16_t* Q; const bf16_t* Q2; int ldq, qhs; const bf16_t* K; int ldk, khs; long kbs; const bf16_t* K2; int ldk2; const bf16_t* V; int ldv; bf16_t* O; int H, gshift, seq, nunits; float scale; };
template <int DQK, int SDEPTH>
__device__ __forceinline__ void run_attn(const AttnJob& a, char* lds) {
  for (int u = blockIdx.x; u < a.nunits; u += gridDim.x) {
    const int per_b = a.H * 32, b = u / per_b, rest = u - b * per_b, h = rest % a.H, qb = rest / a.H, kh = h >> a.gshift;
    const long tok0 = (long)b * SEQ + qb * 256;
    attn_body<DQK, SDEPTH>(a.Q + tok0 * a.ldq + h * a.qhs, a.Q2 + tok0 * a.ldq + h * 64, a.ldq, a.K + (long)b * a.kbs + kh * a.khs, a.ldk, a.K2 + (long)b * SEQ * a.ldk2, a.ldk2,
                           a.V + (long)b * a.kbs + kh * a.khs, a.ldv, a.O + tok0 * 1536 + h * 128, 1536, a.seq, a.scale, lds);
  }
}
}

__device__ __forceinline__ void rms_rows(const float* __restrict__ src, const float* __restrict__ gain, bf16_t* __restrict__ dst, int nrows) {
  const int tid_ = opaque_tid(), wid = tid_ >> 6, lane = tid_ & 63;
  for (int row = blockIdx.x * 8 + wid; row < nrows; row += gridDim.x * 8) {
    const f32x4* s = (const f32x4*)(src + (size_t)row * DM);
    f32x4 v[4]; float ss = 0.f;
#pragma unroll
    for (int j = 0; j < 4; ++j) { v[j] = s[lane + 64 * j]; ss += v[j][0] * v[j][0] + v[j][1] * v[j][1] + v[j][2] * v[j][2] + v[j][3] * v[j][3]; }
    ss = wave_sum(ss);
    const float rs = rsqrtf(ss * (1.f / DM) + EPS);
#pragma unroll
    for (int j = 0; j < 4; ++j) { const f32x4 g = ((const f32x4*)gain)[lane + 64 * j];
      u32x2 w; w.x = cvtpk(v[j][0] * rs * g[0], v[j][1] * rs * g[1]); w.y = cvtpk(v[j][2] * rs * g[2], v[j][3] * rs * g[3]);
      *(u32x2*)(dst + (size_t)row * DM + (lane + 64 * j) * 4) = w; }
  }
}
template <int MODE>
__device__ __forceinline__ void prep_w(const float* __restrict__ src, int K, int Nsrc, bf16_t* __restrict__ dst, int Ndst, const float* __restrict__ kgain) {
  const long total = (long)Ndst * (K / 8);
  for (long i = (long)blockIdx.x * 512 + opaque_tid(); i < total; i += (long)gridDim.x * 512) {
    const int n = (int)(i % Ndst), k8 = (int)(i / Ndst);
    int ns = n;
    if (MODE == 1) { const int pn = n >> 8, r = n & 255, bj = r >> 7, ii = r & 127; ns = bj * DFF + pn * 128 + ii; }
    if (MODE == 2) { ns = n < 640 ? n : (n < 1152 ? n + 64 : (n < 1216 ? n - 512 : Nsrc)); }
    if (MODE == 3) { ns = n < 1024 ? (n >> 7) * 192 + (n & 127) : ((n - 1024) >> 6) * 192 + 128 + ((n - 1024) & 63); }
    float x[8];
#pragma unroll
    for (int j = 0; j < 8; ++j) x[j] = (ns < Nsrc) ? src[(size_t)(k8 * 8 + j) * Nsrc + ns] : 0.f;
    if (kgain) {
#pragma unroll
      for (int j = 0; j < 8; ++j) x[j] *= kgain[k8 * 8 + j];
    }
    u32x4 w; w.x = cvtpk(x[0], x[1]); w.y = cvtpk(x[2], x[3]); w.z = cvtpk(x[4], x[5]); w.w = cvtpk(x[6], x[7]);
    *(u32x4*)(dst + (size_t)n * K + k8 * 8) = w;
  }
}
__device__ __forceinline__ void unpack8(u32x4 w, float* v) {
#pragma unroll
  for (int i = 0; i < 4; ++i) { v[2 * i] = __uint_as_float(w[i] << 16); v[2 * i + 1] = __uint_as_float(w[i] & 0xffff0000u); }
}
__device__ __forceinline__ u32x4 pack8(const float* v) { u32x4 w; w.x = cvtpk(v[0], v[1]); w.y = cvtpk(v[2], v[3]); w.z = cvtpk(v[4], v[5]); w.w = cvtpk(v[6], v[7]); return w; }
__device__ __forceinline__ float sumsq8(const float* v) { float s = 0.f;
#pragma unroll
  for (int j = 0; j < 8; ++j) s += v[j] * v[j];
  return s; }
template <int GL> __device__ __forceinline__ float group_sum(float s) {
#pragma unroll
  for (int o = 1; o < GL; o <<= 1) s += __shfl_xor(s, o, 64);
  return s;
}
__device__ __forceinline__ void load8(float* g, const float* __restrict__ p) { const f32x4 a = *(const f32x4*)p, b = *(const f32x4*)(p + 4);
  g[0] = a[0]; g[1] = a[1]; g[2] = a[2]; g[3] = a[3]; g[4] = b[0]; g[5] = b[1]; g[6] = b[2]; g[7] = b[3]; }
template <int GL> __device__ __forceinline__ void norm8(float* v, const float* g) {
  const float ss = group_sum<GL>(sumsq8(v)); const float rs = rsqrtf(ss * (1.f / (GL * 8)) + EPS);
#pragma unroll
  for (int j = 0; j < 8; ++j) v[j] *= rs * g[j];
}
template <int XM> __device__ __forceinline__ void rope8(float* v, const float* inv, float pos, bool first) {
#pragma unroll
  for (int j = 0; j < 8; ++j) {
    const float partner = __shfl_xor(v[j], XM, 64);
    float rev = pos * inv[j] * INV2PI; rev -= floorf(rev);
    const float c = __builtin_amdgcn_cosf(rev), s = __builtin_amdgcn_sinf(rev);
    v[j] = first ? v[j] * c - partner * s : v[j] * c + partner * s;
  }
}
template <int NE> __device__ __forceinline__ void ld_seg(float* v, const bf16_t* p, int lane) {
#pragma unroll
  for (int j = 0; j < NE; ++j) v[j] = bf2f(p[lane + 64 * j]);
}
template <int NE> __device__ __forceinline__ void st_seg(const float* v, bf16_t* p, int lane) {
#pragma unroll
  for (int j = 0; j < NE; ++j) p[lane + 64 * j] = f2bf(v[j]);
}
template <int NE, int ROPE> __device__ __forceinline__ void norm_seg(float* v, const float* __restrict__ gain, int lane, int prow, int pcol) {
  float ss = 0.f;
#pragma unroll
  for (int j = 0; j < NE; ++j) ss += v[j] * v[j];
  ss = wave_sum(ss);
  const float rs = rsqrtf(ss * (1.f / (64 * NE)) + EPS);
#pragma unroll
  for (int j = 0; j < NE; ++j) v[j] = v[j] * rs * gain[lane + 64 * j];
  if constexpr (ROPE && NE == 2) {
    const int f = lane & 31; const float inv = exp2f(-(float)(2 * f) * (1.f / 64.f) * LOG2_THETA);
#pragma unroll
    for (int j = 0; j < 2; ++j) {
      const float partner = __shfl_xor(v[j], 32, 64);
      const float ang = (float)(j == 0 ? prow : pcol) * inv;
      float rev = ang * INV2PI; rev -= floorf(rev);
      const float c = __builtin_amdgcn_cosf(rev), s = __builtin_amdgcn_sinf(rev);
      v[j] = (lane < 32) ? v[j] * c - partner * s : v[j] * c + partner * s;
    }
  }
  if constexpr (ROPE && NE == 1) {
    const int f = lane & 15; const float inv = exp2f(-(float)(2 * f) * (1.f / 32.f) * LOG2_THETA);
    const float partner = __shfl_xor(v[0], 16, 64);
    const float ang = (float)(lane < 32 ? prow : pcol) * inv;
    float rev = ang * INV2PI; rev -= floorf(rev);
    const float c = __builtin_amdgcn_cosf(rev), s = __builtin_amdgcn_sinf(rev);
    v[0] = (lane & 16) ? v[0] * c + partner * s : v[0] * c - partner * s;
  }
}

constexpr int LDS_BYTES = pg8::STAGE_BYTES;
static_assert(att::SHM_ATTN <= LDS_BYTES, "lds");
constexpr int NPHASE = 18;
#ifndef PHMASK
#define PHMASK 0xf
#endif
#ifndef REPMASK
#define REPMASK 0
#endif
#ifndef A128_SD
#define A128_SD 1
#endif
#ifndef KARG
#define KARG 0
#endif
#define wt_in0 ((bf16_t*)(p.ws + WS_WT_IN0))
#define wt_qb ((bf16_t*)(p.ws + WS_WT_QB))
#define wt_kvb ((bf16_t*)(p.ws + WS_WT_KVB))
#define wt_out ((bf16_t*)(p.ws + WS_WT_OUT))
#define wt_memkv ((bf16_t*)(p.ws + WS_WT_MEMKV))
#define wt_gu ((bf16_t*)(p.ws + WS_WT_GU))
#define wt_dn ((bf16_t*)(p.ws + WS_WT_DN))
#define wt_in1 ((bf16_t*)(p.ws + WS_WT_IN1))
#define memn ((bf16_t*)(p.ws + WS_MEMN))
#define memkv ((bf16_t*)(p.ws + WS_MEMKV))
#define hbuf ((bf16_t*)(p.ws + WS_HM))
#define mix ((bf16_t*)(p.ws + WS_HM))
#define proj ((bf16_t*)(p.ws + WS_R))
#define act ((bf16_t*)(p.ws + WS_R))
#define qbuf ((bf16_t*)(p.ws + WS_Q))
#define kvbuf ((bf16_t*)(p.ws + WS_KV))

struct GemmJob { const bf16_t* A; int lda; const bf16_t* Bt; int M, N, K; int kind; bf16_t* O; int ldc; const float* res; int coff; };

__device__ __forceinline__ int gemm_jobs(const Params& p, int ph, int gi, GemmJob& j) {
  const float* x = p.in[0];
  j.M = NTOK; j.res = nullptr; j.coff = 0; j.O = nullptr; j.ldc = 0;
  switch (ph) {
  case 1:
    if (gi == 0) { j.A = hbuf; j.lda = 1024; j.Bt = wt_in0; j.N = 1280; j.K = 1024; j.kind = 0; j.O = proj; j.ldc = 1280; }
    else { j.A = memn; j.lda = 1024; j.Bt = wt_memkv + (size_t)(gi - 1) * 1024 * 1024; j.M = NMEMROWS; j.N = 1024; j.K = 1024; j.kind = 0; j.O = memkv + (size_t)(gi - 1) * NMEMROWS * 1024; j.ldc = 1024; j.coff = (gi - 1) * 128; }
    return 3;
  case 3:
    if (gi == 0) { j.A = proj; j.lda = 1280; j.Bt = wt_qb; j.N = 1536; j.K = 384; j.kind = 0; j.O = qbuf; j.ldc = 1536; }
    else { j.A = proj + 384; j.lda = 1280; j.Bt = wt_kvb; j.N = 2048; j.K = 256; j.kind = 0; j.O = kvbuf; j.ldc = 2048; }
    return 2;
  case 6: case 14: { const int L = ph == 6 ? 0 : 1;
    j.A = mix; j.lda = 1536; j.Bt = wt_out + (size_t)L * 1024 * 1536; j.N = 1024; j.K = 1536; j.kind = 1; j.res = L == 0 ? x : p.out; return 1; }
  case 8: case 16: { const int L = ph == 8 ? 0 : 1;
    j.A = hbuf; j.lda = 1024; j.Bt = wt_gu + (size_t)L * 5632 * 1024; j.N = 5632; j.K = 1024; j.kind = 2; j.O = act; return 1; }
  case 9: case 17: { const int L = ph == 9 ? 0 : 1;
    j.A = act; j.lda = DFF; j.Bt = wt_dn + (size_t)L * 1024 * 2816; j.N = 1024; j.K = DFF; j.kind = 1; j.res = p.out; return 1; }
  case 11:
    j.A = hbuf; j.lda = 1024; j.Bt = wt_in1; j.N = 2048; j.K = 1024; j.kind = 0; j.O = proj; j.ldc = 2048; return 1;
  default: return 0;
  }
}

__global__ __launch_bounds__(512) void mega(Params p_) {
  extern __shared__ __attribute__((aligned(16))) unsigned char shm[];
  LAS unsigned char* glds = (LAS unsigned char*)shm;
  char* alds = (char*)shm;
  const Params* pp = (const Params*)__builtin_amdgcn_kernarg_segment_ptr();
  const int ph_lo = p_.ph_lo, ph_hi = p_.ph_hi;

  for (int ph = ph_lo; ph < ph_hi; ++ph) {
    if (ph == 2) continue;
#if KARG
    asm volatile("" : "+s"(pp));
    const Params& p = *pp;
#else
    const Params& p = p_;
#endif
    const float* x = p.in[0];
    for (int rep = 0; rep < 1 + ((REPMASK >> ph) & 1); ++rep) {
    const int tid_ = opaque_tid(), wid = tid_ >> 6, lane = tid_ & 63;
    const int gw = blockIdx.x * 8 + wid, nw = gridDim.x * 8;
    if (PHMASK & 1) switch (ph) {
    case 0: {
      prep_w<2>(p.in[11], 1024, 1216, wt_in0, 1280, nullptr);
      prep_w<3>(p.in[13], 384, 1536, wt_qb, 1536, p.in[12]);
      prep_w<0>(p.in[15], 256, 2048, wt_kvb, 2048, p.in[14]);
      for (int i = 0; i < 2; ++i) {
        prep_w<0>(p.in[5] + (size_t)i * 1536 * 1024, 1536, 1024, wt_out + (size_t)i * 1024 * 1536, 1024, nullptr);
        prep_w<0>(p.in[6] + (size_t)i * 1024 * 1024, 1024, 1024, wt_memkv + (size_t)i * 1024 * 1024, 1024, nullptr);
        prep_w<1>(p.in[9] + (size_t)i * 1024 * 5632, 1024, 5632, wt_gu + (size_t)i * 5632 * 1024, 5632, nullptr);
        prep_w<0>(p.in[10] + (size_t)i * 2816 * 1024, 2816, 1024, wt_dn + (size_t)i * 1024 * 2816, 1024, nullptr);
      }
      prep_w<0>(p.in[18], 1024, 2048, wt_in1, 2048, nullptr);
      rms_rows(p.in[1], p.in[2], memn, NMEMROWS);
      rms_rows(x, p.in[3], hbuf, NTOK);
    } break;
    case 4: {
      const int l16 = lane & 15, l8 = lane & 7;
      float inv64[8], g_mq[8], g_qn[8], g_qp[8], g_kn[8], g_kp[8];
#pragma unroll
      for (int j = 0; j < 8; ++j) inv64[j] = exp2f(-(float)(2 * ((l8 & 1) * 8 + j)) * (1.f / 32.f) * LOG2_THETA);
      load8(g_mq, p.in[7] + l16 * 8); load8(g_qn, p.in[16] + l16 * 8); load8(g_qp, p.in[16] + 128 + l8 * 8); load8(g_kn, p.in[17] + l16 * 8); load8(g_kp, p.in[17] + 128 + l8 * 8);
      const bool first64 = !(l8 & 2);
      for (int t = gw; t < NTOK; t += nw) {
        const int sq = t & (SEQ - 1); const float pos64 = (float)((l8 < 4) ? (sq >> 6) : (sq & 63));
        bf16_t* pr = proj + (size_t)t * 1280 + lane * 8; bf16_t* qrow = qbuf + (size_t)t * 1536 + lane * 8; bf16_t* kvrow = kvbuf + (size_t)t * 2048 + lane * 8;
        const u32x4 P0 = *(const u32x4*)pr, P1 = *(const u32x4*)(pr + 512);
        u32x4 P2 = {0u, 0u, 0u, 0u}; if (lane < 32) P2 = *(const u32x4*)(pr + 1024);
        const u32x4 Q0 = *(const u32x4*)qrow, Q1 = *(const u32x4*)(qrow + 512), Q2 = *(const u32x4*)(qrow + 1024);
        const u32x4 KV0 = *(const u32x4*)kvrow, KV1 = *(const u32x4*)(kvrow + 512), KV2 = *(const u32x4*)(kvrow + 1024), KV3 = *(const u32x4*)(kvrow + 1536);
        float a[8], b[8];
        unpack8(P0, a); unpack8(P1, b);
        const float s0 = sumsq8(a), s1 = sumsq8(b);
        const float ssq = wave_sum(lane < 48 ? s0 : 0.f), sskv = wave_sum((lane >= 48 ? s0 : 0.f) + (lane < 16 ? s1 : 0.f));
        const float rs_q = rsqrtf(ssq * (1.f / 384.f) + EPS), rs_kv = rsqrtf(sskv * (1.f / 256.f) + EPS);
        norm8<16>(b, g_mq); if (lane >= 16) *(u32x4*)(pr + 512) = pack8(b);
        unpack8(P2, a);
        { const float s8 = group_sum<8>(sumsq8(a)), s16 = s8 + __shfl_xor(s8, 8, 64);
          const float rsA = rsqrtf(s16 * (1.f / 128.f) + EPS), rsB = rsqrtf(s8 * (1.f / 64.f) + EPS);
#pragma unroll
          for (int j = 0; j < 8; ++j) { b[j] = a[j] * rsB * g_kp[j]; a[j] = a[j] * rsA * g_mq[j]; }
          rope8<2>(b, inv64, pos64, first64);
#pragma unroll
          for (int j = 0; j < 8; ++j) a[j] = lane < 16 ? a[j] : b[j];
          if (lane < 24) *(u32x4*)(pr + 1024) = pack8(a); }
        unpack8(Q0, a);
#pragma unroll
        for (int j = 0; j < 8; ++j) a[j] *= rs_q;
        norm8<16>(a, g_qn); *(u32x4*)qrow = pack8(a);
        unpack8(Q1, a);
#pragma unroll
        for (int j = 0; j < 8; ++j) a[j] *= rs_q;
        norm8<16>(a, g_qn); *(u32x4*)(qrow + 512) = pack8(a);
        unpack8(Q2, a);
#pragma unroll
        for (int j = 0; j < 8; ++j) a[j] *= rs_q;
        norm8<8>(a, g_qp); rope8<2>(a, inv64, pos64, first64); *(u32x4*)(qrow + 1024) = pack8(a);
        const bool is_k = !((lane >> 4) & 1);
#define KVCHUNK(W, OFF) do { unpack8(W, a); _Pragma("unroll") for (int j = 0; j < 8; ++j) { a[j] *= rs_kv; b[j] = a[j]; } norm8<16>(b, g_kn); \
          _Pragma("unroll") for (int j = 0; j < 8; ++j) a[j] = is_k ? b[j] : a[j]; *(u32x4*)(kvrow + (OFF)) = pack8(a); } while (0)
        KVCHUNK(KV0, 0); KVCHUNK(KV1, 512); KVCHUNK(KV2, 1024); KVCHUNK(KV3, 1536);
#undef KVCHUNK
      }
      for (int r = gw; r < 2 * NMEMROWS; r += nw) {
        float g_mk[8]; load8(g_mk, p.in[8] + (r / NMEMROWS) * 128 + l16 * 8);
        bf16_t* row = memkv + (size_t)r * 1024 + lane * 8;
        float a[8]; unpack8(*(const u32x4*)row, a); norm8<16>(a, g_mk); *(u32x4*)row = pack8(a);
      }
    } break;
    case 7: case 15: rms_rows(p.out, p.in[4] + (ph == 7 ? 0 : 1024), hbuf, NTOK); break;
    case 10: rms_rows(p.out, p.in[3] + 1024, hbuf, NTOK); break;
    case 12: {
      const int l16 = lane & 15;
      float inv128[8], g_q[8], g_k[8], g_mq[8];
#pragma unroll
      for (int j = 0; j < 8; ++j) inv128[j] = exp2f(-(float)(2 * ((l16 & 3) * 8 + j)) * (1.f / 64.f) * LOG2_THETA);
      load8(g_q, p.in[19] + l16 * 8); load8(g_k, p.in[20] + l16 * 8); load8(g_mq, p.in[7] + 128 + l16 * 8);
      const bool first128 = !(l16 & 4);
      for (int t = gw; t < NTOK; t += nw) {
        const int sq = t & (SEQ - 1); const float pos128 = (float)((l16 < 8) ? (sq >> 6) : (sq & 63));
        bf16_t* row = proj + (size_t)t * 2048 + lane * 8;
        const u32x4 W0 = *(const u32x4*)row, W1 = *(const u32x4*)(row + 512), W2 = *(const u32x4*)(row + 1024), W3 = *(const u32x4*)(row + 1536);
        float a[8];
        unpack8(W0, a); norm8<16>(a, g_q); rope8<4>(a, inv128, pos128, first128); *(u32x4*)row = pack8(a);
        unpack8(W1, a); norm8<16>(a, g_q); rope8<4>(a, inv128, pos128, first128); *(u32x4*)(row + 512) = pack8(a);
        unpack8(W2, a); norm8<16>(a, g_k); rope8<4>(a, inv128, pos128, first128); if (lane < 32) *(u32x4*)(row + 1024) = pack8(a);
        unpack8(W3, a); norm8<16>(a, g_mq); *(u32x4*)(row + 1536) = pack8(a);
      }
    } break;
    default: break;
    }
    if (PHMASK & 2) {
      GemmJob j; const int ng = gemm_jobs(p, ph, 0, j);
      for (int gi = 0; gi < ng; ++gi) {
        if (gi) gemm_jobs(p, ph, gi, j);
        if (j.kind == 0) pg8::run_gemm(glds, j.A, j.lda, j.Bt, j.M, j.N, j.K, pg8::EpiBf16{j.O, j.ldc}, j.coff);
        else if (j.kind == 1) pg8::run_gemm(glds, j.A, j.lda, j.Bt, j.M, j.N, j.K, pg8::EpiResF32{p.out, j.res}, j.coff);
        else pg8::run_gemm(glds, j.A, j.lda, j.Bt, j.M, j.N, j.K, pg8::EpiSwiGLU{j.O}, j.coff);
      }
    }
    if ((PHMASK & 12) && (ph == 5 || ph == 13)) {
      const int L = ph == 5 ? 0 : 1;
      att::AttnJob a;
      if (L == 0) {
        a.Q = qbuf; a.Q2 = qbuf + 1024; a.ldq = 1536; a.qhs = 128; a.K = kvbuf; a.ldk = 2048; a.khs = 256; a.kbs = (long)SEQ * 2048; a.K2 = proj + 1152; a.ldk2 = 1280;
        a.V = kvbuf + 128; a.ldv = 2048; a.O = mix; a.H = 8; a.gshift = 0; a.seq = SEQ; a.nunits = 2048; a.scale = 0.072168783648703220f;
        if (PHMASK & 4) att::run_attn<192, 1>(a, alds);
      } else {
        a.Q = proj; a.Q2 = proj; a.ldq = 2048; a.qhs = 128; a.K = proj + 1024; a.ldk = 2048; a.khs = 128; a.kbs = (long)SEQ * 2048; a.K2 = proj; a.ldk2 = 0;
        a.V = proj + 1280; a.ldv = 2048; a.O = mix; a.H = 8; a.gshift = 2; a.seq = SEQ; a.nunits = 2048; a.scale = 0.088388347648318440f;
      }
      for (int pass = (L == 0 ? 1 : 0); pass < 2; ++pass) {
        if (pass == 1) {
          a.Q = L == 0 ? proj + 640 : proj + 1536; a.Q2 = a.Q; a.ldq = L == 0 ? 1280 : 2048; a.qhs = 128;
          a.K = memkv + (size_t)L * NMEMROWS * 1024; a.ldk = 1024; a.khs = 128; a.kbs = 256 * 1024; a.K2 = a.K; a.ldk2 = 0;
          a.V = a.K + 512; a.ldv = 1024; a.O = mix + 1024; a.H = 4; a.gshift = 0; a.seq = 256; a.nunits = 1024; a.scale = 0.088388347648318440f;
        }
        if (PHMASK & 8) att::run_attn<128, A128_SD>(a, alds);
      }
    }
    }
    if (ph + 1 < ph_hi) cg::this_grid().sync();
  }
}

extern "C" void kernel_launch(void* const* d_in, const int* in_sizes, int n_in, void* d_out, int out_size, void* d_ws, size_t ws_size, hipStream_t stream) {
  static int grid = 0;
  if (grid == 0) {
    if (n_in != 21 || in_sizes[0] != NTOK * DM || out_size != NTOK * DM || ws_size < WS_END) {
      fprintf(stderr, "kernel_launch: shape/workspace mismatch (n_in %d, in0 %d, out %d, ws %zu, need %zu)\n", n_in, n_in > 0 ? in_sizes[0] : -1, out_size, ws_size, (size_t)WS_END);
      grid = -1; return; }
    int dev = 0, cus = 0, per_cu = 0;
    (void)hipGetDevice(&dev); (void)hipDeviceGetAttribute(&cus, hipDeviceAttributeMultiprocessorCount, dev);
    if (hipFuncSetAttribute((const void*)mega, hipFuncAttributeMaxDynamicSharedMemorySize, LDS_BYTES) != hipSuccess) { fprintf(stderr, "kernel_launch: hipFuncSetAttribute failed\n"); grid = -1; return; }
    if (hipOccupancyMaxActiveBlocksPerMultiprocessor(&per_cu, (const void*)mega, 512, LDS_BYTES) != hipSuccess || per_cu < 1) { fprintf(stderr, "kernel_launch: occupancy query says %d\n", per_cu); per_cu = 1; }
    (void)hipGetLastError();
    grid = cus * 1;
    if (grid <= 0) grid = 256;
  }
  if (grid < 0) return;
  Params p{};
  for (int i = 0; i < 21; ++i) p.in[i] = (const float*)d_in[i];
  p.out = (float*)d_out; p.ws = (unsigned char*)d_ws;
#if MK_ONE_LAUNCH
  p.ph_lo = 0; p.ph_hi = NPHASE;
  void* args[] = {&p};
  hipError_t e = hipLaunchCooperativeKernel((const void*)mega, dim3(grid), dim3(512), args, LDS_BYTES, stream);
  if (e != hipSuccess) fprintf(stderr, "kernel_launch: cooperative launch failed: %s (grid %d)\n", hipGetErrorString(e), grid);
#else
  for (int ph = 0; ph < NPHASE; ++ph) {
    p.ph_lo = ph; p.ph_hi = ph + 1;
    hipLaunchKernelGGL(mega, dim3(grid), dim3(512), LDS_BYTES, stream, p);
  }
#endif
}
```

```cpp
#include <hip/hip_runtime.h>
#include <hip/hip_cooperative_groups.h>
#include <cstdio>
#include <cstdint>
namespace cg = cooperative_groups;

#ifndef MK_ONE_LAUNCH
#define MK_ONE_LAUNCH 1
#endif

typedef unsigned short bf16_t;
typedef short bf16x8 __attribute__((ext_vector_type(8)));
typedef short s16x4 __attribute__((ext_vector_type(4)));
typedef float f32x4 __attribute__((ext_vector_type(4)));
typedef float f32x16 __attribute__((ext_vector_type(16)));
typedef unsigned u32x4 __attribute__((ext_vector_type(4)));
typedef unsigned u32x2 __attribute__((ext_vector_type(2)));
#define LAS __attribute__((address_space(3)))

constexpr int NTOK = 65536, SEQ = 8192, DM = 1024, DFF = 2816, NMEMROWS = 2048;
constexpr float EPS = 1e-6f;
constexpr float LOG2_THETA = 13.287712379549449f;
constexpr float INV2PI = 0.15915494309189535f;
constexpr size_t MiB = 1ull << 20;
constexpr size_t WS_WT_IN0 = 0;
constexpr size_t WS_WT_QB = WS_WT_IN0 + 1280ull * 1024 * 2;
constexpr size_t WS_WT_KVB = WS_WT_QB + 1536ull * 384 * 2;
constexpr size_t WS_WT_OUT = WS_WT_KVB + 2048ull * 256 * 2;
constexpr size_t WS_WT_MEMKV = WS_WT_OUT + 2ull * 1024 * 1536 * 2;
constexpr size_t WS_WT_GU = WS_WT_MEMKV + 2ull * 1024 * 1024 * 2;
constexpr size_t WS_WT_DN = WS_WT_GU + 2ull * 5632 * 1024 * 2;
constexpr size_t WS_WT_IN1 = WS_WT_DN + 2ull * 1024 * 2816 * 2;
constexpr size_t WS_WT_END = WS_WT_IN1 + 2048ull * 1024 * 2;
static_assert(WS_WT_END <= 56 * MiB, "weights region");
constexpr size_t WS_MEMN = 56 * MiB;
constexpr size_t WS_MEMKV = 60 * MiB;
constexpr size_t WS_BAR = 70 * MiB;
constexpr size_t WS_HM = 72 * MiB;
constexpr size_t WS_R = 264 * MiB;
constexpr size_t WS_Q = WS_R + 160 * MiB;
constexpr size_t WS_KV = WS_Q + 192 * MiB;
constexpr size_t WS_END = WS_KV + 256 * MiB;

struct Params { const float* in[21]; float* out; unsigned char* ws; int ph_lo, ph_hi; };

__device__ __forceinline__ float bf2f(bf16_t v) { return __uint_as_float(((unsigned)v) << 16); }
__device__ __forceinline__ bf16_t f2bf(float f) { unsigned u = __float_as_uint(f); u += 0x7FFFu + ((u >> 16) & 1u); return (bf16_t)(u >> 16); }
__device__ __forceinline__ unsigned cvtpk(float lo, float hi) { unsigned r; asm volatile("v_cvt_pk_bf16_f32 %0, %1, %2" : "=v"(r) : "v"(lo), "v"(hi)); return r; }
__device__ __forceinline__ float wave_sum(float v) {
#pragma unroll
  for (int o = 32; o > 0; o >>= 1) v += __shfl_xor(v, o, 64);
  return v;
}

__device__ __forceinline__ int opaque_tid() { int t = threadIdx.x; asm volatile("" : "+v"(t)); return t; }

namespace pg8 {
constexpr int BM = 256, BK = 64, HALF = 128, HTB = HALF * BK * 2, STAGE_BYTES = 8 * HTB, NXCD = 8, WGM = 8;
__device__ __forceinline__ int lds_byte(int r, int c) { const int st = (r >> 4) * 2 + (c >> 5), rr = r & 15, cc = c & 31, ob = rr * 64 + cc * 2; return st * 1024 + (ob ^ (((ob >> 9) & 1) << 5)); }
__device__ __forceinline__ void stage_rc(int b, int& R, int& C) { const int st = b / 1024, sb = b % 1024, swz = sb ^ (((sb >> 9) & 1) << 5); R = (st >> 1) * 16 + swz / 64; C = (st & 1) * 32 + (swz % 64) / 2; }
__device__ __forceinline__ int perm32(int rho) { const int n = rho >> 4, i = rho & 15; return 8 * (i >> 2) + 4 * n + (i & 3); }
struct Unit { int pm, pn; };
struct Gemm { const bf16_t* A; const bf16_t* Bt; int M, N, K, lda; };
struct StaticOrder {
  int nM, nN, nwg, G, c;
  __device__ void init(int M, int N, int G_, int c_) { nM = M / BM; nN = N / BM; nwg = nM * nN; G = G_; c = c_; }
  __device__ bool next(int i, Unit& u) const {
    const long L = (long)i * G + c; if (L >= nwg) return false;
    int wgid = (int)L; { const int q = nwg / NXCD, r = nwg % NXCD, xcd = wgid % NXCD, off = wgid / NXCD; wgid = (xcd < r ? xcd * (q + 1) : r * (q + 1) + (xcd - r) * q) + off; }
    const int nig = WGM * nN, gid = wgid / nig, fm = gid * WGM, gsz = (nM - fm) < WGM ? (nM - fm) : WGM;
    u.pm = fm + ((wgid % nig) % gsz); u.pn = (wgid % nig) / gsz; return true;
  }
};

struct EpiBf16 {
  static constexpr bool PERM = true;
  bf16_t* O; int ldc;
  __device__ __forceinline__ void operator()(const f32x4 (&acc)[2][2][4][2], const Unit& u, int wr, int wc, int fr, int fq) const {
    const int row0 = u.pm * BM + wr * 64 + fr, col0 = u.pn * BM + wc * 32 + 8 * fq;
#pragma unroll
    for (int ai = 0; ai < 2; ++ai)
#pragma unroll
      for (int m = 0; m < 4; ++m) { bf16_t* rowp = O + (size_t)(row0 + ai * HALF + m * 16) * ldc + col0;
#pragma unroll
        for (int bj = 0; bj < 2; ++bj) { const f32x4 v0 = acc[ai][bj][m][0], v1 = acc[ai][bj][m][1];
          u32x4 w; w.x = cvtpk(v0[0], v0[1]); w.y = cvtpk(v0[2], v0[3]); w.z = cvtpk(v1[0], v1[1]); w.w = cvtpk(v1[2], v1[3]);
          *(u32x4*)(rowp + bj * HALF) = w; } }
  }
};
struct EpiResF32 {
  static constexpr bool PERM = false;
  float* out; const float* res;
  __device__ __forceinline__ void operator()(const f32x4 (&acc)[2][2][4][2], const Unit& u, int wr, int wc, int fr, int fq) const {
    const int row0 = u.pm * BM + wr * 64 + fr, col0 = u.pn * BM + wc * 32 + 4 * fq;
#pragma unroll
    for (int ai = 0; ai < 2; ++ai)
#pragma unroll
      for (int m = 0; m < 4; ++m) { const size_t off = (size_t)(row0 + ai * HALF + m * 16) * DM + col0;
#pragma unroll
        for (int bj = 0; bj < 2; ++bj)
#pragma unroll
          for (int n = 0; n < 2; ++n) { const f32x4 r = *(const f32x4*)(res + off + bj * HALF + n * 16); *(f32x4*)(out + off + bj * HALF + n * 16) = r + acc[ai][bj][m][n]; } }
  }
};
struct EpiSwiGLU {
  static constexpr bool PERM = true;
  bf16_t* O;
  __device__ __forceinline__ void operator()(const f32x4 (&acc)[2][2][4][2], const Unit& u, int wr, int wc, int fr, int fq) const {
    const int row0 = u.pm * BM + wr * 64 + fr, col0 = u.pn * HALF + wc * 32 + 8 * fq;
#pragma unroll
    for (int ai = 0; ai < 2; ++ai)
#pragma unroll
      for (int m = 0; m < 4; ++m) { bf16_t* rowp = O + (size_t)(row0 + ai * HALF + m * 16) * DFF + col0;
        float y[8];
#pragma unroll
        for (int n = 0; n < 2; ++n)
#pragma unroll
          for (int j = 0; j < 4; ++j) { const float g = acc[ai][0][m][n][j], up = acc[ai][1][m][n][j];
            const float e = __builtin_amdgcn_exp2f(-g * 1.4426950408889634f);
            y[n * 4 + j] = g * __builtin_amdgcn_rcpf(1.0f + e) * up; }
        u32x4 w; w.x = cvtpk(y[0], y[1]); w.y = cvtpk(y[2], y[3]); w.z = cvtpk(y[4], y[5]); w.w = cvtpk(y[6], y[7]);
        *(u32x4*)rowp = w; }
  }
};

template <class Epi>
__device__ __forceinline__ void gemm_phase(LAS unsigned char* lds, const Gemm g, const StaticOrder& S, const Epi& E) {
  const int tid = opaque_tid(), wid = __builtin_amdgcn_readfirstlane(tid >> 6), lane = tid & 63, wr = wid >> 2, wc = wid & 3, fr = lane & 15, fq = lane >> 4;
  const int K = g.K, nt = K / BK, lda = g.lda;
  unsigned voffA[2], voffB[2];
#pragma unroll
  for (int i = 0; i < 2; ++i) { int R, C; stage_rc(tid * 16 + i * 8192, R, C); const int Rb = Epi::PERM ? ((R & ~31) + perm32(R & 31)) : R;
    voffA[i] = (unsigned)(R * lda + C) * 2u; voffB[i] = (unsigned)(Rb * K + C) * 2u; }
  const size_t kstep = (size_t)(BK * 2);
  const size_t hstepA = (size_t)HALF * lda * 2, hstepB = (size_t)HALF * K * 2;
  const size_t tstepA = 2 * hstepA, tstepB = 2 * hstepB;
  const unsigned ldsw = (unsigned)wid * 1024u;
  const int aoff = lds_byte(wr * 64 + fr, fq * 8), boff = lds_byte(wc * 32 + fr, fq * 8);
#define PG8_SA(b, h) (((b) * 2 + (h)) * HTB)
#define PG8_SB(b, h) ((4 + (b) * 2 + (h)) * HTB)
#define PG8_STAGE(bufoff, gbase, voff) do { _Pragma("unroll") for (int _i = 0; _i < 2; ++_i) \
    __builtin_amdgcn_global_load_lds((const unsigned*)((const char*)(gbase) + (voff)[_i]), (LAS unsigned*)(lds + (bufoff) + ldsw + _i * 8192), 16, 0, 0); } while (0)
#define PG8_LDA(dst, b, h) do { _Pragma("unroll") for (int m = 0; m < 4; ++m) _Pragma("unroll") for (int k = 0; k < 2; ++k) dst[m][k] = *(const LAS bf16x8*)(lds + PG8_SA(b, h) + aoff + m * 2048 + k * 1024); } while (0)
#define PG8_LDB(dst, b, h) do { _Pragma("unroll") for (int n = 0; n < 2; ++n) _Pragma("unroll") for (int k = 0; k < 2; ++k) dst[n][k] = *(const LAS bf16x8*)(lds + PG8_SB(b, h) + boff + n * 2048 + k * 1024); } while (0)
#define PG8_MMA(ai, bj, At, Bt) do { __builtin_amdgcn_s_setprio(1); _Pragma("unroll") for (int m = 0; m < 4; ++m) _Pragma("unroll") for (int n = 0; n < 2; ++n) _Pragma("unroll") for (int k = 0; k < 2; ++k) \
    acc[ai][bj][m][n] = __builtin_amdgcn_mfma_f32_16x16x32_bf16(Bt[n][k], At[m][k], acc[ai][bj][m][n], 0, 0, 0); __builtin_amdgcn_s_setprio(0); } while (0)
#define PG8_WAIT_V(n) asm volatile("s_waitcnt vmcnt(" #n ")" ::: "memory")
#define PG8_WAIT_L(n) asm volatile("s_waitcnt lgkmcnt(" #n ")" ::: "memory")
#define PG8_BAR __builtin_amdgcn_s_barrier()
#define PG8_SCHED __builtin_amdgcn_sched_barrier(0)
  Unit cur, nxt; int ui = 0;
  if (!S.next(0, cur)) return;
  f32x4 acc[2][2][4][2];
#pragma unroll
  for (int a = 0; a < 2; ++a)
#pragma unroll
    for (int b = 0; b < 2; ++b)
#pragma unroll
      for (int m = 0; m < 4; ++m)
#pragma unroll
        for (int n = 0; n < 2; ++n) acc[a][b][m][n] = (f32x4){0.f, 0.f, 0.f, 0.f};
  bf16x8 At[4][2], B0[2][2], B1[2][2];
  const char* cA = (const char*)g.A + (size_t)cur.pm * tstepA; const char* cB = (const char*)g.Bt + (size_t)cur.pn * tstepB;
  PG8_STAGE(PG8_SB(0, 0), cB, voffB); PG8_STAGE(PG8_SA(0, 0), cA, voffA); PG8_STAGE(PG8_SB(0, 1), cB + hstepB, voffB); PG8_STAGE(PG8_SA(0, 1), cA + hstepA, voffA);
  if (wr == 1) PG8_BAR;
  PG8_WAIT_V(4); PG8_BAR;
  PG8_STAGE(PG8_SB(1, 0), cB + kstep, voffB); PG8_STAGE(PG8_SA(1, 0), cA + kstep, voffA); PG8_STAGE(PG8_SB(1, 1), cB + hstepB + kstep, voffB);
  PG8_WAIT_V(6); PG8_BAR;
  for (;;) {
    const bool has_next = S.next(ui + 1, nxt);
    const char* nA = has_next ? (const char*)g.A + (size_t)nxt.pm * tstepA : cA; const char* nB = has_next ? (const char*)g.Bt + (size_t)nxt.pn * tstepB : cB;
    for (int t = 0; t < nt; t += 2) {
      const bool last = (t == nt - 2);
      const char* a1 = cA + (size_t)(t + 1) * kstep;
      const char* a2 = last ? nA : cA + (size_t)(t + 2) * kstep; const char* b2 = last ? nB : cB + (size_t)(t + 2) * kstep;
      const char* a3 = a2 + kstep; const char* b3 = b2 + kstep;
      PG8_LDB(B0, 0, 0); PG8_SCHED; PG8_LDA(At, 0, 0); PG8_STAGE(PG8_SA(1, 1), a1 + hstepA, voffA);
      PG8_WAIT_L(8); PG8_BAR; PG8_WAIT_L(0); PG8_MMA(0, 0, At, B0); PG8_BAR; PG8_SCHED;
      PG8_LDB(B1, 0, 1); PG8_STAGE(PG8_SB(0, 0), b2, voffB);
      PG8_BAR; PG8_WAIT_L(0); PG8_MMA(0, 1, At, B1); PG8_BAR;
      PG8_LDA(At, 0, 1); PG8_STAGE(PG8_SA(0, 0), a2, voffA);
      PG8_BAR; PG8_WAIT_L(0); PG8_MMA(1, 0, At, B0); PG8_BAR; PG8_SCHED;
      PG8_STAGE(PG8_SB(0, 1), b2 + hstepB, voffB);
      PG8_WAIT_V(6); PG8_BAR; PG8_MMA(1, 1, At, B1); PG8_BAR;
      PG8_LDB(B0, 1, 0); PG8_SCHED; PG8_LDA(At, 1, 0); PG8_STAGE(PG8_SA(0, 1), a2 + hstepA, voffA);
      PG8_WAIT_L(8); PG8_BAR; PG8_WAIT_L(0); PG8_MMA(0, 0, At, B0); PG8_BAR; PG8_SCHED;
      PG8_LDB(B1, 1, 1); PG8_STAGE(PG8_SB(1, 0), b3, voffB);
      PG8_BAR; PG8_WAIT_L(0); PG8_MMA(0, 1, At, B1); PG8_BAR;
      PG8_LDA(At, 1, 1); PG8_STAGE(PG8_SA(1, 0), a3, voffA);
      PG8_BAR; PG8_WAIT_L(0); PG8_MMA(1, 0, At, B0); PG8_BAR; PG8_SCHED;
      PG8_STAGE(PG8_SB(1, 1), b3 + hstepB, voffB);
      PG8_WAIT_V(6); PG8_BAR; PG8_MMA(1, 1, At, B1); PG8_BAR;
    }
    E(acc, cur, wr, wc, fr, fq);
    if (!has_next) break;
#pragma unroll
    for (int a = 0; a < 2; ++a)
#pragma unroll
      for (int b = 0; b < 2; ++b)
#pragma unroll
        for (int m = 0; m < 4; ++m)
#pragma unroll
          for (int n = 0; n < 2; ++n) acc[a][b][m][n] = (f32x4){0.f, 0.f, 0.f, 0.f};
    cur = nxt; cA = nA; cB = nB; ++ui;
  }
  PG8_WAIT_V(0);
  if (wr == 0) PG8_BAR;
  PG8_BAR;
#undef PG8_SA
#undef PG8_SB
#undef PG8_STAGE
#undef PG8_LDA
#undef PG8_LDB
#undef PG8_MMA
#undef PG8_WAIT_V
#undef PG8_WAIT_L
#undef PG8_BAR
#undef PG8_SCHED
}
template <class Epi>
__device__ __forceinline__ void run_gemm(LAS unsigned char* lds, const bf16_t* A, int lda, const bf16_t* Bt, int M, int N, int K, const Epi& E, int coff) {
  Gemm g{A, Bt, M, N, K, lda};
  StaticOrder S; S.init(M, N, (int)gridDim.x, (int)((blockIdx.x + coff) % gridDim.x));
  gemm_phase<Epi>(lds, g, S, E);
}
}

namespace att {
constexpr int NW = 8, QBLK = 32, KVBLK = 64;
constexpr float THR = 8.f;
constexpr int SHM_V = KVBLK * 128 * 2, SHM_K = KVBLK * 128 * 2, SHM_K2 = KVBLK * 64 * 2;
constexpr int OFF_K = 2 * SHM_V, OFF_K2 = OFF_K + 2 * SHM_K, OFF_WS = OFF_K2 + 2 * SHM_K2, OFF_Q2 = OFF_WS + NW * 64 * 4, SHM_ATTN = OFF_Q2 + 32768;
#define KSWZ(row, colB) ((row) * 256 + ((colB) ^ (((row) & 7) << 4)))
#define K2SWZ(row, colB) ((row) * 128 + ((colB) ^ ((((row) >> 1) & 7) << 4)))
#define SBAR() __builtin_amdgcn_sched_barrier(0)
__device__ __forceinline__ int crow(int r, int hi) { return (r & 3) + 8 * (r >> 2) + 4 * hi; }
__device__ __forceinline__ void partialSM(f32x16& p0, f32x16& p1, float& m_reg, float& mn, float& alpha, float C, float thr_s) {
  float pmax = p0[0];
#pragma unroll
  for (int r = 1; r < 16; ++r) pmax = fmaxf(pmax, p0[r]);
#pragma unroll
  for (int r = 0; r < 16; ++r) pmax = fmaxf(pmax, p1[r]);
  { auto rr = __builtin_amdgcn_permlane32_swap(__float_as_uint(pmax), __float_as_uint(pmax), false, false);
    pmax = fmaxf(__uint_as_float(rr[0]), __uint_as_float(rr[1])); }
  if (__builtin_expect(__all(pmax - m_reg <= thr_s), 1)) { mn = m_reg; alpha = 1.f; }
  else { mn = fmaxf(m_reg, pmax); alpha = __builtin_amdgcn_exp2f((m_reg - mn) * C); m_reg = mn; }
  float mnC = -mn * C;
#pragma unroll
  for (int r = 0; r < 16; ++r) p0[r] = fmaf(p0[r], C, mnC);
#pragma unroll
  for (int r = 0; r < 16; ++r) p1[r] = fmaf(p1[r], C, mnC);
#pragma unroll
  for (int r = 0; r < 16; ++r) p0[r] = __builtin_amdgcn_exp2f(p0[r]);
}
__device__ __forceinline__ void finishSM(f32x16& p0, f32x16& p1, float alpha, float& l_reg, bf16x8& pa0, bf16x8& pa1, bf16x8& pa2, bf16x8& pa3) {
#pragma unroll
  for (int r = 0; r < 16; ++r) p1[r] = __builtin_amdgcn_exp2f(p1[r]);
  float ps = 0;
#pragma unroll
  for (int r = 0; r < 16; ++r) ps += p0[r];
#pragma unroll
  for (int r = 0; r < 16; ++r) ps += p1[r];
  { auto rr = __builtin_amdgcn_permlane32_swap(__float_as_uint(ps), __float_as_uint(ps), false, false);
    ps = __uint_as_float(rr[0]) + __uint_as_float(rr[1]); }
  l_reg = l_reg * alpha + ps;
#define PK4(P, BASE, OUT) do { unsigned a0 = cvtpk(P[BASE + 0], P[BASE + 1]), a1 = cvtpk(P[BASE + 2], P[BASE + 3]);   \
    unsigned b0 = cvtpk(P[BASE + 4], P[BASE + 5]), b1 = cvtpk(P[BASE + 6], P[BASE + 7]);                              \
    auto r0 = __builtin_amdgcn_permlane32_swap(a0, b0, false, false); auto r1 = __builtin_amdgcn_permlane32_swap(a1, b1, false, false); \
    u32x4 w = {r0[0], r1[0], r0[1], r1[1]}; OUT = *reinterpret_cast<bf16x8*>(&w); } while (0)
  PK4(p0, 0, pa0); PK4(p0, 8, pa1); PK4(p1, 0, pa2); PK4(p1, 8, pa3);
#undef PK4
}
template <int DQK>
__device__ __forceinline__ void qkt(f32x16& p0, f32x16& p1, const char* Ks, const char* K2s, const bf16x8* qr, const char* q2l, int r32, int hi) {
#pragma unroll
  for (int r = 0; r < 16; ++r) { p0[r] = 0.f; p1[r] = 0.f; }
#pragma unroll
  for (int d0 = 0; d0 < 8; ++d0) { int cb = (d0 * 16 + hi * 8) * 2;
    bf16x8 b0 = *reinterpret_cast<const bf16x8*>(Ks + KSWZ(r32, cb));
    bf16x8 b1 = *reinterpret_cast<const bf16x8*>(Ks + KSWZ(32 + r32, cb));
    p0 = __builtin_amdgcn_mfma_f32_32x32x16_bf16(b0, qr[d0], p0, 0, 0, 0);
    p1 = __builtin_amdgcn_mfma_f32_32x32x16_bf16(b1, qr[d0], p1, 0, 0, 0); }
  if constexpr (DQK == 192) {
#pragma unroll
    for (int d0 = 0; d0 < 4; ++d0) { int cb = (d0 * 16 + hi * 8) * 2;
      bf16x8 b0 = *reinterpret_cast<const bf16x8*>(K2s + K2SWZ(r32, cb));
      bf16x8 b1 = *reinterpret_cast<const bf16x8*>(K2s + K2SWZ(32 + r32, cb));
      const bf16x8 q2 = *reinterpret_cast<const bf16x8*>(q2l + d0 * 1024);
      p0 = __builtin_amdgcn_mfma_f32_32x32x16_bf16(b0, q2, p0, 0, 0, 0);
      p1 = __builtin_amdgcn_mfma_f32_32x32x16_bf16(b1, q2, p1, 0, 0, 0); }
  }
}
__device__ __forceinline__ int v_st(int k, int c) { const int kk = (k & ~0xC) | ((k & 4) << 1) | ((k & 8) >> 1); return ((kk >> 3) * 4 + (c >> 5)) * 512 + ((kk & 7) * 32 + (c & 31)) * 2; }
__device__ __forceinline__ int v_rd_base(int lane) { return ((lane & 3) << 3) | (((lane >> 2) & 3) << 6) | (((lane >> 4) & 1) << 5) | (((lane >> 5) & 1) << 8); }
constexpr int v_rd_off(int d0, int ks, int half) { return d0 * 512 + ks * 4096 + half * 2048; }
template <int OFF> __device__ __forceinline__ s16x4 tr_read(int vb) {
  s16x4 r; asm volatile("ds_read_b64_tr_b16 %0, %1 offset:%2" : "=&v"(r) : "v"(vb), "i"(OFF) : "memory"); return r;
}
template <int D0> __device__ __forceinline__ void pv_one(f32x16& od, int vb, bf16x8 pa0, bf16x8 pa1, bf16x8 pa2, bf16x8 pa3) {
  const s16x4 l0 = tr_read<v_rd_off(D0, 0, 0)>(vb), h0 = tr_read<v_rd_off(D0, 0, 1)>(vb), l1 = tr_read<v_rd_off(D0, 1, 0)>(vb), h1 = tr_read<v_rd_off(D0, 1, 1)>(vb);
  const s16x4 l2 = tr_read<v_rd_off(D0, 2, 0)>(vb), h2 = tr_read<v_rd_off(D0, 2, 1)>(vb), l3 = tr_read<v_rd_off(D0, 3, 0)>(vb), h3 = tr_read<v_rd_off(D0, 3, 1)>(vb);
  asm volatile("s_waitcnt lgkmcnt(0)" ::: "memory"); SBAR();
#define PK(L, H) (bf16x8){L[0], L[1], L[2], L[3], H[0], H[1], H[2], H[3]}
  od = __builtin_amdgcn_mfma_f32_32x32x16_bf16(pa0, PK(l0, h0), od, 0, 0, 0);
  od = __builtin_amdgcn_mfma_f32_32x32x16_bf16(pa1, PK(l1, h1), od, 0, 0, 0);
  od = __builtin_amdgcn_mfma_f32_32x32x16_bf16(pa2, PK(l2, h2), od, 0, 0, 0);
  od = __builtin_amdgcn_mfma_f32_32x32x16_bf16(pa3, PK(l3, h3), od, 0, 0, 0);
#undef PK
}
__device__ __forceinline__ void pv_d0(f32x16* o, int vb, bf16x8 pa0, bf16x8 pa1, bf16x8 pa2, bf16x8 pa3) {
  pv_one<0>(o[0], vb, pa0, pa1, pa2, pa3); pv_one<1>(o[1], vb, pa0, pa1, pa2, pa3); pv_one<2>(o[2], vb, pa0, pa1, pa2, pa3); pv_one<3>(o[3], vb, pa0, pa1, pa2, pa3);
}

template <int DQK, int SDEPTH>
__device__ __forceinline__ void attn_body(const bf16_t* __restrict__ Qb, const bf16_t* __restrict__ Q2b, int ldq, const bf16_t* __restrict__ Kh, int ldk, const bf16_t* __restrict__ K2h, int ldk2,
                                          const bf16_t* __restrict__ Vh, int ldv, bf16_t* __restrict__ Ob, int ldo, int seq, float scale, char* lds) {
  constexpr int ND = 8;
  const int tid = opaque_tid(), wid = tid >> 6, lane = tid & 63, r32 = lane & 31, hi = lane >> 5;
  const float C = scale * 1.4426950408889634f, thr_s = THR / scale;
  char* V_lds = lds; char* K_lds = lds + OFF_K; char* K2_lds = lds + OFF_K2;
  float* ws = (float*)(lds + OFF_WS) + wid * 64; float* li_l = ws; float* al_l = ws + 32;
  float m_reg = -1e30f, l_reg = 0; f32x16 o[4]; bf16x8 qr[ND];
#pragma unroll
  for (int d = 0; d < 4; ++d)
#pragma unroll
    for (int r = 0; r < 16; ++r) o[d][r] = 0.f;
  const bf16_t* Qw = Qb + (long)(wid * QBLK + r32) * ldq + hi * 8;
#pragma unroll
  for (int d0 = 0; d0 < ND; ++d0) qr[d0] = *reinterpret_cast<const bf16x8*>(Qw + d0 * 16);
  char* q2l = lds + OFF_Q2 + (wid * 4 * 64 + lane) * 16;
  __syncthreads();
  if constexpr (DQK == 192) {
#pragma unroll
    for (int d0 = 0; d0 < 4; ++d0) *reinterpret_cast<bf16x8*>(q2l + d0 * 1024) = *reinterpret_cast<const bf16x8*>(Q2b + (long)(wid * QBLK + r32) * ldq + hi * 8 + d0 * 16);
  }
  const int sr = tid >> 4, sc = (tid & 15) * 8, vst0 = v_st(sr, sc), vst1 = v_st(32 + sr, sc);
  const int sr2 = tid >> 3, sc2 = (tid & 7) * 8;
  const unsigned voffV = (unsigned)(sr * ldv + sc) * 2u, voffK = (unsigned)(sr * ldk + sc) * 2u, voffK2 = (unsigned)(sr2 * ldk2 + sc2) * 2u;
  const size_t tsV = (size_t)ldv * 2, tsK = (size_t)ldk * 2, tsK2 = (size_t)ldk2 * 2;
  const int vb0 = (int)(uintptr_t)V_lds + v_rd_base(lane);
  struct { bf16x8 vs0, vs1, ks0, ks1, k2; } sr_[SDEPTH];
#define SLOAD(i, k0) do { const char* vb_ = (const char*)Vh + (size_t)(k0) * tsV; const char* kb_ = (const char*)Kh + (size_t)(k0) * tsK; \
    sr_[i].vs0 = *(const bf16x8*)(vb_ + voffV); sr_[i].vs1 = *(const bf16x8*)(vb_ + 32 * tsV + voffV); \
    sr_[i].ks0 = *(const bf16x8*)(kb_ + voffK); sr_[i].ks1 = *(const bf16x8*)(kb_ + 32 * tsK + voffK); \
    if constexpr (DQK == 192) sr_[i].k2 = *(const bf16x8*)((const char*)K2h + (size_t)(k0) * tsK2 + voffK2); } while (0)
#define SWRITE(b, i) do { *(bf16x8*)(V_lds + (b) * SHM_V + vst0) = sr_[i].vs0;          \
    *(bf16x8*)(V_lds + (b) * SHM_V + vst1) = sr_[i].vs1; int kc = sc * 2;               \
    *(bf16x8*)(K_lds + (b) * SHM_K + KSWZ(sr, kc)) = sr_[i].ks0;                       \
    *(bf16x8*)(K_lds + (b) * SHM_K + KSWZ(32 + sr, kc)) = sr_[i].ks1;                  \
    if constexpr (DQK == 192) *(bf16x8*)(K2_lds + (b) * SHM_K2 + K2SWZ(sr2, sc2 * 2)) = sr_[i].k2; } while (0)
#define SWAIT() do { if constexpr (SDEPTH == 1) asm volatile("s_waitcnt vmcnt(0)" ::: "memory"); else if constexpr (DQK == 192) asm volatile("s_waitcnt vmcnt(5)" ::: "memory"); else asm volatile("s_waitcnt vmcnt(4)" ::: "memory"); } while (0)
#define RESC(a) do { if (__any((a) < 1.f)) { if (hi == 0) al_l[r32] = (a); asm volatile("s_waitcnt lgkmcnt(0)" ::: "memory"); \
    _Pragma("unroll") for (int d = 0; d < 4; ++d) _Pragma("unroll") for (int r = 0; r < 16; ++r) o[d][r] *= al_l[crow(r, hi)]; } } while (0)
  f32x16 pA0, pA1, pB0, pB1; float mnA, mnB, alA, alB; bf16x8 pa0, pa1, pa2, pa3; const int NT = seq / KVBLK;
  constexpr int SE = 0, SO = SDEPTH - 1;
  SLOAD(SE, 0); asm volatile("s_waitcnt vmcnt(0)" ::: "memory"); SWRITE(0, SE); __syncthreads();
  qkt<DQK>(pA0, pA1, K_lds, K2_lds, qr, q2l, r32, hi); partialSM(pA0, pA1, m_reg, mnA, alA, C, thr_s);
  SLOAD(SO, KVBLK); if constexpr (SDEPTH == 2) { if (2 < NT) SLOAD(SE, 2 * KVBLK); }
  SWAIT(); SWRITE(1, SO); __syncthreads();
  for (int j = 1; j + 1 < NT; j += 2) {
    SBAR(); qkt<DQK>(pB0, pB1, K_lds + SHM_K, K2_lds + SHM_K2, qr, q2l, r32, hi);
    finishSM(pA0, pA1, alA, l_reg, pa0, pa1, pa2, pa3); SBAR();
    SLOAD(SO, (j + SDEPTH) * KVBLK); SBAR();
    pv_d0(o, vb0, pa0, pa1, pa2, pa3); partialSM(pB0, pB1, m_reg, mnB, alB, C, thr_s);
    __syncthreads(); SWAIT(); SWRITE(0, SE);
    RESC(alB); __syncthreads();
    SBAR(); qkt<DQK>(pA0, pA1, K_lds, K2_lds, qr, q2l, r32, hi);
    finishSM(pB0, pB1, alB, l_reg, pa0, pa1, pa2, pa3); SBAR();
    if (SDEPTH == 1 || j + 3 < NT) SLOAD(SE, (j + 1 + SDEPTH) * KVBLK); SBAR();
    pv_d0(o, vb0 + SHM_V, pa0, pa1, pa2, pa3); partialSM(pA0, pA1, m_reg, mnA, alA, C, thr_s);
    __syncthreads(); SWAIT(); SWRITE(1, SO);
    RESC(alA); __syncthreads();
  }
  SBAR(); qkt<DQK>(pB0, pB1, K_lds + SHM_K, K2_lds + SHM_K2, qr, q2l, r32, hi);
  finishSM(pA0, pA1, alA, l_reg, pa0, pa1, pa2, pa3); SBAR();
  pv_d0(o, vb0, pa0, pa1, pa2, pa3); partialSM(pB0, pB1, m_reg, mnB, alB, C, thr_s);
  __syncthreads(); RESC(alB);
  finishSM(pB0, pB1, alB, l_reg, pa0, pa1, pa2, pa3); SBAR();
  pv_d0(o, vb0 + SHM_V, pa0, pa1, pa2, pa3);
  if (hi == 0) li_l[r32] = l_reg; asm volatile("s_waitcnt lgkmcnt(0)" ::: "memory");
  float rli[16];
#pragma unroll
  for (int r = 0; r < 16; ++r) rli[r] = __builtin_amdgcn_rcpf(li_l[crow(r, hi)]);
  bf16_t* Ow = Ob + (long)(wid * QBLK) * ldo;
#pragma unroll
  for (int r = 0; r < 16; ++r) { int orow = crow(r, hi);
#pragma unroll
    for (int d0 = 0; d0 < 4; ++d0) Ow[(long)orow * ldo + d0 * 32 + r32] = f2bf(o[d0][r] * rli[r]); }
#undef SLOAD
#undef SWRITE
#undef SWAIT
#undef RESC
}
struct AttnJob { const bf16_t* Q; const bf16_t* Q2; int ldq, qhs; const bf16_t* K; int ldk, khs; long kbs; const bf16_t* K2; int ldk2; const bf16_t* V; int ldv; bf16_t* O; int H, gshift, seq, nunits; float scale; };
template <int DQK, int SDEPTH>
__device__ __forceinline__ void run_attn(const AttnJob& a, char* lds) {
  for (int u = blockIdx.x; u < a.nunits; u += gridDim.x) {
    const int per_b = a.H * 32, b = u / per_b, rest = u - b * per_b, h = rest % a.H, qb = rest / a.H, kh = h >> a.gshift;
    const long tok0 = (long)b * SEQ + qb * 256;
    attn_body<DQK, SDEPTH>(a.Q + tok0 * a.ldq + h * a.qhs, a.Q2 + tok0 * a.ldq + h * 64, a.ldq, a.K + (long)b * a.kbs + kh * a.khs, a.ldk, a.K2 + (long)b * SEQ * a.ldk2, a.ldk2,
                           a.V + (long)b * a.kbs + kh * a.khs, a.ldv, a.O + tok0 * 1536 + h * 128, 1536, a.seq, a.scale, lds);
  }
}
}

__device__ __forceinline__ void rms_rows(const float* __restrict__ src, const float* __restrict__ gain, bf16_t* __restrict__ dst, int nrows) {
  const int tid_ = opaque_tid(), wid = tid_ >> 6, lane = tid_ & 63;
  for (int row = blockIdx.x * 8 + wid; row < nrows; row += gridDim.x * 8) {
    const f32x4* s = (const f32x4*)(src + (size_t)row * DM);
    f32x4 v[4]; float ss = 0.f;
#pragma unroll
    for (int j = 0; j < 4; ++j) { v[j] = s[lane + 64 * j]; ss += v[j][0] * v[j][0] + v[j][1] * v[j][1] + v[j][2] * v[j][2] + v[j][3] * v[j][3]; }
    ss = wave_sum(ss);
    const float rs = rsqrtf(ss * (1.f / DM) + EPS);
#pragma unroll
    for (int j = 0; j < 4; ++j) { const f32x4 g = ((const f32x4*)gain)[lane + 64 * j];
      u32x2 w; w.x = cvtpk(v[j][0] * rs * g[0], v[j][1] * rs * g[1]); w.y = cvtpk(v[j][2] * rs * g[2], v[j][3] * rs * g[3]);
      *(u32x2*)(dst + (size_t)row * DM + (lane + 64 * j) * 4) = w; }
  }
}
template <int MODE>
__device__ __forceinline__ void prep_w(const float* __restrict__ src, int K, int Nsrc, bf16_t* __restrict__ dst, int Ndst, const float* __restrict__ kgain) {
  const long total = (long)Ndst * (K / 8);
  for (long i = (long)blockIdx.x * 512 + opaque_tid(); i < total; i += (long)gridDim.x * 512) {
    const int n = (int)(i % Ndst), k8 = (int)(i / Ndst);
    int ns = n;
    if (MODE == 1) { const int pn = n >> 8, r = n & 255, bj = r >> 7, ii = r & 127; ns = bj * DFF + pn * 128 + ii; }
    if (MODE == 2) { ns = n < 640 ? n : (n < 1152 ? n + 64 : (n < 1216 ? n - 512 : Nsrc)); }
    if (MODE == 3) { ns = n < 1024 ? (n >> 7) * 192 + (n & 127) : ((n - 1024) >> 6) * 192 + 128 + ((n - 1024) & 63); }
    float x[8];
#pragma unroll
    for (int j = 0; j < 8; ++j) x[j] = (ns < Nsrc) ? src[(size_t)(k8 * 8 + j) * Nsrc + ns] : 0.f;
    if (kgain) {
#pragma unroll
      for (int j = 0; j < 8; ++j) x[j] *= kgain[k8 * 8 + j];
    }
    u32x4 w; w.x = cvtpk(x[0], x[1]); w.y = cvtpk(x[2], x[3]); w.z = cvtpk(x[4], x[5]); w.w = cvtpk(x[6], x[7]);
    *(u32x4*)(dst + (size_t)n * K + k8 * 8) = w;
  }
}
__device__ __forceinline__ void unpack8(u32x4 w, float* v) {
#pragma unroll
  for (int i = 0; i < 4; ++i) { v[2 * i] = __uint_as_float(w[i] << 16); v[2 * i + 1] = __uint_as_float(w[i] & 0xffff0000u); }
}
__device__ __forceinline__ u32x4 pack8(const float* v) { u32x4 w; w.x = cvtpk(v[0], v[1]); w.y = cvtpk(v[2], v[3]); w.z = cvtpk(v[4], v[5]); w.w = cvtpk(v[6], v[7]); return w; }
__device__ __forceinline__ float sumsq8(const float* v) { float s = 0.f;
#pragma unroll
  for (int j = 0; j < 8; ++j) s += v[j] * v[j];
  return s; }
template <int GL> __device__ __forceinline__ float group_sum(float s) {
#pragma unroll
  for (int o = 1; o < GL; o <<= 1) s += __shfl_xor(s, o, 64);
  return s;
}
__device__ __forceinline__ void load8(float* g, const float* __restrict__ p) { const f32x4 a = *(const f32x4*)p, b = *(const f32x4*)(p + 4);
  g[0] = a[0]; g[1] = a[1]; g[2] = a[2]; g[3] = a[3]; g[4] = b[0]; g[5] = b[1]; g[6] = b[2]; g[7] = b[3]; }
template <int GL> __device__ __forceinline__ void norm8(float* v, const float* g) {
  const float ss = group_sum<GL>(sumsq8(v)); const float rs = rsqrtf(ss * (1.f / (GL * 8)) + EPS);
#pragma unroll
  for (int j = 0; j < 8; ++j) v[j] *= rs * g[j];
}
template <int XM> __device__ __forceinline__ void rope8(float* v, const float* inv, float pos, bool first) {
#pragma unroll
  for (int j = 0; j < 8; ++j) {
    const float partner = __shfl_xor(v[j], XM, 64);
    float rev = pos * inv[j] * INV2PI; rev -= floorf(rev);
    const float c = __builtin_amdgcn_cosf(rev), s = __builtin_amdgcn_sinf(rev);
    v[j] = first ? v[j] * c - partner * s : v[j] * c + partner * s;
  }
}
template <int NE> __device__ __forceinline__ void ld_seg(float* v, const bf16_t* p, int lane) {
#pragma unroll
  for (int j = 0; j < NE; ++j) v[j] = bf2f(p[lane + 64 * j]);
}
template <int NE> __device__ __forceinline__ void st_seg(const float* v, bf16_t* p, int lane) {
#pragma unroll
  for (int j = 0; j < NE; ++j) p[lane + 64 * j] = f2bf(v[j]);
}
template <int NE, int ROPE> __device__ __forceinline__ void norm_seg(float* v, const float* __restrict__ gain, int lane, int prow, int pcol) {
  float ss = 0.f;
#pragma unroll
  for (int j = 0; j < NE; ++j) ss += v[j] * v[j];
  ss = wave_sum(ss);
  const float rs = rsqrtf(ss * (1.f / (64 * NE)) + EPS);
#pragma unroll
  for (int j = 0; j < NE; ++j) v[j] = v[j] * rs * gain[lane + 64 * j];
  if constexpr (ROPE && NE == 2) {
    const int f = lane & 31; const float inv = exp2f(-(float)(2 * f) * (1.f / 64.f) * LOG2_THETA);
#pragma unroll
    for (int j = 0; j < 2; ++j) {
      const float partner = __shfl_xor(v[j], 32, 64);
      const float ang = (float)(j == 0 ? prow : pcol) * inv;
      float rev = ang * INV2PI; rev -= floorf(rev);
      const float c = __builtin_amdgcn_cosf(rev), s = __builtin_amdgcn_sinf(rev);
      v[j] = (lane < 32) ? v[j] * c - partner * s : v[j] * c + partner * s;
    }
  }
  if constexpr (ROPE && NE == 1) {
    const int f = lane & 15; const float inv = exp2f(-(float)(2 * f) * (1.f / 32.f) * LOG2_THETA);
    const float partner = __shfl_xor(v[0], 16, 64);
    const float ang = (float)(lane < 32 ? prow : pcol) * inv;
    float rev = ang * INV2PI; rev -= floorf(rev);
    const float c = __builtin_amdgcn_cosf(rev), s = __builtin_amdgcn_sinf(rev);
    v[0] = (lane & 16) ? v[0] * c + partner * s : v[0] * c - partner * s;
  }
}

#define XB_TMO      128
#define XB_XCNT(j)  (256  + 64 * (j))
#define XB_XSUB(j)  (1280 + 64 * (j))
#define XB_XGEN(j)  (2304 + 64 * (j))
#define XB_TOP      3328
#define XB_TOPGEN   3392
#define XCD_BAR_WORDS 3456
#define XB_SPIN_CAP (1u << 22)
__device__ __forceinline__ unsigned xb_ld(unsigned* p)              { return __hip_atomic_load(p, __ATOMIC_RELAXED, __HIP_MEMORY_SCOPE_AGENT); }
__device__ __forceinline__ unsigned xb_add(unsigned* p, unsigned v) { return __hip_atomic_fetch_add(p, v, __ATOMIC_RELAXED, __HIP_MEMORY_SCOPE_AGENT); }
__device__ __forceinline__ unsigned xb_xcc_id() { return (unsigned)__builtin_amdgcn_s_getreg((3 << 11) | 20) & 0xFu; }
#define XB_SPIN(cond, bar) do { unsigned _sp = 0; while (cond) { __builtin_amdgcn_s_sleep(1); \
    if ((++_sp & 255u) == 0u) { if (xb_ld(&(bar)[XB_TMO])) break; if (_sp > XB_SPIN_CAP) { atomicAdd(&(bar)[XB_TMO], 1u); break; } } } } while (0)
struct XcdBarrier { unsigned* bar; unsigned x; volatile LAS unsigned* st; };
__device__ __forceinline__ XcdBarrier xcd_barrier_post(unsigned* bar, volatile LAS unsigned* st) {
  XcdBarrier b; b.bar = bar; b.x = xb_xcc_id(); b.st = st;
  if (threadIdx.x == 0) (void)xb_add(&bar[XB_XCNT(b.x)], 1u);
  return b;
}
__device__ __forceinline__ void xcd_barrier_complete(unsigned* bar, unsigned x, unsigned& nloc, unsigned& nx) {
  const unsigned G = gridDim.x * gridDim.y * gridDim.z;
  unsigned sum, cnt, mine, sp = 0u;
  for (;;) {
    sum = 0u; cnt = 0u; mine = 0u;
#pragma unroll
    for (unsigned j = 0; j < 16; ++j) { const unsigned c = xb_ld(&bar[XB_XCNT(j)]); sum += c; cnt += (c > 0u) ? 1u : 0u; mine = (j == x) ? c : mine; }
    if (sum == G) break;
    __builtin_amdgcn_s_sleep(1);
    if ((++sp & 255u) == 0u) { if (xb_ld(&bar[XB_TMO])) break; if (sp > XB_SPIN_CAP) { atomicAdd(&bar[XB_TMO], 1u); break; } }
  }
  nloc = mine > 0u ? mine : 1u; nx = cnt > 0u ? cnt : 1u;
}
__device__ __forceinline__ void xcd_barrier(const XcdBarrier& b) {
  asm volatile("s_waitcnt vmcnt(0)" ::: "memory");
  __syncthreads();
  if (threadIdx.x == 0) {
    unsigned* bar = b.bar;
    __builtin_amdgcn_s_waitcnt(0);
    unsigned nloc = b.st[0], nx = b.st[1];
    if (nloc == 0u) { xcd_barrier_complete(bar, b.x, nloc, nx); b.st[0] = nloc; b.st[1] = nx; }
    const unsigned old = xb_add(&bar[XB_XSUB(b.x)], 1u);
    const unsigned gen = old / nloc;
    if (old + 1u == (gen + 1u) * nloc) {
      __builtin_amdgcn_fence(__ATOMIC_RELEASE, "agent");
      asm volatile("s_waitcnt vmcnt(0)" ::: "memory");
      const unsigned og = xb_add(&bar[XB_TOP], 1u);
      const unsigned tg = og / nx;
      if (og + 1u == (tg + 1u) * nx) xb_add(&bar[XB_TOPGEN], 1u);
      else XB_SPIN(xb_ld(&bar[XB_TOPGEN]) == tg, bar);
      __builtin_amdgcn_fence(__ATOMIC_ACQUIRE, "agent");
      xb_add(&bar[XB_XGEN(b.x)], 1u);
      asm volatile("s_waitcnt vmcnt(0)" ::: "memory");
    } else {
      XB_SPIN(xb_ld(&bar[XB_XGEN(b.x)]) == gen, bar);
      __builtin_amdgcn_fence(__ATOMIC_ACQUIRE, "agent");
      asm volatile("s_waitcnt vmcnt(0)" ::: "memory");
    }
  }
  __syncthreads();
}

constexpr int LDS_MAIN = pg8::STAGE_BYTES;
constexpr int LDS_BYTES = LDS_MAIN + 16;
static_assert(att::SHM_ATTN <= LDS_MAIN, "lds");
constexpr int NPHASE = 18;
#ifndef PHMASK
#define PHMASK 0xf
#endif
#ifndef REPMASK
#define REPMASK 0
#endif
#ifndef A128_SD
#define A128_SD 1
#endif
#ifndef KARG
#define KARG 0
#endif
#define wt_in0 ((bf16_t*)(p.ws + WS_WT_IN0))
#define wt_qb ((bf16_t*)(p.ws + WS_WT_QB))
#define wt_kvb ((bf16_t*)(p.ws + WS_WT_KVB))
#define wt_out ((bf16_t*)(p.ws + WS_WT_OUT))
#define wt_memkv ((bf16_t*)(p.ws + WS_WT_MEMKV))
#define wt_gu ((bf16_t*)(p.ws + WS_WT_GU))
#define wt_dn ((bf16_t*)(p.ws + WS_WT_DN))
#define wt_in1 ((bf16_t*)(p.ws + WS_WT_IN1))
#define memn ((bf16_t*)(p.ws + WS_MEMN))
#define memkv ((bf16_t*)(p.ws + WS_MEMKV))
#define hbuf ((bf16_t*)(p.ws + WS_HM))
#define mix ((bf16_t*)(p.ws + WS_HM))
#define proj ((bf16_t*)(p.ws + WS_R))
#define act ((bf16_t*)(p.ws + WS_R))
#define qbuf ((bf16_t*)(p.ws + WS_Q))
#define kvbuf ((bf16_t*)(p.ws + WS_KV))

struct GemmJob { const bf16_t* A; int lda; const bf16_t* Bt; int M, N, K; int kind; bf16_t* O; int ldc; const float* res; int coff; };

__device__ __forceinline__ int gemm_jobs(const Params& p, int ph, int gi, GemmJob& j) {
  const float* x = p.in[0];
  j.M = NTOK; j.res = nullptr; j.coff = 0; j.O = nullptr; j.ldc = 0;
  switch (ph) {
  case 1:
    if (gi == 0) { j.A = hbuf; j.lda = 1024; j.Bt = wt_in0; j.N = 1280; j.K = 1024; j.kind = 0; j.O = proj; j.ldc = 1280; }
    else { j.A = memn; j.lda = 1024; j.Bt = wt_memkv + (size_t)(gi - 1) * 1024 * 1024; j.M = NMEMROWS; j.N = 1024; j.K = 1024; j.kind = 0; j.O = memkv + (size_t)(gi - 1) * NMEMROWS * 1024; j.ldc = 1024; j.coff = (gi - 1) * 128; }
    return 3;
  case 3:
    if (gi == 0) { j.A = proj; j.lda = 1280; j.Bt = wt_qb; j.N = 1536; j.K = 384; j.kind = 0; j.O = qbuf; j.ldc = 1536; }
    else { j.A = proj + 384; j.lda = 1280; j.Bt = wt_kvb; j.N = 2048; j.K = 256; j.kind = 0; j.O = kvbuf; j.ldc = 2048; }
    return 2;
  case 6: case 14: { const int L = ph == 6 ? 0 : 1;
    j.A = mix; j.lda = 1536; j.Bt = wt_out + (size_t)L * 1024 * 1536; j.N = 1024; j.K = 1536; j.kind = 1; j.res = L == 0 ? x : p.out; return 1; }
  case 8: case 16: { const int L = ph == 8 ? 0 : 1;
    j.A = hbuf; j.lda = 1024; j.Bt = wt_gu + (size_t)L * 5632 * 1024; j.N = 5632; j.K = 1024; j.kind = 2; j.O = act; return 1; }
  case 9: case 17: { const int L = ph == 9 ? 0 : 1;
    j.A = act; j.lda = DFF; j.Bt = wt_dn + (size_t)L * 1024 * 2816; j.N = 1024; j.K = DFF; j.kind = 1; j.res = p.out; return 1; }
  case 11:
    j.A = hbuf; j.lda = 1024; j.Bt = wt_in1; j.N = 2048; j.K = 1024; j.kind = 0; j.O = proj; j.ldc = 2048; return 1;
  default: return 0;
  }
}

__global__ __launch_bounds__(512) void mega(Params p_) {
  extern __shared__ __attribute__((aligned(16))) unsigned char shm[];
  LAS unsigned char* glds = (LAS unsigned char*)shm;
  char* alds = (char*)shm;
  const Params* pp = (const Params*)__builtin_amdgcn_kernarg_segment_ptr();
  const int ph_lo = p_.ph_lo, ph_hi = p_.ph_hi;
  volatile LAS unsigned* bst = (volatile LAS unsigned*)(glds + LDS_MAIN);
  if (threadIdx.x == 0) { bst[0] = 0u; bst[1] = 0u; }
  __syncthreads();
  const XcdBarrier xb = xcd_barrier_post((unsigned*)(p_.ws + WS_BAR), bst);
  if (ph_lo < 0) cg::this_grid().sync();

  for (int ph = ph_lo; ph < ph_hi; ++ph) {
    if (ph == 2) continue;
#if KARG
    asm volatile("" : "+s"(pp));
    const Params& p = *pp;
#else
    const Params& p = p_;
#endif
    const float* x = p.in[0];
    for (int rep = 0; rep < 1 + ((REPMASK >> ph) & 1); ++rep) {
    const int tid_ = opaque_tid(), wid = tid_ >> 6, lane = tid_ & 63;
    const int gw = blockIdx.x * 8 + wid, nw = gridDim.x * 8;
    if (PHMASK & 1) switch (ph) {
    case 0: {
      prep_w<2>(p.in[11], 1024, 1216, wt_in0, 1280, nullptr);
      prep_w<3>(p.in[13], 384, 1536, wt_qb, 1536, p.in[12]);
      prep_w<0>(p.in[15], 256, 2048, wt_kvb, 2048, p.in[14]);
      for (int i = 0; i < 2; ++i) {
        prep_w<0>(p.in[5] + (size_t)i * 1536 * 1024, 1536, 1024, wt_out + (size_t)i * 1024 * 1536, 1024, nullptr);
        prep_w<0>(p.in[6] + (size_t)i * 1024 * 1024, 1024, 1024, wt_memkv + (size_t)i * 1024 * 1024, 1024, nullptr);
        prep_w<1>(p.in[9] + (size_t)i * 1024 * 5632, 1024, 5632, wt_gu + (size_t)i * 5632 * 1024, 5632, nullptr);
        prep_w<0>(p.in[10] + (size_t)i * 2816 * 1024, 2816, 1024, wt_dn + (size_t)i * 1024 * 2816, 1024, nullptr);
      }
      prep_w<0>(p.in[18], 1024, 2048, wt_in1, 2048, nullptr);
      rms_rows(p.in[1], p.in[2], memn, NMEMROWS);
      rms_rows(x, p.in[3], hbuf, NTOK);
    } break;
    case 4: {
      const int l16 = lane & 15, l8 = lane & 7;
      float inv64[8], g_mq[8], g_qn[8], g_qp[8], g_kn[8], g_kp[8];
#pragma unroll
      for (int j = 0; j < 8; ++j) inv64[j] = exp2f(-(float)(2 * ((l8 & 1) * 8 + j)) * (1.f / 32.f) * LOG2_THETA);
      load8(g_mq, p.in[7] + l16 * 8); load8(g_qn, p.in[16] + l16 * 8); load8(g_qp, p.in[16] + 128 + l8 * 8); load8(g_kn, p.in[17] + l16 * 8); load8(g_kp, p.in[17] + 128 + l8 * 8);
      const bool first64 = !(l8 & 2);
      for (int t = gw; t < NTOK; t += nw) {
        const int sq = t & (SEQ - 1); const float pos64 = (float)((l8 < 4) ? (sq >> 6) : (sq & 63));
        bf16_t* pr = proj + (size_t)t * 1280 + lane * 8; bf16_t* qrow = qbuf + (size_t)t * 1536 + lane * 8; bf16_t* kvrow = kvbuf + (size_t)t * 2048 + lane * 8;
        const u32x4 P0 = *(const u32x4*)pr, P1 = *(const u32x4*)(pr + 512);
        u32x4 P2 = {0u, 0u, 0u, 0u}; if (lane < 32) P2 = *(const u32x4*)(pr + 1024);
        const u32x4 Q0 = *(const u32x4*)qrow, Q1 = *(const u32x4*)(qrow + 512), Q2 = *(const u32x4*)(qrow + 1024);
        const u32x4 KV0 = *(const u32x4*)kvrow, KV1 = *(const u32x4*)(kvrow + 512), KV2 = *(const u32x4*)(kvrow + 1024), KV3 = *(const u32x4*)(kvrow + 1536);
        float a[8], b[8];
        unpack8(P0, a); unpack8(P1, b);
        const float s0 = sumsq8(a), s1 = sumsq8(b);
        const float ssq = wave_sum(lane < 48 ? s0 : 0.f), sskv = wave_sum((lane >= 48 ? s0 : 0.f) + (lane < 16 ? s1 : 0.f));
        const float rs_q = rsqrtf(ssq * (1.f / 384.f) + EPS), rs_kv = rsqrtf(sskv * (1.f / 256.f) + EPS);
        norm8<16>(b, g_mq); if (lane >= 16) *(u32x4*)(pr + 512) = pack8(b);
        unpack8(P2, a);
        { const float s8 = group_sum<8>(sumsq8(a)), s16 = s8 + __shfl_xor(s8, 8, 64);
          const float rsA = rsqrtf(s16 * (1.f / 128.f) + EPS), rsB = rsqrtf(s8 * (1.f / 64.f) + EPS);
#pragma unroll
          for (int j = 0; j < 8; ++j) { b[j] = a[j] * rsB * g_kp[j]; a[j] = a[j] * rsA * g_mq[j]; }
          rope8<2>(b, inv64, pos64, first64);
#pragma unroll
          for (int j = 0; j < 8; ++j) a[j] = lane < 16 ? a[j] : b[j];
          if (lane < 24) *(u32x4*)(pr + 1024) = pack8(a); }
        unpack8(Q0, a);
#pragma unroll
        for (int j = 0; j < 8; ++j) a[j] *= rs_q;
        norm8<16>(a, g_qn); *(u32x4*)qrow = pack8(a);
        unpack8(Q1, a);
#pragma unroll
        for (int j = 0; j < 8; ++j) a[j] *= rs_q;
        norm8<16>(a, g_qn); *(u32x4*)(qrow + 512) = pack8(a);
        unpack8(Q2, a);
#pragma unroll
        for (int j = 0; j < 8; ++j) a[j] *= rs_q;
        norm8<8>(a, g_qp); rope8<2>(a, inv64, pos64, first64); *(u32x4*)(qrow + 1024) = pack8(a);
        const bool is_k = !((lane >> 4) & 1);
#define KVCHUNK(W, OFF) do { unpack8(W, a); _Pragma("unroll") for (int j = 0; j < 8; ++j) { a[j] *= rs_kv; b[j] = a[j]; } norm8<16>(b, g_kn); \
          _Pragma("unroll") for (int j = 0; j < 8; ++j) a[j] = is_k ? b[j] : a[j]; *(u32x4*)(kvrow + (OFF)) = pack8(a); } while (0)
        KVCHUNK(KV0, 0); KVCHUNK(KV1, 512); KVCHUNK(KV2, 1024); KVCHUNK(KV3, 1536);
#undef KVCHUNK
      }
      for (int r = gw; r < 2 * NMEMROWS; r += nw) {
        float g_mk[8]; load8(g_mk, p.in[8] + (r / NMEMROWS) * 128 + l16 * 8);
        bf16_t* row = memkv + (size_t)r * 1024 + lane * 8;
        float a[8]; unpack8(*(const u32x4*)row, a); norm8<16>(a, g_mk); *(u32x4*)row = pack8(a);
      }
    } break;
    case 7: case 15: rms_rows(p.out, p.in[4] + (ph == 7 ? 0 : 1024), hbuf, NTOK); break;
    case 10: rms_rows(p.out, p.in[3] + 1024, hbuf, NTOK); break;
    case 12: {
      const int l16 = lane & 15;
      float inv128[8], g_q[8], g_k[8], g_mq[8];
#pragma unroll
      for (int j = 0; j < 8; ++j) inv128[j] = exp2f(-(float)(2 * ((l16 & 3) * 8 + j)) * (1.f / 64.f) * LOG2_THETA);
      load8(g_q, p.in[19] + l16 * 8); load8(g_k, p.in[20] + l16 * 8); load8(g_mq, p.in[7] + 128 + l16 * 8);
      const bool first128 = !(l16 & 4);
      for (int t = gw; t < NTOK; t += nw) {
        const int sq = t & (SEQ - 1); const float pos128 = (float)((l16 < 8) ? (sq >> 6) : (sq & 63));
        bf16_t* row = proj + (size_t)t * 2048 + lane * 8;
        const u32x4 W0 = *(const u32x4*)row, W1 = *(const u32x4*)(row + 512), W2 = *(const u32x4*)(row + 1024), W3 = *(const u32x4*)(row + 1536);
        float a[8];
        unpack8(W0, a); norm8<16>(a, g_q); rope8<4>(a, inv128, pos128, first128); *(u32x4*)row = pack8(a);
        unpack8(W1, a); norm8<16>(a, g_q); rope8<4>(a, inv128, pos128, first128); *(u32x4*)(row + 512) = pack8(a);
        unpack8(W2, a); norm8<16>(a, g_k); rope8<4>(a, inv128, pos128, first128); if (lane < 32) *(u32x4*)(row + 1024) = pack8(a);
        unpack8(W3, a); norm8<16>(a, g_mq); *(u32x4*)(row + 1536) = pack8(a);
      }
    } break;
    default: break;
    }
    if (PHMASK & 2) {
      GemmJob j; const int ng = gemm_jobs(p, ph, 0, j);
      for (int gi = 0; gi < ng; ++gi) {
        if (gi) gemm_jobs(p, ph, gi, j);
        if (j.kind == 0) pg8::run_gemm(glds, j.A, j.lda, j.Bt, j.M, j.N, j.K, pg8::EpiBf16{j.O, j.ldc}, j.coff);
        else if (j.kind == 1) pg8::run_gemm(glds, j.A, j.lda, j.Bt, j.M, j.N, j.K, pg8::EpiResF32{p.out, j.res}, j.coff);
        else pg8::run_gemm(glds, j.A, j.lda, j.Bt, j.M, j.N, j.K, pg8::EpiSwiGLU{j.O}, j.coff);
      }
    }
    if ((PHMASK & 12) && (ph == 5 || ph == 13)) {
      const int L = ph == 5 ? 0 : 1;
      att::AttnJob a;
      if (L == 0) {
        a.Q = qbuf; a.Q2 = qbuf + 1024; a.ldq = 1536; a.qhs = 128; a.K = kvbuf; a.ldk = 2048; a.khs = 256; a.kbs = (long)SEQ * 2048; a.K2 = proj + 1152; a.ldk2 = 1280;
        a.V = kvbuf + 128; a.ldv = 2048; a.O = mix; a.H = 8; a.gshift = 0; a.seq = SEQ; a.nunits = 2048; a.scale = 0.072168783648703220f;
        if (PHMASK & 4) att::run_attn<192, 1>(a, alds);
      } else {
        a.Q = proj; a.Q2 = proj; a.ldq = 2048; a.qhs = 128; a.K = proj + 1024; a.ldk = 2048; a.khs = 128; a.kbs = (long)SEQ * 2048; a.K2 = proj; a.ldk2 = 0;
        a.V = proj + 1280; a.ldv = 2048; a.O = mix; a.H = 8; a.gshift = 2; a.seq = SEQ; a.nunits = 2048; a.scale = 0.088388347648318440f;
      }
      for (int pass = (L == 0 ? 1 : 0); pass < 2; ++pass) {
        if (pass == 1) {
          a.Q = L == 0 ? proj + 640 : proj + 1536; a.Q2 = a.Q; a.ldq = L == 0 ? 1280 : 2048; a.qhs = 128;
          a.K = memkv + (size_t)L * NMEMROWS * 1024; a.ldk = 1024; a.khs = 128; a.kbs = 256 * 1024; a.K2 = a.K; a.ldk2 = 0;
          a.V = a.K + 512; a.ldv = 1024; a.O = mix + 1024; a.H = 4; a.gshift = 0; a.seq = 256; a.nunits = 1024; a.scale = 0.088388347648318440f;
        }
        if (PHMASK & 8) att::run_attn<128, A128_SD>(a, alds);
      }
    }
    }
    if (ph + 1 < ph_hi) xcd_barrier(xb);
  }
}

extern "C" void kernel_launch(void* const* d_in, const int* in_sizes, int n_in, void* d_out, int out_size, void* d_ws, size_t ws_size, hipStream_t stream) {
  static int grid = 0;
  if (grid == 0) {
    if (n_in != 21 || in_sizes[0] != NTOK * DM || out_size != NTOK * DM || ws_size < WS_END) {
      fprintf(stderr, "kernel_launch: shape/workspace mismatch (n_in %d, in0 %d, out %d, ws %zu, need %zu)\n", n_in, n_in > 0 ? in_sizes[0] : -1, out_size, ws_size, (size_t)WS_END);
      grid = -1; return; }
    int dev = 0, cus = 0, per_cu = 0;
    (void)hipGetDevice(&dev); (void)hipDeviceGetAttribute(&cus, hipDeviceAttributeMultiprocessorCount, dev);
    if (hipFuncSetAttribute((const void*)mega, hipFuncAttributeMaxDynamicSharedMemorySize, LDS_BYTES) != hipSuccess) { fprintf(stderr, "kernel_launch: hipFuncSetAttribute failed\n"); grid = -1; return; }
    if (hipOccupancyMaxActiveBlocksPerMultiprocessor(&per_cu, (const void*)mega, 512, LDS_BYTES) != hipSuccess || per_cu < 1) { fprintf(stderr, "kernel_launch: occupancy query says %d\n", per_cu); per_cu = 1; }
    (void)hipGetLastError();
    grid = cus * 1;
    if (grid <= 0) grid = 256;
  }
  if (grid < 0) return;
  if (hipMemsetAsync((char*)d_ws + WS_BAR, 0, XCD_BAR_WORDS * 4, stream) != hipSuccess) { fprintf(stderr, "kernel_launch: memset of barrier words failed\n"); return; }
  Params p{};
  for (int i = 0; i < 21; ++i) p.in[i] = (const float*)d_in[i];
  p.out = (float*)d_out; p.ws = (unsigned char*)d_ws;
#if MK_ONE_LAUNCH
  p.ph_lo = 0; p.ph_hi = NPHASE;
  void* args[] = {&p};
  hipError_t e = hipLaunchCooperativeKernel((const void*)mega, dim3(grid), dim3(512), args, LDS_BYTES, stream);
  if (e != hipSuccess) fprintf(stderr, "kernel_launch: cooperative launch failed: %s (grid %d)\n", hipGetErrorString(e), grid);
#else
  for (int ph = 0; ph < NPHASE; ++ph) {
    p.ph_lo = ph; p.ph_hi = ph + 1;
    hipLaunchKernelGGL(mega, dim3(grid), dim3(512), LDS_BYTES, stream, p);
  }
#endif
}
```

```cpp
#include <hip/hip_runtime.h>
#include <hip/hip_cooperative_groups.h>
#include <cstdio>
#include <cstdint>
namespace cg = cooperative_groups;

#ifndef MK_ONE_LAUNCH
#define MK_ONE_LAUNCH 1
#endif

typedef unsigned short bf16_t;
typedef short bf16x8 __attribute__((ext_vector_type(8)));
typedef short s16x4 __attribute__((ext_vector_type(4)));
typedef float f32x4 __attribute__((ext_vector_type(4)));
typedef float f32x16 __attribute__((ext_vector_type(16)));
typedef unsigned u32x4 __attribute__((ext_vector_type(4)));
typedef unsigned u32x2 __attribute__((ext_vector_type(2)));
#define LAS __attribute__((address_space(3)))

constexpr int NTOK = 65536, SEQ = 8192, DM = 1024, DFF = 2816, NMEMROWS = 2048;
constexpr float EPS = 1e-6f;
constexpr float LOG2_THETA = 13.287712379549449f;
constexpr float INV2PI = 0.15915494309189535f;
constexpr size_t MiB = 1ull << 20;
constexpr size_t WS_WT_IN0 = 0;
constexpr size_t WS_WT_QB = WS_WT_IN0 + 1280ull * 1024 * 2;
constexpr size_t WS_WT_KVB = WS_WT_QB + 1536ull * 384 * 2;
constexpr size_t WS_WT_OUT = WS_WT_KVB + 2048ull * 256 * 2;
constexpr size_t WS_WT_MEMKV = WS_WT_OUT + 2ull * 1024 * 1536 * 2;
constexpr size_t WS_WT_GU = WS_WT_MEMKV + 2ull * 1024 * 1024 * 2;
constexpr size_t WS_WT_DN = WS_WT_GU + 2ull * 5632 * 1024 * 2;
constexpr size_t WS_WT_IN1 = WS_WT_DN + 2ull * 1024 * 2816 * 2;
constexpr size_t WS_WT_END = WS_WT_IN1 + 2048ull * 1024 * 2;
static_assert(WS_WT_END <= 56 * MiB, "weights region");
constexpr size_t WS_MEMN = 56 * MiB;
constexpr size_t WS_MEMKV = 60 * MiB;
constexpr size_t WS_BAR = 70 * MiB;
constexpr size_t WS_ROWSS = 70 * MiB + 65536;
constexpr size_t WS_HM = 72 * MiB;
constexpr size_t WS_R = 264 * MiB;
constexpr size_t WS_Q = WS_R + 160 * MiB;
constexpr size_t WS_KV = WS_Q + 192 * MiB;
constexpr size_t WS_XB = WS_R + 352 * MiB;
constexpr size_t WS_END = WS_KV + 256 * MiB;

struct Params { const float* in[21]; float* out; unsigned char* ws; int ph_lo, ph_hi; };

__device__ __forceinline__ float bf2f(bf16_t v) { return __uint_as_float(((unsigned)v) << 16); }
__device__ __forceinline__ bf16_t f2bf(float f) { unsigned u = __float_as_uint(f); u += 0x7FFFu + ((u >> 16) & 1u); return (bf16_t)(u >> 16); }
__device__ __forceinline__ unsigned cvtpk(float lo, float hi) { unsigned r; asm volatile("v_cvt_pk_bf16_f32 %0, %1, %2" : "=v"(r) : "v"(lo), "v"(hi)); return r; }
__device__ __forceinline__ float wave_sum(float v) {
#pragma unroll
  for (int o = 32; o > 0; o >>= 1) v += __shfl_xor(v, o, 64);
  return v;
}

__device__ __forceinline__ int opaque_tid() { int t = threadIdx.x; asm volatile("" : "+v"(t)); return t; }

namespace pg8 {
constexpr int BM = 256, BK = 64, HALF = 128, HTB = HALF * BK * 2, STAGE_BYTES = 8 * HTB, NXCD = 8, WGM = 8;
__device__ __forceinline__ int lds_byte(int r, int c) { const int st = (r >> 4) * 2 + (c >> 5), rr = r & 15, cc = c & 31, ob = rr * 64 + cc * 2; return st * 1024 + (ob ^ (((ob >> 9) & 1) << 5)); }
__device__ __forceinline__ void stage_rc(int b, int& R, int& C) { const int st = b / 1024, sb = b % 1024, swz = sb ^ (((sb >> 9) & 1) << 5); R = (st >> 1) * 16 + swz / 64; C = (st & 1) * 32 + (swz % 64) / 2; }
__device__ __forceinline__ int perm32(int rho) { const int n = rho >> 4, i = rho & 15; return 8 * (i >> 2) + 4 * n + (i & 3); }
struct Unit { int pm, pn; };
struct Gemm { const bf16_t* A; const bf16_t* Bt; int M, N, K, lda; };
struct StaticOrder {
  int nM, nN, nwg, G, c;
  __device__ void init(int M, int N, int G_, int c_) { nM = M / BM; nN = N / BM; nwg = nM * nN; G = G_; c = c_; }
  __device__ bool next(int i, Unit& u) const {
    const long L = (long)i * G + c; if (L >= nwg) return false;
    int wgid = (int)L; { const int q = nwg / NXCD, r = nwg % NXCD, xcd = wgid % NXCD, off = wgid / NXCD; wgid = (xcd < r ? xcd * (q + 1) : r * (q + 1) + (xcd - r) * q) + off; }
    const int nig = WGM * nN, gid = wgid / nig, fm = gid * WGM, gsz = (nM - fm) < WGM ? (nM - fm) : WGM;
    u.pm = fm + ((wgid % nig) % gsz); u.pn = (wgid % nig) / gsz; return true;
  }
};

struct EpiBf16 {
  static constexpr bool PERM = true;
  bf16_t* O; int ldc; const float* rowss;
  __device__ __forceinline__ void operator()(const f32x4 (&acc)[2][2][4][2], const Unit& u, int wr, int wc, int fr, int fq) const {
    const int row0 = u.pm * BM + wr * 64 + fr, col0 = u.pn * BM + wc * 32 + 8 * fq;
#pragma unroll
    for (int ai = 0; ai < 2; ++ai)
#pragma unroll
      for (int m = 0; m < 4; ++m) { const int row = row0 + ai * HALF + m * 16; bf16_t* rowp = O + (size_t)row * ldc + col0;
        const float rs = rowss ? rsqrtf(rowss[row] * (1.f / DM) + EPS) : 1.f;
#pragma unroll
        for (int bj = 0; bj < 2; ++bj) { const f32x4 v0 = acc[ai][bj][m][0] * rs, v1 = acc[ai][bj][m][1] * rs;
          u32x4 w; w.x = cvtpk(v0[0], v0[1]); w.y = cvtpk(v0[2], v0[3]); w.z = cvtpk(v1[0], v1[1]); w.w = cvtpk(v1[2], v1[3]);
          *(u32x4*)(rowp + bj * HALF) = w; } }
  }
};
struct EpiResF32 {
  static constexpr bool PERM = false;
  float* out; const float* res; bf16_t* xb; float* rowss;
  __device__ __forceinline__ void operator()(const f32x4 (&acc)[2][2][4][2], const Unit& u, int wr, int wc, int fr, int fq) const {
    const int row0 = u.pm * BM + wr * 64 + fr, col0 = u.pn * BM + wc * 32 + 4 * fq;
#pragma unroll
    for (int ai = 0; ai < 2; ++ai)
#pragma unroll
      for (int mp = 0; mp < 4; mp += 2) {
        f32x4 r[2][2][2];
#pragma unroll
        for (int mm = 0; mm < 2; ++mm) { const size_t off = (size_t)(row0 + ai * HALF + (mp + mm) * 16) * DM + col0;
#pragma unroll
          for (int bj = 0; bj < 2; ++bj)
#pragma unroll
            for (int n = 0; n < 2; ++n) r[mm][bj][n] = *(const f32x4*)(res + off + bj * HALF + n * 16); }
#pragma unroll
        for (int mm = 0; mm < 2; ++mm) { const int row = row0 + ai * HALF + (mp + mm) * 16; const size_t off = (size_t)row * DM + col0;
          float ss = 0.f;
#pragma unroll
          for (int bj = 0; bj < 2; ++bj)
#pragma unroll
            for (int n = 0; n < 2; ++n) { const f32x4 v = r[mm][bj][n] + acc[ai][bj][mp + mm][n];
              *(f32x4*)(out + off + bj * HALF + n * 16) = v;
              if (xb) { u32x2 w; w.x = cvtpk(v[0], v[1]); w.y = cvtpk(v[2], v[3]); *(u32x2*)(xb + off + bj * HALF + n * 16) = w;
                ss += v[0] * v[0] + v[1] * v[1] + v[2] * v[2] + v[3] * v[3]; } }
          if (xb) { ss += __shfl_xor(ss, 16, 64); ss += __shfl_xor(ss, 32, 64); if (fq == 0) unsafeAtomicAdd(rowss + row, ss); }
        }
      }
  }
};
struct EpiSwiGLU {
  static constexpr bool PERM = true;
  bf16_t* O; const float* rowss;
  __device__ __forceinline__ void operator()(const f32x4 (&acc)[2][2][4][2], const Unit& u, int wr, int wc, int fr, int fq) const {
    const int row0 = u.pm * BM + wr * 64 + fr, col0 = u.pn * HALF + wc * 32 + 8 * fq;
#pragma unroll
    for (int ai = 0; ai < 2; ++ai)
#pragma unroll
      for (int m = 0; m < 4; ++m) { const int row = row0 + ai * HALF + m * 16; bf16_t* rowp = O + (size_t)row * DFF + col0;
        const float rs = rsqrtf(rowss[row] * (1.f / DM) + EPS);
        float y[8];
#pragma unroll
        for (int n = 0; n < 2; ++n)
#pragma unroll
          for (int j = 0; j < 4; ++j) { const float g = acc[ai][0][m][n][j] * rs, up = acc[ai][1][m][n][j] * rs;
            const float e = __builtin_amdgcn_exp2f(-g * 1.4426950408889634f);
            y[n * 4 + j] = g * __builtin_amdgcn_rcpf(1.0f + e) * up; }
        u32x4 w; w.x = cvtpk(y[0], y[1]); w.y = cvtpk(y[2], y[3]); w.z = cvtpk(y[4], y[5]); w.w = cvtpk(y[6], y[7]);
        *(u32x4*)rowp = w; }
  }
};

template <class Epi>
__device__ __forceinline__ void gemm_phase(LAS unsigned char* lds, const Gemm g, const StaticOrder& S, const Epi& E) {
  const int tid = opaque_tid(), wid = __builtin_amdgcn_readfirstlane(tid >> 6), lane = tid & 63, wr = wid >> 2, wc = wid & 3, fr = lane & 15, fq = lane >> 4;
  const int K = g.K, nt = K / BK, lda = g.lda;
  unsigned voffA[2], voffB[2];
#pragma unroll
  for (int i = 0; i < 2; ++i) { int R, C; stage_rc(tid * 16 + i * 8192, R, C); const int Rb = Epi::PERM ? ((R & ~31) + perm32(R & 31)) : R;
    voffA[i] = (unsigned)(R * lda + C) * 2u; voffB[i] = (unsigned)(Rb * K + C) * 2u; }
  const size_t kstep = (size_t)(BK * 2);
  const size_t hstepA = (size_t)HALF * lda * 2, hstepB = (size_t)HALF * K * 2;
  const size_t tstepA = 2 * hstepA, tstepB = 2 * hstepB;
  const unsigned ldsw = (unsigned)wid * 1024u;
  const int aoff = lds_byte(wr * 64 + fr, fq * 8), boff = lds_byte(wc * 32 + fr, fq * 8);
#define PG8_SA(b, h) (((b) * 2 + (h)) * HTB)
#define PG8_SB(b, h) ((4 + (b) * 2 + (h)) * HTB)
#define PG8_STAGE(bufoff, gbase, voff) do { _Pragma("unroll") for (int _i = 0; _i < 2; ++_i) \
    __builtin_amdgcn_global_load_lds((const unsigned*)((const char*)(gbase) + (voff)[_i]), (LAS unsigned*)(lds + (bufoff) + ldsw + _i * 8192), 16, 0, 0); } while (0)
#define PG8_LDA(dst, b, h) do { _Pragma("unroll") for (int m = 0; m < 4; ++m) _Pragma("unroll") for (int k = 0; k < 2; ++k) dst[m][k] = *(const LAS bf16x8*)(lds + PG8_SA(b, h) + aoff + m * 2048 + k * 1024); } while (0)
#define PG8_LDB(dst, b, h) do { _Pragma("unroll") for (int n = 0; n < 2; ++n) _Pragma("unroll") for (int k = 0; k < 2; ++k) dst[n][k] = *(const LAS bf16x8*)(lds + PG8_SB(b, h) + boff + n * 2048 + k * 1024); } while (0)
#define PG8_MMA(ai, bj, At, Bt) do { __builtin_amdgcn_s_setprio(1); _Pragma("unroll") for (int m = 0; m < 4; ++m) _Pragma("unroll") for (int n = 0; n < 2; ++n) _Pragma("unroll") for (int k = 0; k < 2; ++k) \
    acc[ai][bj][m][n] = __builtin_amdgcn_mfma_f32_16x16x32_bf16(Bt[n][k], At[m][k], acc[ai][bj][m][n], 0, 0, 0); __builtin_amdgcn_s_setprio(0); } while (0)
#define PG8_WAIT_V(n) asm volatile("s_waitcnt vmcnt(" #n ")" ::: "memory")
#define PG8_WAIT_L(n) asm volatile("s_waitcnt lgkmcnt(" #n ")" ::: "memory")
#define PG8_BAR __builtin_amdgcn_s_barrier()
#define PG8_SCHED __builtin_amdgcn_sched_barrier(0)
  Unit cur, nxt; int ui = 0;
  if (!S.next(0, cur)) return;
  f32x4 acc[2][2][4][2];
#pragma unroll
  for (int a = 0; a < 2; ++a)
#pragma unroll
    for (int b = 0; b < 2; ++b)
#pragma unroll
      for (int m = 0; m < 4; ++m)
#pragma unroll
        for (int n = 0; n < 2; ++n) acc[a][b][m][n] = (f32x4){0.f, 0.f, 0.f, 0.f};
  bf16x8 At[4][2], B0[2][2], B1[2][2];
  const char* cA = (const char*)g.A + (size_t)cur.pm * tstepA; const char* cB = (const char*)g.Bt + (size_t)cur.pn * tstepB;
  PG8_STAGE(PG8_SB(0, 0), cB, voffB); PG8_STAGE(PG8_SA(0, 0), cA, voffA); PG8_STAGE(PG8_SB(0, 1), cB + hstepB, voffB); PG8_STAGE(PG8_SA(0, 1), cA + hstepA, voffA);
  if (wr == 1) PG8_BAR;
  PG8_WAIT_V(4); PG8_BAR;
  PG8_STAGE(PG8_SB(1, 0), cB + kstep, voffB); PG8_STAGE(PG8_SA(1, 0), cA + kstep, voffA); PG8_STAGE(PG8_SB(1, 1), cB + hstepB + kstep, voffB);
  PG8_WAIT_V(6); PG8_BAR;
  for (;;) {
    const bool has_next = S.next(ui + 1, nxt);
    const char* nA = has_next ? (const char*)g.A + (size_t)nxt.pm * tstepA : cA; const char* nB = has_next ? (const char*)g.Bt + (size_t)nxt.pn * tstepB : cB;
    for (int t = 0; t < nt; t += 2) {
      const bool last = (t == nt - 2);
      const char* a1 = cA + (size_t)(t + 1) * kstep;
      const char* a2 = last ? nA : cA + (size_t)(t + 2) * kstep; const char* b2 = last ? nB : cB + (size_t)(t + 2) * kstep;
      const char* a3 = a2 + kstep; const char* b3 = b2 + kstep;
      PG8_LDB(B0, 0, 0); PG8_SCHED; PG8_LDA(At, 0, 0); PG8_STAGE(PG8_SA(1, 1), a1 + hstepA, voffA);
      PG8_WAIT_L(8); PG8_BAR; PG8_WAIT_L(0); PG8_MMA(0, 0, At, B0); PG8_BAR; PG8_SCHED;
      PG8_LDB(B1, 0, 1); PG8_STAGE(PG8_SB(0, 0), b2, voffB);
      PG8_BAR; PG8_WAIT_L(0); PG8_MMA(0, 1, At, B1); PG8_BAR;
      PG8_LDA(At, 0, 1); PG8_STAGE(PG8_SA(0, 0), a2, voffA);
      PG8_BAR; PG8_WAIT_L(0); PG8_MMA(1, 0, At, B0); PG8_BAR; PG8_SCHED;
      PG8_STAGE(PG8_SB(0, 1), b2 + hstepB, voffB);
      PG8_WAIT_V(6); PG8_BAR; PG8_MMA(1, 1, At, B1); PG8_BAR;
      PG8_LDB(B0, 1, 0); PG8_SCHED; PG8_LDA(At, 1, 0); PG8_STAGE(PG8_SA(0, 1), a2 + hstepA, voffA);
      PG8_WAIT_L(8); PG8_BAR; PG8_WAIT_L(0); PG8_MMA(0, 0, At, B0); PG8_BAR; PG8_SCHED;
      PG8_LDB(B1, 1, 1); PG8_STAGE(PG8_SB(1, 0), b3, voffB);
      PG8_BAR; PG8_WAIT_L(0); PG8_MMA(0, 1, At, B1); PG8_BAR;
      PG8_LDA(At, 1, 1); PG8_STAGE(PG8_SA(1, 0), a3, voffA);
      PG8_BAR; PG8_WAIT_L(0); PG8_MMA(1, 0, At, B0); PG8_BAR; PG8_SCHED;
      PG8_STAGE(PG8_SB(1, 1), b3 + hstepB, voffB);
      PG8_WAIT_V(6); PG8_BAR; PG8_MMA(1, 1, At, B1); PG8_BAR;
    }
    E(acc, cur, wr, wc, fr, fq);
    if (!has_next) break;
#pragma unroll
    for (int a = 0; a < 2; ++a)
#pragma unroll
      for (int b = 0; b < 2; ++b)
#pragma unroll
        for (int m = 0; m < 4; ++m)
#pragma unroll
          for (int n = 0; n < 2; ++n) acc[a][b][m][n] = (f32x4){0.f, 0.f, 0.f, 0.f};
    cur = nxt; cA = nA; cB = nB; ++ui;
  }
  PG8_WAIT_V(0);
  if (wr == 0) PG8_BAR;
  PG8_BAR;
#undef PG8_SA
#undef PG8_SB
#undef PG8_STAGE
#undef PG8_LDA
#undef PG8_LDB
#undef PG8_MMA
#undef PG8_WAIT_V
#undef PG8_WAIT_L
#undef PG8_BAR
#undef PG8_SCHED
}
template <class Epi>
__device__ __forceinline__ void run_gemm(LAS unsigned char* lds, const bf16_t* A, int lda, const bf16_t* Bt, int M, int N, int K, const Epi& E, int coff) {
  Gemm g{A, Bt, M, N, K, lda};
  StaticOrder S; S.init(M, N, (int)gridDim.x, (int)((blockIdx.x + coff) % gridDim.x));
  gemm_phase<Epi>(lds, g, S, E);
}
}

namespace att {
constexpr int NW = 8, QBLK = 32, KVBLK = 64;
constexpr float THR = 8.f;
constexpr int SHM_V = KVBLK * 128 * 2, SHM_K = KVBLK * 128 * 2, SHM_K2 = KVBLK * 64 * 2;
constexpr int OFF_K = 2 * SHM_V, OFF_K2 = OFF_K + 2 * SHM_K, OFF_WS = OFF_K2 + 2 * SHM_K2, OFF_Q2 = OFF_WS + NW * 64 * 4, SHM_ATTN = OFF_Q2 + 32768;
#define KSWZ(row, colB) ((row) * 256 + ((colB) ^ (((row) & 7) << 4)))
#define K2SWZ(row, colB) ((row) * 128 + ((colB) ^ ((((row) >> 1) & 7) << 4)))
#define SBAR() __builtin_amdgcn_sched_barrier(0)
__device__ __forceinline__ int crow(int r, int hi) { return (r & 3) + 8 * (r >> 2) + 4 * hi; }
__device__ __forceinline__ void partialSM(f32x16& p0, f32x16& p1, float& m_reg, float& mn, float& alpha, float C, float thr_s) {
  float pmax = p0[0];
#pragma unroll
  for (int r = 1; r < 16; ++r) pmax = fmaxf(pmax, p0[r]);
#pragma unroll
  for (int r = 0; r < 16; ++r) pmax = fmaxf(pmax, p1[r]);
  { auto rr = __builtin_amdgcn_permlane32_swap(__float_as_uint(pmax), __float_as_uint(pmax), false, false);
    pmax = fmaxf(__uint_as_float(rr[0]), __uint_as_float(rr[1])); }
  if (__builtin_expect(__all(pmax - m_reg <= thr_s), 1)) { mn = m_reg; alpha = 1.f; }
  else { mn = fmaxf(m_reg, pmax); alpha = __builtin_amdgcn_exp2f((m_reg - mn) * C); m_reg = mn; }
  float mnC = -mn * C;
#pragma unroll
  for (int r = 0; r < 16; ++r) p0[r] = fmaf(p0[r], C, mnC);
#pragma unroll
  for (int r = 0; r < 16; ++r) p1[r] = fmaf(p1[r], C, mnC);
#pragma unroll
  for (int r = 0; r < 16; ++r) p0[r] = __builtin_amdgcn_exp2f(p0[r]);
}
__device__ __forceinline__ void finishSM(f32x16& p0, f32x16& p1, float alpha, float& l_reg, bf16x8& pa0, bf16x8& pa1, bf16x8& pa2, bf16x8& pa3) {
#pragma unroll
  for (int r = 0; r < 16; ++r) p1[r] = __builtin_amdgcn_exp2f(p1[r]);
  float ps = 0;
#pragma unroll
  for (int r = 0; r < 16; ++r) ps += p0[r];
#pragma unroll
  for (int r = 0; r < 16; ++r) ps += p1[r];
  { auto rr = __builtin_amdgcn_permlane32_swap(__float_as_uint(ps), __float_as_uint(ps), false, false);
    ps = __uint_as_float(rr[0]) + __uint_as_float(rr[1]); }
  l_reg = l_reg * alpha + ps;
#define PK4(P, BASE, OUT) do { unsigned a0 = cvtpk(P[BASE + 0], P[BASE + 1]), a1 = cvtpk(P[BASE + 2], P[BASE + 3]);   \
    unsigned b0 = cvtpk(P[BASE + 4], P[BASE + 5]), b1 = cvtpk(P[BASE + 6], P[BASE + 7]);                              \
    auto r0 = __builtin_amdgcn_permlane32_swap(a0, b0, false, false); auto r1 = __builtin_amdgcn_permlane32_swap(a1, b1, false, false); \
    u32x4 w = {r0[0], r1[0], r0[1], r1[1]}; OUT = *reinterpret_cast<bf16x8*>(&w); } while (0)
  PK4(p0, 0, pa0); PK4(p0, 8, pa1); PK4(p1, 0, pa2); PK4(p1, 8, pa3);
#undef PK4
}
template <int DQK>
__device__ __forceinline__ void qkt(f32x16& p0, f32x16& p1, const char* Ks, const char* K2s, const bf16x8* qr, const char* q2l, int r32, int hi) {
#pragma unroll
  for (int r = 0; r < 16; ++r) { p0[r] = 0.f; p1[r] = 0.f; }
#pragma unroll
  for (int d0 = 0; d0 < 8; ++d0) { int cb = (d0 * 16 + hi * 8) * 2;
    bf16x8 b0 = *reinterpret_cast<const bf16x8*>(Ks + KSWZ(r32, cb));
    bf16x8 b1 = *reinterpret_cast<const bf16x8*>(Ks + KSWZ(32 + r32, cb));
    p0 = __builtin_amdgcn_mfma_f32_32x32x16_bf16(b0, qr[d0], p0, 0, 0, 0);
    p1 = __builtin_amdgcn_mfma_f32_32x32x16_bf16(b1, qr[d0], p1, 0, 0, 0); }
  if constexpr (DQK == 192) {
#pragma unroll
    for (int d0 = 0; d0 < 4; ++d0) { int cb = (d0 * 16 + hi * 8) * 2;
      bf16x8 b0 = *reinterpret_cast<const bf16x8*>(K2s + K2SWZ(r32, cb));
      bf16x8 b1 = *reinterpret_cast<const bf16x8*>(K2s + K2SWZ(32 + r32, cb));
      const bf16x8 q2 = *reinterpret_cast<const bf16x8*>(q2l + d0 * 1024);
      p0 = __builtin_amdgcn_mfma_f32_32x32x16_bf16(b0, q2, p0, 0, 0, 0);
      p1 = __builtin_amdgcn_mfma_f32_32x32x16_bf16(b1, q2, p1, 0, 0, 0); }
  }
}
__device__ __forceinline__ int v_st(int k, int c) { const int kk = (k & ~0xC) | ((k & 4) << 1) | ((k & 8) >> 1); return ((kk >> 3) * 4 + (c >> 5)) * 512 + ((kk & 7) * 32 + (c & 31)) * 2; }
__device__ __forceinline__ int v_rd_base(int lane) { return ((lane & 3) << 3) | (((lane >> 2) & 3) << 6) | (((lane >> 4) & 1) << 5) | (((lane >> 5) & 1) << 8); }
constexpr int v_rd_off(int d0, int ks, int half) { return d0 * 512 + ks * 4096 + half * 2048; }
template <int OFF> __device__ __forceinline__ s16x4 tr_read(int vb) {
  s16x4 r; asm volatile("ds_read_b64_tr_b16 %0, %1 offset:%2" : "=&v"(r) : "v"(vb), "i"(OFF) : "memory"); return r;
}
template <int D0> __device__ __forceinline__ void pv_one(f32x16& od, int vb, bf16x8 pa0, bf16x8 pa1, bf16x8 pa2, bf16x8 pa3) {
  const s16x4 l0 = tr_read<v_rd_off(D0, 0, 0)>(vb), h0 = tr_read<v_rd_off(D0, 0, 1)>(vb), l1 = tr_read<v_rd_off(D0, 1, 0)>(vb), h1 = tr_read<v_rd_off(D0, 1, 1)>(vb);
  const s16x4 l2 = tr_read<v_rd_off(D0, 2, 0)>(vb), h2 = tr_read<v_rd_off(D0, 2, 1)>(vb), l3 = tr_read<v_rd_off(D0, 3, 0)>(vb), h3 = tr_read<v_rd_off(D0, 3, 1)>(vb);
  asm volatile("s_waitcnt lgkmcnt(0)" ::: "memory"); SBAR();
#define PK(L, H) (bf16x8){L[0], L[1], L[2], L[3], H[0], H[1], H[2], H[3]}
  od = __builtin_amdgcn_mfma_f32_32x32x16_bf16(pa0, PK(l0, h0), od, 0, 0, 0);
  od = __builtin_amdgcn_mfma_f32_32x32x16_bf16(pa1, PK(l1, h1), od, 0, 0, 0);
  od = __builtin_amdgcn_mfma_f32_32x32x16_bf16(pa2, PK(l2, h2), od, 0, 0, 0);
  od = __builtin_amdgcn_mfma_f32_32x32x16_bf16(pa3, PK(l3, h3), od, 0, 0, 0);
#undef PK
}
__device__ __forceinline__ void pv_d0(f32x16* o, int vb, bf16x8 pa0, bf16x8 pa1, bf16x8 pa2, bf16x8 pa3) {
  pv_one<0>(o[0], vb, pa0, pa1, pa2, pa3); pv_one<1>(o[1], vb, pa0, pa1, pa2, pa3); pv_one<2>(o[2], vb, pa0, pa1, pa2, pa3); pv_one<3>(o[3], vb, pa0, pa1, pa2, pa3);
}

template <int DQK, int SDEPTH>
__device__ __forceinline__ void attn_body(const bf16_t* __restrict__ Qb, const bf16_t* __restrict__ Q2b, int ldq, const bf16_t* __restrict__ Kh, int ldk, const bf16_t* __restrict__ K2h, int ldk2,
                                          const bf16_t* __restrict__ Vh, int ldv, bf16_t* __restrict__ Ob, int ldo, int seq, float scale, char* lds) {
  constexpr int ND = 8;
  const int tid = opaque_tid(), wid = tid >> 6, lane = tid & 63, r32 = lane & 31, hi = lane >> 5;
  const float C = scale * 1.4426950408889634f, thr_s = THR / scale;
  char* V_lds = lds; char* K_lds = lds + OFF_K; char* K2_lds = lds + OFF_K2;
  float* ws = (float*)(lds + OFF_WS) + wid * 64; float* li_l = ws; float* al_l = ws + 32;
  float m_reg = -1e30f, l_reg = 0; f32x16 o[4]; bf16x8 qr[ND];
#pragma unroll
  for (int d = 0; d < 4; ++d)
#pragma unroll
    for (int r = 0; r < 16; ++r) o[d][r] = 0.f;
  const bf16_t* Qw = Qb + (long)(wid * QBLK + r32) * ldq + hi * 8;
#pragma unroll
  for (int d0 = 0; d0 < ND; ++d0) qr[d0] = *reinterpret_cast<const bf16x8*>(Qw + d0 * 16);
  char* q2l = lds + OFF_Q2 + (wid * 4 * 64 + lane) * 16;
  __syncthreads();
  if constexpr (DQK == 192) {
#pragma unroll
    for (int d0 = 0; d0 < 4; ++d0) *reinterpret_cast<bf16x8*>(q2l + d0 * 1024) = *reinterpret_cast<const bf16x8*>(Q2b + (long)(wid * QBLK + r32) * ldq + hi * 8 + d0 * 16);
  }
  const int sr = tid >> 4, sc = (tid & 15) * 8, vst0 = v_st(sr, sc), vst1 = v_st(32 + sr, sc);
  const int sr2 = tid >> 3, sc2 = (tid & 7) * 8;
  const unsigned voffV = (unsigned)(sr * ldv + sc) * 2u, voffK = (unsigned)(sr * ldk + sc) * 2u, voffK2 = (unsigned)(sr2 * ldk2 + sc2) * 2u;
  const size_t tsV = (size_t)ldv * 2, tsK = (size_t)ldk * 2, tsK2 = (size_t)ldk2 * 2;
  const int vb0 = (int)(uintptr_t)V_lds + v_rd_base(lane);
  struct { bf16x8 vs0, vs1, ks0, ks1, k2; } sr_[SDEPTH];
#define SLOAD(i, k0) do { const char* vb_ = (const char*)Vh + (size_t)(k0) * tsV; const char* kb_ = (const char*)Kh + (size_t)(k0) * tsK; \
    sr_[i].vs0 = *(const bf16x8*)(vb_ + voffV); sr_[i].vs1 = *(const bf16x8*)(vb_ + 32 * tsV + voffV); \
    sr_[i].ks0 = *(const bf16x8*)(kb_ + voffK); sr_[i].ks1 = *(const bf16x8*)(kb_ + 32 * tsK + voffK); \
    if constexpr (DQK == 192) sr_[i].k2 = *(const bf16x8*)((const char*)K2h + (size_t)(k0) * tsK2 + voffK2); } while (0)
#define SWRITE(b, i) do { *(bf16x8*)(V_lds + (b) * SHM_V + vst0) = sr_[i].vs0;          \
    *(bf16x8*)(V_lds + (b) * SHM_V + vst1) = sr_[i].vs1; int kc = sc * 2;               \
    *(bf16x8*)(K_lds + (b) * SHM_K + KSWZ(sr, kc)) = sr_[i].ks0;                       \
    *(bf16x8*)(K_lds + (b) * SHM_K + KSWZ(32 + sr, kc)) = sr_[i].ks1;                  \
    if constexpr (DQK == 192) *(bf16x8*)(K2_lds + (b) * SHM_K2 + K2SWZ(sr2, sc2 * 2)) = sr_[i].k2; } while (0)
#define SWAIT() do { if constexpr (SDEPTH == 1) asm volatile("s_waitcnt vmcnt(0)" ::: "memory"); else if constexpr (DQK == 192) asm volatile("s_waitcnt vmcnt(5)" ::: "memory"); else asm volatile("s_waitcnt vmcnt(4)" ::: "memory"); } while (0)
#define RESC(a) do { if (__any((a) < 1.f)) { if (hi == 0) al_l[r32] = (a); asm volatile("s_waitcnt lgkmcnt(0)" ::: "memory"); \
    _Pragma("unroll") for (int d = 0; d < 4; ++d) _Pragma("unroll") for (int r = 0; r < 16; ++r) o[d][r] *= al_l[crow(r, hi)]; } } while (0)
  f32x16 pA0, pA1, pB0, pB1; float mnA, mnB, alA, alB; bf16x8 pa0, pa1, pa2, pa3; const int NT = seq / KVBLK;
  constexpr int SE = 0, SO = SDEPTH - 1;
  SLOAD(SE, 0); asm volatile("s_waitcnt vmcnt(0)" ::: "memory"); SWRITE(0, SE); __syncthreads();
  qkt<DQK>(pA0, pA1, K_lds, K2_lds, qr, q2l, r32, hi); partialSM(pA0, pA1, m_reg, mnA, alA, C, thr_s);
  SLOAD(SO, KVBLK); if constexpr (SDEPTH == 2) { if (2 < NT) SLOAD(SE, 2 * KVBLK); }
  SWAIT(); SWRITE(1, SO); __syncthreads();
  for (int j = 1; j + 1 < NT; j += 2) {
    SBAR(); qkt<DQK>(pB0, pB1, K_lds + SHM_K, K2_lds + SHM_K2, qr, q2l, r32, hi);
    finishSM(pA0, pA1, alA, l_reg, pa0, pa1, pa2, pa3); SBAR();
    SLOAD(SO, (j + SDEPTH) * KVBLK); SBAR();
    pv_d0(o, vb0, pa0, pa1, pa2, pa3); partialSM(pB0, pB1, m_reg, mnB, alB, C, thr_s);
    __syncthreads(); SWAIT(); SWRITE(0, SE);
    RESC(alB); __syncthreads();
    SBAR(); qkt<DQK>(pA0, pA1, K_lds, K2_lds, qr, q2l, r32, hi);
    finishSM(pB0, pB1, alB, l_reg, pa0, pa1, pa2, pa3); SBAR();
    if (SDEPTH == 1 || j + 3 < NT) SLOAD(SE, (j + 1 + SDEPTH) * KVBLK); SBAR();
    pv_d0(o, vb0 + SHM_V, pa0, pa1, pa2, pa3); partialSM(pA0, pA1, m_reg, mnA, alA, C, thr_s);
    __syncthreads(); SWAIT(); SWRITE(1, SO);
    RESC(alA); __syncthreads();
  }
  SBAR(); qkt<DQK>(pB0, pB1, K_lds + SHM_K, K2_lds + SHM_K2, qr, q2l, r32, hi);
  finishSM(pA0, pA1, alA, l_reg, pa0, pa1, pa2, pa3); SBAR();
  pv_d0(o, vb0, pa0, pa1, pa2, pa3); partialSM(pB0, pB1, m_reg, mnB, alB, C, thr_s);
  __syncthreads(); RESC(alB);
  finishSM(pB0, pB1, alB, l_reg, pa0, pa1, pa2, pa3); SBAR();
  pv_d0(o, vb0 + SHM_V, pa0, pa1, pa2, pa3);
  if (hi == 0) li_l[r32] = l_reg; asm volatile("s_waitcnt lgkmcnt(0)" ::: "memory");
  float rli[16];
#pragma unroll
  for (int r = 0; r < 16; ++r) rli[r] = __builtin_amdgcn_rcpf(li_l[crow(r, hi)]);
  bf16_t* Ow = Ob + (long)(wid * QBLK) * ldo;
#pragma unroll
  for (int r = 0; r < 16; ++r) { int orow = crow(r, hi);
#pragma unroll
    for (int d0 = 0; d0 < 4; ++d0) Ow[(long)orow * ldo + d0 * 32 + r32] = f2bf(o[d0][r] * rli[r]); }
#undef SLOAD
#undef SWRITE
#undef SWAIT
#undef RESC
}
struct AttnJob { const bf16_t* Q; const bf16_t* Q2; int ldq, qhs; const bf16_t* K; int ldk, khs; long kbs; const bf16_t* K2; int ldk2; const bf16_t* V; int ldv; bf16_t* O; int H, gshift, seq, nunits; float scale; };
template <int DQK, int SDEPTH>
__device__ __forceinline__ void run_attn(const AttnJob& a, char* lds) {
  for (int u = blockIdx.x; u < a.nunits; u += gridDim.x) {
    const int per_b = a.H * 32, b = u / per_b, rest = u - b * per_b, h = rest % a.H, qb = rest / a.H, kh = h >> a.gshift;
    const long tok0 = (long)b * SEQ + qb * 256;
    attn_body<DQK, SDEPTH>(a.Q + tok0 * a.ldq + h * a.qhs, a.Q2 + tok0 * a.ldq + h * 64, a.ldq, a.K + (long)b * a.kbs + kh * a.khs, a.ldk, a.K2 + (long)b * SEQ * a.ldk2, a.ldk2,
                           a.V + (long)b * a.kbs + kh * a.khs, a.ldv, a.O + tok0 * 1536 + h * 128, 1536, a.seq, a.scale, lds);
  }
}
}

__device__ __forceinline__ void rms_rows(const float* __restrict__ src, const float* __restrict__ gain, bf16_t* __restrict__ dst, int nrows) {
  const int tid_ = opaque_tid(), wid = tid_ >> 6, lane = tid_ & 63;
  for (int row = blockIdx.x * 8 + wid; row < nrows; row += gridDim.x * 8) {
    const f32x4* s = (const f32x4*)(src + (size_t)row * DM);
    f32x4 v[4]; float ss = 0.f;
#pragma unroll
    for (int j = 0; j < 4; ++j) { v[j] = s[lane + 64 * j]; ss += v[j][0] * v[j][0] + v[j][1] * v[j][1] + v[j][2] * v[j][2] + v[j][3] * v[j][3]; }
    ss = wave_sum(ss);
    const float rs = rsqrtf(ss * (1.f / DM) + EPS);
#pragma unroll
    for (int j = 0; j < 4; ++j) { const f32x4 g = ((const f32x4*)gain)[lane + 64 * j];
      u32x2 w; w.x = cvtpk(v[j][0] * rs * g[0], v[j][1] * rs * g[1]); w.y = cvtpk(v[j][2] * rs * g[2], v[j][3] * rs * g[3]);
      *(u32x2*)(dst + (size_t)row * DM + (lane + 64 * j) * 4) = w; }
  }
}
template <int MODE>
__device__ __forceinline__ void prep_w(const float* __restrict__ src, int K, int Nsrc, bf16_t* __restrict__ dst, int Ndst, const float* __restrict__ kgain) {
  const long total = (long)Ndst * (K / 8);
  for (long i = (long)blockIdx.x * 512 + opaque_tid(); i < total; i += (long)gridDim.x * 512) {
    const int n = (int)(i % Ndst), k8 = (int)(i / Ndst);
    int ns = n;
    if (MODE == 1) { const int pn = n >> 8, r = n & 255, bj = r >> 7, ii = r & 127; ns = bj * DFF + pn * 128 + ii; }
    if (MODE == 2) { ns = n < 640 ? n : (n < 1152 ? n + 64 : (n < 1216 ? n - 512 : Nsrc)); }
    if (MODE == 3) { ns = n < 1024 ? (n >> 7) * 192 + (n & 127) : ((n - 1024) >> 6) * 192 + 128 + ((n - 1024) & 63); }
    float x[8];
#pragma unroll
    for (int j = 0; j < 8; ++j) x[j] = (ns < Nsrc) ? src[(size_t)(k8 * 8 + j) * Nsrc + ns] : 0.f;
    if (kgain) {
#pragma unroll
      for (int j = 0; j < 8; ++j) x[j] *= kgain[k8 * 8 + j];
    }
    u32x4 w; w.x = cvtpk(x[0], x[1]); w.y = cvtpk(x[2], x[3]); w.z = cvtpk(x[4], x[5]); w.w = cvtpk(x[6], x[7]);
    *(u32x4*)(dst + (size_t)n * K + k8 * 8) = w;
  }
}
__device__ __forceinline__ void unpack8(u32x4 w, float* v) {
#pragma unroll
  for (int i = 0; i < 4; ++i) { v[2 * i] = __uint_as_float(w[i] << 16); v[2 * i + 1] = __uint_as_float(w[i] & 0xffff0000u); }
}
__device__ __forceinline__ u32x4 pack8(const float* v) { u32x4 w; w.x = cvtpk(v[0], v[1]); w.y = cvtpk(v[2], v[3]); w.z = cvtpk(v[4], v[5]); w.w = cvtpk(v[6], v[7]); return w; }
__device__ __forceinline__ float sumsq8(const float* v) { float s = 0.f;
#pragma unroll
  for (int j = 0; j < 8; ++j) s += v[j] * v[j];
  return s; }
template <int GL> __device__ __forceinline__ float group_sum(float s) {
#pragma unroll
  for (int o = 1; o < GL; o <<= 1) s += __shfl_xor(s, o, 64);
  return s;
}
__device__ __forceinline__ void load8(float* g, const float* __restrict__ p) { const f32x4 a = *(const f32x4*)p, b = *(const f32x4*)(p + 4);
  g[0] = a[0]; g[1] = a[1]; g[2] = a[2]; g[3] = a[3]; g[4] = b[0]; g[5] = b[1]; g[6] = b[2]; g[7] = b[3]; }
template <int GL> __device__ __forceinline__ void norm8(float* v, const float* g) {
  const float ss = group_sum<GL>(sumsq8(v)); const float rs = rsqrtf(ss * (1.f / (GL * 8)) + EPS);
#pragma unroll
  for (int j = 0; j < 8; ++j) v[j] *= rs * g[j];
}
template <int XM> __device__ __forceinline__ void rope8(float* v, const float* inv, float pos, bool first) {
#pragma unroll
  for (int j = 0; j < 8; ++j) {
    const float partner = __shfl_xor(v[j], XM, 64);
    float rev = pos * inv[j] * INV2PI; rev -= floorf(rev);
    const float c = __builtin_amdgcn_cosf(rev), s = __builtin_amdgcn_sinf(rev);
    v[j] = first ? v[j] * c - partner * s : v[j] * c + partner * s;
  }
}
template <int NE> __device__ __forceinline__ void ld_seg(float* v, const bf16_t* p, int lane) {
#pragma unroll
  for (int j = 0; j < NE; ++j) v[j] = bf2f(p[lane + 64 * j]);
}
template <int NE> __device__ __forceinline__ void st_seg(const float* v, bf16_t* p, int lane) {
#pragma unroll
  for (int j = 0; j < NE; ++j) p[lane + 64 * j] = f2bf(v[j]);
}
template <int NE, int ROPE> __device__ __forceinline__ void norm_seg(float* v, const float* __restrict__ gain, int lane, int prow, int pcol) {
  float ss = 0.f;
#pragma unroll
  for (int j = 0; j < NE; ++j) ss += v[j] * v[j];
  ss = wave_sum(ss);
  const float rs = rsqrtf(ss * (1.f / (64 * NE)) + EPS);
#pragma unroll
  for (int j = 0; j < NE; ++j) v[j] = v[j] * rs * gain[lane + 64 * j];
  if constexpr (ROPE && NE == 2) {
    const int f = lane & 31; const float inv = exp2f(-(float)(2 * f) * (1.f / 64.f) * LOG2_THETA);
#pragma unroll
    for (int j = 0; j < 2; ++j) {
      const float partner = __shfl_xor(v[j], 32, 64);
      const float ang = (float)(j == 0 ? prow : pcol) * inv;
      float rev = ang * INV2PI; rev -= floorf(rev);
      const float c = __builtin_amdgcn_cosf(rev), s = __builtin_amdgcn_sinf(rev);
      v[j] = (lane < 32) ? v[j] * c - partner * s : v[j] * c + partner * s;
    }
  }
  if constexpr (ROPE && NE == 1) {
    const int f = lane & 15; const float inv = exp2f(-(float)(2 * f) * (1.f / 32.f) * LOG2_THETA);
    const float partner = __shfl_xor(v[0], 16, 64);
    const float ang = (float)(lane < 32 ? prow : pcol) * inv;
    float rev = ang * INV2PI; rev -= floorf(rev);
    const float c = __builtin_amdgcn_cosf(rev), s = __builtin_amdgcn_sinf(rev);
    v[0] = (lane & 16) ? v[0] * c + partner * s : v[0] * c - partner * s;
  }
}

#define XB_TMO      128
#define XB_XCNT(j)  (256  + 64 * (j))
#define XB_XSUB(j)  (1280 + 64 * (j))
#define XB_XGEN(j)  (2304 + 64 * (j))
#define XB_TOP      3328
#define XB_TOPGEN   3392
#define XCD_BAR_WORDS 3456
#define XB_SPIN_CAP (1u << 22)
__device__ __forceinline__ unsigned xb_ld(unsigned* p)              { return __hip_atomic_load(p, __ATOMIC_RELAXED, __HIP_MEMORY_SCOPE_AGENT); }
__device__ __forceinline__ unsigned xb_add(unsigned* p, unsigned v) { return __hip_atomic_fetch_add(p, v, __ATOMIC_RELAXED, __HIP_MEMORY_SCOPE_AGENT); }
__device__ __forceinline__ unsigned xb_xcc_id() { return (unsigned)__builtin_amdgcn_s_getreg((3 << 11) | 20) & 0xFu; }
#define XB_SPIN(cond, bar) do { unsigned _sp = 0; while (cond) { __builtin_amdgcn_s_sleep(1); \
    if ((++_sp & 255u) == 0u) { if (xb_ld(&(bar)[XB_TMO])) break; if (_sp > XB_SPIN_CAP) { atomicAdd(&(bar)[XB_TMO], 1u); break; } } } } while (0)
struct XcdBarrier { unsigned* bar; unsigned x; volatile LAS unsigned* st; };
__device__ __forceinline__ XcdBarrier xcd_barrier_post(unsigned* bar, volatile LAS unsigned* st) {
  XcdBarrier b; b.bar = bar; b.x = xb_xcc_id(); b.st = st;
  if (threadIdx.x == 0) (void)xb_add(&bar[XB_XCNT(b.x)], 1u);
  return b;
}
__device__ __forceinline__ void xcd_barrier_complete(unsigned* bar, unsigned x, unsigned& nloc, unsigned& nx) {
  const unsigned G = gridDim.x * gridDim.y * gridDim.z;
  unsigned sum, cnt, mine, sp = 0u;
  for (;;) {
    sum = 0u; cnt = 0u; mine = 0u;
#pragma unroll
    for (unsigned j = 0; j < 16; ++j) { const unsigned c = xb_ld(&bar[XB_XCNT(j)]); sum += c; cnt += (c > 0u) ? 1u : 0u; mine = (j == x) ? c : mine; }
    if (sum == G) break;
    __builtin_amdgcn_s_sleep(1);
    if ((++sp & 255u) == 0u) { if (xb_ld(&bar[XB_TMO])) break; if (sp > XB_SPIN_CAP) { atomicAdd(&bar[XB_TMO], 1u); break; } }
  }
  nloc = mine > 0u ? mine : 1u; nx = cnt > 0u ? cnt : 1u;
}
__device__ __forceinline__ void xcd_barrier(const XcdBarrier& b) {
  asm volatile("s_waitcnt vmcnt(0)" ::: "memory");
  __syncthreads();
  if (threadIdx.x == 0) {
    unsigned* bar = b.bar;
    __builtin_amdgcn_s_waitcnt(0);
    unsigned nloc = b.st[0], nx = b.st[1];
    if (nloc == 0u) { xcd_barrier_complete(bar, b.x, nloc, nx); b.st[0] = nloc; b.st[1] = nx; }
    const unsigned old = xb_add(&bar[XB_XSUB(b.x)], 1u);
    const unsigned gen = old / nloc;
    if (old + 1u == (gen + 1u) * nloc) {
      __builtin_amdgcn_fence(__ATOMIC_RELEASE, "agent");
      asm volatile("s_waitcnt vmcnt(0)" ::: "memory");
      const unsigned og = xb_add(&bar[XB_TOP], 1u);
      const unsigned tg = og / nx;
      if (og + 1u == (tg + 1u) * nx) xb_add(&bar[XB_TOPGEN], 1u);
      else XB_SPIN(xb_ld(&bar[XB_TOPGEN]) == tg, bar);
      __builtin_amdgcn_fence(__ATOMIC_ACQUIRE, "agent");
      xb_add(&bar[XB_XGEN(b.x)], 1u);
      asm volatile("s_waitcnt vmcnt(0)" ::: "memory");
    } else {
      XB_SPIN(xb_ld(&bar[XB_XGEN(b.x)]) == gen, bar);
      __builtin_amdgcn_fence(__ATOMIC_ACQUIRE, "agent");
      asm volatile("s_waitcnt vmcnt(0)" ::: "memory");
    }
  }
  __syncthreads();
}

constexpr int LDS_MAIN = pg8::STAGE_BYTES;
constexpr int LDS_BYTES = LDS_MAIN + 16;
static_assert(att::SHM_ATTN <= LDS_MAIN, "lds");
constexpr int NPHASE = 18;
#ifndef PHMASK
#define PHMASK 0xf
#endif
#ifndef REPMASK
#define REPMASK 0
#endif
#ifndef A128_SD
#define A128_SD 1
#endif
#ifndef KARG
#define KARG 0
#endif
#define wt_in0 ((bf16_t*)(p.ws + WS_WT_IN0))
#define wt_qb ((bf16_t*)(p.ws + WS_WT_QB))
#define wt_kvb ((bf16_t*)(p.ws + WS_WT_KVB))
#define wt_out ((bf16_t*)(p.ws + WS_WT_OUT))
#define wt_memkv ((bf16_t*)(p.ws + WS_WT_MEMKV))
#define wt_gu ((bf16_t*)(p.ws + WS_WT_GU))
#define wt_dn ((bf16_t*)(p.ws + WS_WT_DN))
#define wt_in1 ((bf16_t*)(p.ws + WS_WT_IN1))
#define memn ((bf16_t*)(p.ws + WS_MEMN))
#define memkv ((bf16_t*)(p.ws + WS_MEMKV))
#define hbuf ((bf16_t*)(p.ws + WS_HM))
#define mix ((bf16_t*)(p.ws + WS_HM))
#define proj ((bf16_t*)(p.ws + WS_R))
#define act ((bf16_t*)(p.ws + WS_R))
#define qbuf ((bf16_t*)(p.ws + WS_Q))
#define kvbuf ((bf16_t*)(p.ws + WS_KV))

struct GemmJob { const bf16_t* A; int lda; const bf16_t* Bt; int M, N, K; int kind; bf16_t* O; int ldc; const float* res; int coff; const float* rs_in; float* rs_out; };

__device__ __forceinline__ int gemm_jobs(const Params& p, int ph, int gi, GemmJob& j) {
  const float* x = p.in[0];
  j.M = NTOK; j.res = nullptr; j.coff = 0; j.O = nullptr; j.ldc = 0; j.rs_in = nullptr; j.rs_out = nullptr;
  float* rowss = (float*)(p.ws + WS_ROWSS); bf16_t* xbuf = (bf16_t*)(p.ws + WS_XB);
  switch (ph) {
  case 1:
    if (gi == 0) { j.A = hbuf; j.lda = 1024; j.Bt = wt_in0; j.N = 1280; j.K = 1024; j.kind = 0; j.O = proj; j.ldc = 1280; }
    else { j.A = memn; j.lda = 1024; j.Bt = wt_memkv + (size_t)(gi - 1) * 1024 * 1024; j.M = NMEMROWS; j.N = 1024; j.K = 1024; j.kind = 0; j.O = memkv + (size_t)(gi - 1) * NMEMROWS * 1024; j.ldc = 1024; j.coff = (gi - 1) * 128; }
    return 3;
  case 3:
    if (gi == 0) { j.A = proj; j.lda = 1280; j.Bt = wt_qb; j.N = 1536; j.K = 384; j.kind = 0; j.O = qbuf; j.ldc = 1536; }
    else { j.A = proj + 384; j.lda = 1280; j.Bt = wt_kvb; j.N = 2048; j.K = 256; j.kind = 0; j.O = kvbuf; j.ldc = 2048; }
    return 2;
  case 6: case 14: { const int L = ph == 6 ? 0 : 1;
    j.A = mix; j.lda = 1536; j.Bt = wt_out + (size_t)L * 1024 * 1536; j.N = 1024; j.K = 1536; j.kind = 1; j.res = L == 0 ? x : p.out; j.rs_out = rowss + (size_t)(L == 0 ? 0 : 2) * NTOK; j.O = xbuf; return 1; }
  case 8: case 16: { const int L = ph == 8 ? 0 : 1;
    j.A = xbuf; j.lda = 1024; j.Bt = wt_gu + (size_t)L * 5632 * 1024; j.N = 5632; j.K = 1024; j.kind = 2; j.O = act; j.rs_in = rowss + (size_t)(L == 0 ? 0 : 2) * NTOK; return 1; }
  case 9: case 17: { const int L = ph == 9 ? 0 : 1;
    j.A = act; j.lda = DFF; j.Bt = wt_dn + (size_t)L * 1024 * 2816; j.N = 1024; j.K = DFF; j.kind = 1; j.res = p.out; if (L == 0) { j.rs_out = rowss + (size_t)NTOK; j.O = xbuf; } return 1; }
  case 11:
    j.A = xbuf; j.lda = 1024; j.Bt = wt_in1; j.N = 2048; j.K = 1024; j.kind = 0; j.O = proj; j.ldc = 2048; j.rs_in = rowss + (size_t)NTOK; return 1;
  default: return 0;
  }
}

__global__ __launch_bounds__(512) void mega(Params p_) {
  extern __shared__ __attribute__((aligned(16))) unsigned char shm[];
  LAS unsigned char* glds = (LAS unsigned char*)shm;
  char* alds = (char*)shm;
  const Params* pp = (const Params*)__builtin_amdgcn_kernarg_segment_ptr();
  const int ph_lo = p_.ph_lo, ph_hi = p_.ph_hi;
  volatile LAS unsigned* bst = (volatile LAS unsigned*)(glds + LDS_MAIN);
  if (threadIdx.x == 0) { bst[0] = 0u; bst[1] = 0u; }
  __syncthreads();
  const XcdBarrier xb = xcd_barrier_post((unsigned*)(p_.ws + WS_BAR), bst);
  if (ph_lo < 0) cg::this_grid().sync();

  for (int ph = ph_lo; ph < ph_hi; ++ph) {
    if (ph == 2 || ph == 7 || ph == 10 || ph == 15) continue;
#if KARG
    asm volatile("" : "+s"(pp));
    const Params& p = *pp;
#else
    const Params& p = p_;
#endif
    const float* x = p.in[0];
    for (int rep = 0; rep < 1 + ((REPMASK >> ph) & 1); ++rep) {
    const int tid_ = opaque_tid(), wid = tid_ >> 6, lane = tid_ & 63;
    const int gw = blockIdx.x * 8 + wid, nw = gridDim.x * 8;
    if (PHMASK & 1) switch (ph) {
    case 0: {
      prep_w<2>(p.in[11], 1024, 1216, wt_in0, 1280, nullptr);
      prep_w<3>(p.in[13], 384, 1536, wt_qb, 1536, p.in[12]);
      prep_w<0>(p.in[15], 256, 2048, wt_kvb, 2048, p.in[14]);
      for (int i = 0; i < 2; ++i) {
        prep_w<0>(p.in[5] + (size_t)i * 1536 * 1024, 1536, 1024, wt_out + (size_t)i * 1024 * 1536, 1024, nullptr);
        prep_w<0>(p.in[6] + (size_t)i * 1024 * 1024, 1024, 1024, wt_memkv + (size_t)i * 1024 * 1024, 1024, nullptr);
        prep_w<1>(p.in[9] + (size_t)i * 1024 * 5632, 1024, 5632, wt_gu + (size_t)i * 5632 * 1024, 5632, p.in[4] + i * 1024);
        prep_w<0>(p.in[10] + (size_t)i * 2816 * 1024, 2816, 1024, wt_dn + (size_t)i * 1024 * 2816, 1024, nullptr);
      }
      prep_w<0>(p.in[18], 1024, 2048, wt_in1, 2048, p.in[3] + 1024);
      for (int i = blockIdx.x * 512 + tid_; i < 3 * NTOK; i += gridDim.x * 512) ((float*)(p.ws + WS_ROWSS))[i] = 0.f;
      rms_rows(p.in[1], p.in[2], memn, NMEMROWS);
      rms_rows(x, p.in[3], hbuf, NTOK);
    } break;
    case 4: {
      const int l16 = lane & 15, l8 = lane & 7;
      float inv64[8], g_mq[8], g_qn[8], g_qp[8], g_kn[8], g_kp[8];
#pragma unroll
      for (int j = 0; j < 8; ++j) inv64[j] = exp2f(-(float)(2 * ((l8 & 1) * 8 + j)) * (1.f / 32.f) * LOG2_THETA);
      load8(g_mq, p.in[7] + l16 * 8); load8(g_qn, p.in[16] + l16 * 8); load8(g_qp, p.in[16] + 128 + l8 * 8); load8(g_kn, p.in[17] + l16 * 8); load8(g_kp, p.in[17] + 128 + l8 * 8);
      const bool first64 = !(l8 & 2);
      for (int t = gw; t < NTOK; t += nw) {
        const int sq = t & (SEQ - 1); const float pos64 = (float)((l8 < 4) ? (sq >> 6) : (sq & 63));
        bf16_t* pr = proj + (size_t)t * 1280 + lane * 8; bf16_t* qrow = qbuf + (size_t)t * 1536 + lane * 8; bf16_t* kvrow = kvbuf + (size_t)t * 2048 + lane * 8;
        const bool dry = REPMASK && rep == 0; bf16_t* qdst = dry ? (bf16_t*)(p.ws + WS_HM) + (size_t)t * 1536 + lane * 8 : qrow; bf16_t* kvdst = dry ? (bf16_t*)p.out + (size_t)t * 2048 + lane * 8 : kvrow;
        const u32x4 P0 = *(const u32x4*)pr, P1 = *(const u32x4*)(pr + 512);
        u32x4 P2 = {0u, 0u, 0u, 0u}; if (lane < 32) P2 = *(const u32x4*)(pr + 1024);
        const u32x4 Q0 = *(const u32x4*)qrow, Q1 = *(const u32x4*)(qrow + 512), Q2 = *(const u32x4*)(qrow + 1024);
        const u32x4 KV0 = *(const u32x4*)kvrow, KV1 = *(const u32x4*)(kvrow + 512), KV2 = *(const u32x4*)(kvrow + 1024), KV3 = *(const u32x4*)(kvrow + 1536);
        float a[8], b[8];
        unpack8(P0, a); unpack8(P1, b);
        const float s0 = sumsq8(a), s1 = sumsq8(b);
        const float ssq = wave_sum(lane < 48 ? s0 : 0.f), sskv = wave_sum((lane >= 48 ? s0 : 0.f) + (lane < 16 ? s1 : 0.f));
        const float rs_q = rsqrtf(ssq * (1.f / 384.f) + EPS), rs_kv = rsqrtf(sskv * (1.f / 256.f) + EPS);
        norm8<16>(b, g_mq); if (lane >= 16 && !dry) *(u32x4*)(pr + 512) = pack8(b);
        unpack8(P2, a);
        { const float s8 = group_sum<8>(sumsq8(a)), s16 = s8 + __shfl_xor(s8, 8, 64);
          const float rsA = rsqrtf(s16 * (1.f / 128.f) + EPS), rsB = rsqrtf(s8 * (1.f / 64.f) + EPS);
#pragma unroll
          for (int j = 0; j < 8; ++j) { b[j] = a[j] * rsB * g_kp[j]; a[j] = a[j] * rsA * g_mq[j]; }
          rope8<2>(b, inv64, pos64, first64);
#pragma unroll
          for (int j = 0; j < 8; ++j) a[j] = lane < 16 ? a[j] : b[j];
          if (lane < 24 && !dry) *(u32x4*)(pr + 1024) = pack8(a); }
        unpack8(Q0, a);
#pragma unroll
        for (int j = 0; j < 8; ++j) a[j] *= rs_q;
        norm8<16>(a, g_qn); *(u32x4*)qdst = pack8(a);
        unpack8(Q1, a);
#pragma unroll
        for (int j = 0; j < 8; ++j) a[j] *= rs_q;
        norm8<16>(a, g_qn); *(u32x4*)(qdst + 512) = pack8(a);
        unpack8(Q2, a);
#pragma unroll
        for (int j = 0; j < 8; ++j) a[j] *= rs_q;
        norm8<8>(a, g_qp); rope8<2>(a, inv64, pos64, first64); *(u32x4*)(qdst + 1024) = pack8(a);
        const bool is_k = !((lane >> 4) & 1);
#define KVCHUNK(W, OFF) do { unpack8(W, a); _Pragma("unroll") for (int j = 0; j < 8; ++j) { a[j] *= rs_kv; b[j] = a[j]; } norm8<16>(b, g_kn); \
          _Pragma("unroll") for (int j = 0; j < 8; ++j) a[j] = is_k ? b[j] : a[j]; *(u32x4*)(kvdst + (OFF)) = pack8(a); } while (0)
        KVCHUNK(KV0, 0); KVCHUNK(KV1, 512); KVCHUNK(KV2, 1024); KVCHUNK(KV3, 1536);
#undef KVCHUNK
      }
      if (!(REPMASK && rep == 0)) for (int r = gw; r < 2 * NMEMROWS; r += nw) {
        float g_mk[8]; load8(g_mk, p.in[8] + (r / NMEMROWS) * 128 + l16 * 8);
        bf16_t* row = memkv + (size_t)r * 1024 + lane * 8;
        float a[8]; unpack8(*(const u32x4*)row, a); norm8<16>(a, g_mk); *(u32x4*)row = pack8(a);
      }
    } break;
    case 7: case 15: rms_rows(p.out, p.in[4] + (ph == 7 ? 0 : 1024), hbuf, NTOK); break;
    case 10: rms_rows(p.out, p.in[3] + 1024, hbuf, NTOK); break;
    case 12: {
      const int l16 = lane & 15;
      float inv128[8], g_q[8], g_k[8], g_mq[8];
#pragma unroll
      for (int j = 0; j < 8; ++j) inv128[j] = exp2f(-(float)(2 * ((l16 & 3) * 8 + j)) * (1.f / 64.f) * LOG2_THETA);
      load8(g_q, p.in[19] + l16 * 8); load8(g_k, p.in[20] + l16 * 8); load8(g_mq, p.in[7] + 128 + l16 * 8);
      const bool first128 = !(l16 & 4);
      for (int t = gw; t < NTOK; t += nw) {
        const int sq = t & (SEQ - 1); const float pos128 = (float)((l16 < 8) ? (sq >> 6) : (sq & 63));
        bf16_t* row = proj + (size_t)t * 2048 + lane * 8;
        bf16_t* dst = (REPMASK && rep == 0) ? row + 128ull * MiB : row;
        const u32x4 W0 = *(const u32x4*)row, W1 = *(const u32x4*)(row + 512), W2 = *(const u32x4*)(row + 1024), W3 = *(const u32x4*)(row + 1536);
        float a[8];
        unpack8(W0, a); norm8<16>(a, g_q); rope8<4>(a, inv128, pos128, first128); *(u32x4*)dst = pack8(a);
        unpack8(W1, a); norm8<16>(a, g_q); rope8<4>(a, inv128, pos128, first128); *(u32x4*)(dst + 512) = pack8(a);
        unpack8(W2, a); norm8<16>(a, g_k); rope8<4>(a, inv128, pos128, first128); if (lane < 32) *(u32x4*)(dst + 1024) = pack8(a);
        unpack8(W3, a); norm8<16>(a, g_mq); *(u32x4*)(dst + 1536) = pack8(a);
      }
    } break;
    default: break;
    }
    if (PHMASK & 2) {
      GemmJob j; const int ng = gemm_jobs(p, ph, 0, j);
      for (int gi = 0; gi < ng; ++gi) {
        if (gi) gemm_jobs(p, ph, gi, j);
        if (j.kind == 0) pg8::run_gemm(glds, j.A, j.lda, j.Bt, j.M, j.N, j.K, pg8::EpiBf16{j.O, j.ldc, j.rs_in}, j.coff);
        else if (j.kind == 1) pg8::run_gemm(glds, j.A, j.lda, j.Bt, j.M, j.N, j.K, pg8::EpiResF32{p.out, j.res, j.rs_out ? j.O : nullptr, j.rs_out}, j.coff);
        else pg8::run_gemm(glds, j.A, j.lda, j.Bt, j.M, j.N, j.K, pg8::EpiSwiGLU{j.O, j.rs_in}, j.coff);
      }
    }
    if ((PHMASK & 12) && (ph == 5 || ph == 13)) {
      const int L = ph == 5 ? 0 : 1;
      att::AttnJob a;
      if (L == 0) {
        a.Q = qbuf; a.Q2 = qbuf + 1024; a.ldq = 1536; a.qhs = 128; a.K = kvbuf; a.ldk = 2048; a.khs = 256; a.kbs = (long)SEQ * 2048; a.K2 = proj + 1152; a.ldk2 = 1280;
        a.V = kvbuf + 128; a.ldv = 2048; a.O = mix; a.H = 8; a.gshift = 0; a.seq = SEQ; a.nunits = 2048; a.scale = 0.072168783648703220f;
        if (PHMASK & 4) att::run_attn<192, 1>(a, alds);
      } else {
        a.Q = proj; a.Q2 = proj; a.ldq = 2048; a.qhs = 128; a.K = proj + 1024; a.ldk = 2048; a.khs = 128; a.kbs = (long)SEQ * 2048; a.K2 = proj; a.ldk2 = 0;
        a.V = proj + 1280; a.ldv = 2048; a.O = mix; a.H = 8; a.gshift = 2; a.seq = SEQ; a.nunits = 2048; a.scale = 0.088388347648318440f;
      }
      for (int pass = (L == 0 ? 1 : 0); pass < 2; ++pass) {
        if (pass == 1) {
          a.Q = L == 0 ? proj + 640 : proj + 1536; a.Q2 = a.Q; a.ldq = L == 0 ? 1280 : 2048; a.qhs = 128;
          a.K = memkv + (size_t)L * NMEMROWS * 1024; a.ldk = 1024; a.khs = 128; a.kbs = 256 * 1024; a.K2 = a.K; a.ldk2 = 0;
          a.V = a.K + 512; a.ldv = 1024; a.O = mix + 1024; a.H = 4; a.gshift = 0; a.seq = 256; a.nunits = 1024; a.scale = 0.088388347648318440f;
        }
        if (PHMASK & 8) att::run_attn<128, A128_SD>(a, alds);
      }
    }
    }
    if (ph + 1 < ph_hi) xcd_barrier(xb);
  }
}

extern "C" void kernel_launch(void* const* d_in, const int* in_sizes, int n_in, void* d_out, int out_size, void* d_ws, size_t ws_size, hipStream_t stream) {
  static int grid = 0;
  if (grid == 0) {
    if (n_in != 21 || in_sizes[0] != NTOK * DM || out_size != NTOK * DM || ws_size < WS_END) {
      fprintf(stderr, "kernel_launch: shape/workspace mismatch (n_in %d, in0 %d, out %d, ws %zu, need %zu)\n", n_in, n_in > 0 ? in_sizes[0] : -1, out_size, ws_size, (size_t)WS_END);
      grid = -1; return; }
    int dev = 0, cus = 0, per_cu = 0;
    (void)hipGetDevice(&dev); (void)hipDeviceGetAttribute(&cus, hipDeviceAttributeMultiprocessorCount, dev);
    if (hipFuncSetAttribute((const void*)mega, hipFuncAttributeMaxDynamicSharedMemorySize, LDS_BYTES) != hipSuccess) { fprintf(stderr, "kernel_launch: hipFuncSetAttribute failed\n"); grid = -1; return; }
    if (hipOccupancyMaxActiveBlocksPerMultiprocessor(&per_cu, (const void*)mega, 512, LDS_BYTES) != hipSuccess || per_cu < 1) { fprintf(stderr, "kernel_launch: occupancy query says %d\n", per_cu); per_cu = 1; }
    (void)hipGetLastError();
    grid = cus * 1;
    if (grid <= 0) grid = 256;
  }
  if (grid < 0) return;
  if (hipMemsetAsync((char*)d_ws + WS_BAR, 0, XCD_BAR_WORDS * 4, stream) != hipSuccess) { fprintf(stderr, "kernel_launch: memset of barrier words failed\n"); return; }
  Params p{};
  for (int i = 0; i < 21; ++i) p.in[i] = (const float*)d_in[i];
  p.out = (float*)d_out; p.ws = (unsigned char*)d_ws;
#if MK_ONE_LAUNCH
  p.ph_lo = 0; p.ph_hi = NPHASE;
  void* args[] = {&p};
  hipError_t e = hipLaunchCooperativeKernel((const void*)mega, dim3(grid), dim3(512), args, LDS_BYTES, stream);
  if (e != hipSuccess) fprintf(stderr, "kernel_launch: cooperative launch failed: %s (grid %d)\n", hipGetErrorString(e), grid);
#else
  for (int ph = 0; ph < NPHASE; ++ph) {
    p.ph_lo = ph; p.ph_hi = ph + 1;
    hipLaunchKernelGGL(mega, dim3(grid), dim3(512), LDS_BYTES, stream, p);
  }
#endif
}
```

```cpp
#include <hip/hip_runtime.h>
#include <hip/hip_cooperative_groups.h>
#include <cstdio>
#include <cstdint>
namespace cg = cooperative_groups;

#ifndef MK_ONE_LAUNCH
#define MK_ONE_LAUNCH 1
#endif

typedef unsigned short bf16_t;
typedef short bf16x8 __attribute__((ext_vector_type(8)));
typedef short s16x4 __attribute__((ext_vector_type(4)));
typedef float f32x4 __attribute__((ext_vector_type(4)));
typedef float f32x16 __attribute__((ext_vector_type(16)));
typedef unsigned u32x4 __attribute__((ext_vector_type(4)));
typedef unsigned u32x2 __attribute__((ext_vector_type(2)));
#define LAS __attribute__((address_space(3)))

constexpr int NTOK = 65536, SEQ = 8192, DM = 1024, DFF = 2816, NMEMROWS = 2048;
constexpr float EPS = 1e-6f;
constexpr float LOG2_THETA = 13.287712379549449f;
constexpr float INV2PI = 0.15915494309189535f;
constexpr size_t MiB = 1ull << 20;
constexpr size_t WS_WT_IN0 = 0;
constexpr size_t WS_WT_QB = WS_WT_IN0 + 1280ull * 1024 * 2;
constexpr size_t WS_WT_KVB = WS_WT_QB + 1536ull * 384 * 2;
constexpr size_t WS_WT_OUT = WS_WT_KVB + 2048ull * 256 * 2;
constexpr size_t WS_WT_MEMKV = WS_WT_OUT + 2ull * 1024 * 1536 * 2;
constexpr size_t WS_WT_GU = WS_WT_MEMKV + 2ull * 1024 * 1024 * 2;
constexpr size_t WS_WT_DN = WS_WT_GU + 2ull * 5632 * 1024 * 2;
constexpr size_t WS_WT_IN1 = WS_WT_DN + 2ull * 1024 * 2816 * 2;
constexpr size_t WS_WT_END = WS_WT_IN1 + 2048ull * 1024 * 2;
static_assert(WS_WT_END <= 56 * MiB, "weights region");
constexpr size_t WS_MEMN = 56 * MiB;
constexpr size_t WS_MEMKV = 60 * MiB;
constexpr size_t WS_BAR = 70 * MiB;
constexpr size_t WS_ROWSS = 70 * MiB + 65536;
constexpr size_t WS_HM = 72 * MiB;
constexpr size_t WS_R = 264 * MiB;
constexpr size_t WS_Q = WS_R + 160 * MiB;
constexpr size_t WS_KV = WS_Q + 192 * MiB;
constexpr size_t WS_XB = WS_R + 352 * MiB;
constexpr size_t WS_END = WS_KV + 256 * MiB;

struct Params { const float* in[21]; float* out; unsigned char* ws; int ph_lo, ph_hi; };

__device__ __forceinline__ float bf2f(bf16_t v) { return __uint_as_float(((unsigned)v) << 16); }
__device__ __forceinline__ bf16_t f2bf(float f) { unsigned u = __float_as_uint(f); u += 0x7FFFu + ((u >> 16) & 1u); return (bf16_t)(u >> 16); }
__device__ __forceinline__ unsigned cvtpk(float lo, float hi) { unsigned r; asm volatile("v_cvt_pk_bf16_f32 %0, %1, %2" : "=v"(r) : "v"(lo), "v"(hi)); return r; }
__device__ __forceinline__ float wave_sum(float v) {
#pragma unroll
  for (int o = 32; o > 0; o >>= 1) v += __shfl_xor(v, o, 64);
  return v;
}

__device__ __forceinline__ int opaque_tid() { int t = threadIdx.x; asm volatile("" : "+v"(t)); return t; }

namespace pg8 {
constexpr int BM = 256, BK = 64, HALF = 128, HTB = HALF * BK * 2, STAGE_BYTES = 8 * HTB, NXCD = 8, WGM = 8;
__device__ __forceinline__ int lds_byte(int r, int c) { const int st = (r >> 4) * 2 + (c >> 5), rr = r & 15, cc = c & 31, ob = rr * 64 + cc * 2; return st * 1024 + (ob ^ (((ob >> 9) & 1) << 5)); }
__device__ __forceinline__ void stage_rc(int b, int& R, int& C) { const int st = b / 1024, sb = b % 1024, swz = sb ^ (((sb >> 9) & 1) << 5); R = (st >> 1) * 16 + swz / 64; C = (st & 1) * 32 + (swz % 64) / 2; }
__device__ __forceinline__ int perm32(int rho) { const int n = rho >> 4, i = rho & 15; return 8 * (i >> 2) + 4 * n + (i & 3); }
struct Unit { int pm, pn; };
struct Gemm { const bf16_t* A; const bf16_t* Bt; int M, N, K, lda; };
struct StaticOrder {
  int nM, nN, nwg, G, c;
  __device__ void init(int M, int N, int G_, int c_) { nM = M / BM; nN = N / BM; nwg = nM * nN; G = G_; c = c_; }
  __device__ bool next(int i, Unit& u) const {
    const long L = (long)i * G + c; if (L >= nwg) return false;
    int wgid = (int)L; { const int q = nwg / NXCD, r = nwg % NXCD, xcd = wgid % NXCD, off = wgid / NXCD; wgid = (xcd < r ? xcd * (q + 1) : r * (q + 1) + (xcd - r) * q) + off; }
    const int nig = WGM * nN, gid = wgid / nig, fm = gid * WGM, gsz = (nM - fm) < WGM ? (nM - fm) : WGM;
    u.pm = fm + ((wgid % nig) % gsz); u.pn = (wgid % nig) / gsz; return true;
  }
};

struct EpiBf16 {
  static constexpr bool PERM = true;
  bf16_t* O; int ldc; const float* rowss;
  __device__ __forceinline__ void operator()(const f32x4 (&acc)[2][2][4][2], const Unit& u, int wr, int wc, int fr, int fq) const {
    const int row0 = u.pm * BM + wr * 64 + fr, col0 = u.pn * BM + wc * 32 + 8 * fq;
    float rsv[2][4];
#pragma unroll
    for (int ai = 0; ai < 2; ++ai)
#pragma unroll
      for (int m = 0; m < 4; ++m) rsv[ai][m] = rowss ? rowss[row0 + ai * HALF + m * 16] : 0.f;
#pragma unroll
    for (int ai = 0; ai < 2; ++ai)
#pragma unroll
      for (int m = 0; m < 4; ++m) { const int row = row0 + ai * HALF + m * 16; bf16_t* rowp = O + (size_t)row * ldc + col0;
        const float rs = rowss ? rsqrtf(rsv[ai][m] * (1.f / DM) + EPS) : 1.f;
#pragma unroll
        for (int bj = 0; bj < 2; ++bj) { const f32x4 v0 = acc[ai][bj][m][0] * rs, v1 = acc[ai][bj][m][1] * rs;
          u32x4 w; w.x = cvtpk(v0[0], v0[1]); w.y = cvtpk(v0[2], v0[3]); w.z = cvtpk(v1[0], v1[1]); w.w = cvtpk(v1[2], v1[3]);
          *(u32x4*)(rowp + bj * HALF) = w; } }
  }
};
struct EpiResF32 {
  static constexpr bool PERM = false;
  float* out; const float* res; bf16_t* xb; float* rowss;
  __device__ __forceinline__ void operator()(const f32x4 (&acc)[2][2][4][2], const Unit& u, int wr, int wc, int fr, int fq) const {
    const int row0 = u.pm * BM + wr * 64 + fr, col0 = u.pn * BM + wc * 32 + 4 * fq;
    f32x4 r[2][2][2][2];
#define ER_LOAD(buf, ai, mp) do { _Pragma("unroll") for (int mm = 0; mm < 2; ++mm) { const size_t off = (size_t)(row0 + (ai) * HALF + ((mp) + mm) * 16) * DM + col0; \
      _Pragma("unroll") for (int bj = 0; bj < 2; ++bj) _Pragma("unroll") for (int n = 0; n < 2; ++n) r[buf][mm][bj][n] = *(const f32x4*)(res + off + bj * HALF + n * 16); } } while (0)
#define ER_STORE(buf, ai, mp) do { _Pragma("unroll") for (int mm = 0; mm < 2; ++mm) { const int row = row0 + (ai) * HALF + ((mp) + mm) * 16; const size_t off = (size_t)row * DM + col0; float ss = 0.f; \
      _Pragma("unroll") for (int bj = 0; bj < 2; ++bj) _Pragma("unroll") for (int n = 0; n < 2; ++n) { const f32x4 v = r[buf][mm][bj][n] + acc[ai][bj][(mp) + mm][n]; \
        *(f32x4*)(out + off + bj * HALF + n * 16) = v; \
        if (xb) { u32x2 w; w.x = cvtpk(v[0], v[1]); w.y = cvtpk(v[2], v[3]); *(u32x2*)(xb + off + bj * HALF + n * 16) = w; ss += v[0] * v[0] + v[1] * v[1] + v[2] * v[2] + v[3] * v[3]; } } \
      if (xb) { ss += __shfl_xor(ss, 16, 64); ss += __shfl_xor(ss, 32, 64); if (fq == 0) unsafeAtomicAdd(rowss + row, ss); } } } while (0)
    ER_LOAD(0, 0, 0); ER_LOAD(1, 0, 2);
    ER_STORE(0, 0, 0); ER_LOAD(0, 1, 0);
    ER_STORE(1, 0, 2); ER_LOAD(1, 1, 2);
    ER_STORE(0, 1, 0); ER_STORE(1, 1, 2);
#undef ER_LOAD
#undef ER_STORE
  }
};
struct EpiSwiGLU {
  static constexpr bool PERM = true;
  bf16_t* O; const float* rowss;
  __device__ __forceinline__ void operator()(const f32x4 (&acc)[2][2][4][2], const Unit& u, int wr, int wc, int fr, int fq) const {
    const int row0 = u.pm * BM + wr * 64 + fr, col0 = u.pn * HALF + wc * 32 + 8 * fq;
    float rsv[2][4];
#pragma unroll
    for (int ai = 0; ai < 2; ++ai)
#pragma unroll
      for (int m = 0; m < 4; ++m) rsv[ai][m] = rowss[row0 + ai * HALF + m * 16];
#pragma unroll
    for (int ai = 0; ai < 2; ++ai)
#pragma unroll
      for (int m = 0; m < 4; ++m) { const int row = row0 + ai * HALF + m * 16; bf16_t* rowp = O + (size_t)row * DFF + col0;
        const float rs = rsqrtf(rsv[ai][m] * (1.f / DM) + EPS);
        float y[8];
#pragma unroll
        for (int n = 0; n < 2; ++n)
#pragma unroll
          for (int j = 0; j < 4; ++j) { const float g = acc[ai][0][m][n][j] * rs, up = acc[ai][1][m][n][j] * rs;
            const float e = __builtin_amdgcn_exp2f(-g * 1.4426950408889634f);
            y[n * 4 + j] = g * __builtin_amdgcn_rcpf(1.0f + e) * up; }
        u32x4 w; w.x = cvtpk(y[0], y[1]); w.y = cvtpk(y[2], y[3]); w.z = cvtpk(y[4], y[5]); w.w = cvtpk(y[6], y[7]);
        *(u32x4*)rowp = w; }
  }
};

template <class Epi>
__device__ __forceinline__ void gemm_phase(LAS unsigned char* lds, const Gemm g, const StaticOrder& S, const Epi& E) {
  const int tid = opaque_tid(), wid = __builtin_amdgcn_readfirstlane(tid >> 6), lane = tid & 63, wr = wid >> 2, wc = wid & 3, fr = lane & 15, fq = lane >> 4;
  const int K = g.K, nt = K / BK, lda = g.lda;
  unsigned voffA[2], voffB[2];
#pragma unroll
  for (int i = 0; i < 2; ++i) { int R, C; stage_rc(tid * 16 + i * 8192, R, C); const int Rb = Epi::PERM ? ((R & ~31) + perm32(R & 31)) : R;
    voffA[i] = (unsigned)(R * lda + C) * 2u; voffB[i] = (unsigned)(Rb * K + C) * 2u; }
  const size_t kstep = (size_t)(BK * 2);
  const size_t hstepA = (size_t)HALF * lda * 2, hstepB = (size_t)HALF * K * 2;
  const size_t tstepA = 2 * hstepA, tstepB = 2 * hstepB;
  const unsigned ldsw = (unsigned)wid * 1024u;
  const int aoff = lds_byte(wr * 64 + fr, fq * 8), boff = lds_byte(wc * 32 + fr, fq * 8);
#define PG8_SA(b, h) (((b) * 2 + (h)) * HTB)
#define PG8_SB(b, h) ((4 + (b) * 2 + (h)) * HTB)
#define PG8_STAGE(bufoff, gbase, voff) do { _Pragma("unroll") for (int _i = 0; _i < 2; ++_i) \
    __builtin_amdgcn_global_load_lds((const unsigned*)((const char*)(gbase) + (voff)[_i]), (LAS unsigned*)(lds + (bufoff) + ldsw + _i * 8192), 16, 0, 0); } while (0)
#define PG8_LDA(dst, b, h) do { _Pragma("unroll") for (int m = 0; m < 4; ++m) _Pragma("unroll") for (int k = 0; k < 2; ++k) dst[m][k] = *(const LAS bf16x8*)(lds + PG8_SA(b, h) + aoff + m * 2048 + k * 1024); } while (0)
#define PG8_LDB(dst, b, h) do { _Pragma("unroll") for (int n = 0; n < 2; ++n) _Pragma("unroll") for (int k = 0; k < 2; ++k) dst[n][k] = *(const LAS bf16x8*)(lds + PG8_SB(b, h) + boff + n * 2048 + k * 1024); } while (0)
#define PG8_MMA(ai, bj, At, Bt) do { __builtin_amdgcn_s_setprio(1); _Pragma("unroll") for (int m = 0; m < 4; ++m) _Pragma("unroll") for (int n = 0; n < 2; ++n) _Pragma("unroll") for (int k = 0; k < 2; ++k) \
    acc[ai][bj][m][n] = __builtin_amdgcn_mfma_f32_16x16x32_bf16(Bt[n][k], At[m][k], acc[ai][bj][m][n], 0, 0, 0); __builtin_amdgcn_s_setprio(0); } while (0)
#define PG8_WAIT_V(n) asm volatile("s_waitcnt vmcnt(" #n ")" ::: "memory")
#define PG8_WAIT_L(n) asm volatile("s_waitcnt lgkmcnt(" #n ")" ::: "memory")
#define PG8_BAR __builtin_amdgcn_s_barrier()
#define PG8_SCHED __builtin_amdgcn_sched_barrier(0)
  Unit cur, nxt; int ui = 0;
  if (!S.next(0, cur)) return;
  f32x4 acc[2][2][4][2];
#pragma unroll
  for (int a = 0; a < 2; ++a)
#pragma unroll
    for (int b = 0; b < 2; ++b)
#pragma unroll
      for (int m = 0; m < 4; ++m)
#pragma unroll
        for (int n = 0; n < 2; ++n) acc[a][b][m][n] = (f32x4){0.f, 0.f, 0.f, 0.f};
  bf16x8 At[4][2], B0[2][2], B1[2][2];
  const char* cA = (const char*)g.A + (size_t)cur.pm * tstepA; const char* cB = (const char*)g.Bt + (size_t)cur.pn * tstepB;
  PG8_STAGE(PG8_SB(0, 0), cB, voffB); PG8_STAGE(PG8_SA(0, 0), cA, voffA); PG8_STAGE(PG8_SB(0, 1), cB + hstepB, voffB); PG8_STAGE(PG8_SA(0, 1), cA + hstepA, voffA);
  if (wr == 1) PG8_BAR;
  PG8_WAIT_V(4); PG8_BAR;
  PG8_STAGE(PG8_SB(1, 0), cB + kstep, voffB); PG8_STAGE(PG8_SA(1, 0), cA + kstep, voffA); PG8_STAGE(PG8_SB(1, 1), cB + hstepB + kstep, voffB);
  PG8_WAIT_V(6); PG8_BAR;
  for (;;) {
    const bool has_next = S.next(ui + 1, nxt);
    const char* nA = has_next ? (const char*)g.A + (size_t)nxt.pm * tstepA : cA; const char* nB = has_next ? (const char*)g.Bt + (size_t)nxt.pn * tstepB : cB;
    for (int t = 0; t < nt; t += 2) {
      const bool last = (t == nt - 2);
      const char* a1 = cA + (size_t)(t + 1) * kstep;
      const char* a2 = last ? nA : cA + (size_t)(t + 2) * kstep; const char* b2 = last ? nB : cB + (size_t)(t + 2) * kstep;
      const char* a3 = a2 + kstep; const char* b3 = b2 + kstep;
      PG8_LDB(B0, 0, 0); PG8_SCHED; PG8_LDA(At, 0, 0); PG8_STAGE(PG8_SA(1, 1), a1 + hstepA, voffA);
      PG8_WAIT_L(8); PG8_BAR; PG8_WAIT_L(0); PG8_MMA(0, 0, At, B0); PG8_BAR; PG8_SCHED;
      PG8_LDB(B1, 0, 1); PG8_STAGE(PG8_SB(0, 0), b2, voffB);
      PG8_BAR; PG8_WAIT_L(0); PG8_MMA(0, 1, At, B1); PG8_BAR;
      PG8_LDA(At, 0, 1); PG8_STAGE(PG8_SA(0, 0), a2, voffA);
      PG8_BAR; PG8_WAIT_L(0); PG8_MMA(1, 0, At, B0); PG8_BAR; PG8_SCHED;
      PG8_STAGE(PG8_SB(0, 1), b2 + hstepB, voffB);
      PG8_WAIT_V(6); PG8_BAR; PG8_MMA(1, 1, At, B1); PG8_BAR;
      PG8_LDB(B0, 1, 0); PG8_SCHED; PG8_LDA(At, 1, 0); PG8_STAGE(PG8_SA(0, 1), a2 + hstepA, voffA);
      PG8_WAIT_L(8); PG8_BAR; PG8_WAIT_L(0); PG8_MMA(0, 0, At, B0); PG8_BAR; PG8_SCHED;
      PG8_LDB(B1, 1, 1); PG8_STAGE(PG8_SB(1, 0), b3, voffB);
      PG8_BAR; PG8_WAIT_L(0); PG8_MMA(0, 1, At, B1); PG8_BAR;
      PG8_LDA(At, 1, 1); PG8_STAGE(PG8_SA(1, 0), a3, voffA);
      PG8_BAR; PG8_WAIT_L(0); PG8_MMA(1, 0, At, B0); PG8_BAR; PG8_SCHED;
      PG8_STAGE(PG8_SB(1, 1), b3 + hstepB, voffB);
      PG8_WAIT_V(6); PG8_BAR; PG8_MMA(1, 1, At, B1); PG8_BAR;
    }
    E(acc, cur, wr, wc, fr, fq);
    if (!has_next) break;
#pragma unroll
    for (int a = 0; a < 2; ++a)
#pragma unroll
      for (int b = 0; b < 2; ++b)
#pragma unroll
        for (int m = 0; m < 4; ++m)
#pragma unroll
          for (int n = 0; n < 2; ++n) acc[a][b][m][n] = (f32x4){0.f, 0.f, 0.f, 0.f};
    cur = nxt; cA = nA; cB = nB; ++ui;
  }
  PG8_WAIT_V(0);
  if (wr == 0) PG8_BAR;
  PG8_BAR;
#undef PG8_SA
#undef PG8_SB
#undef PG8_STAGE
#undef PG8_LDA
#undef PG8_LDB
#undef PG8_MMA
#undef PG8_WAIT_V
#undef PG8_WAIT_L
#undef PG8_BAR
#undef PG8_SCHED
}
template <class Epi>
__device__ __forceinline__ void run_gemm(LAS unsigned char* lds, const bf16_t* A, int lda, const bf16_t* Bt, int M, int N, int K, const Epi& E, int coff) {
  Gemm g{A, Bt, M, N, K, lda};
  StaticOrder S; S.init(M, N, (int)gridDim.x, (int)((blockIdx.x + coff) % gridDim.x));
  gemm_phase<Epi>(lds, g, S, E);
}
}

namespace att {
constexpr int NW = 8, QBLK = 32, KVBLK = 64;
constexpr float THR = 8.f;
constexpr int SHM_V = KVBLK * 128 * 2, SHM_K = KVBLK * 128 * 2, SHM_K2 = KVBLK * 64 * 2;
constexpr int OFF_K = 2 * SHM_V, OFF_K2 = OFF_K + 2 * SHM_K, OFF_WS = OFF_K2 + 2 * SHM_K2, OFF_Q2 = OFF_WS + NW * 64 * 4, SHM_ATTN = OFF_Q2 + 32768;
#define KSWZ(row, colB) ((row) * 256 + ((colB) ^ (((row) & 7) << 4)))
#define K2SWZ(row, colB) ((row) * 128 + ((colB) ^ ((((row) >> 1) & 7) << 4)))
#define SBAR() __builtin_amdgcn_sched_barrier(0)
__device__ __forceinline__ int crow(int r, int hi) { return (r & 3) + 8 * (r >> 2) + 4 * hi; }
__device__ __forceinline__ void partialSM(f32x16& p0, f32x16& p1, float& m_reg, float& mn, float& alpha, float C, float thr_s) {
  float pmax = p0[0];
#pragma unroll
  for (int r = 1; r < 16; ++r) pmax = fmaxf(pmax, p0[r]);
#pragma unroll
  for (int r = 0; r < 16; ++r) pmax = fmaxf(pmax, p1[r]);
  { auto rr = __builtin_amdgcn_permlane32_swap(__float_as_uint(pmax), __float_as_uint(pmax), false, false);
    pmax = fmaxf(__uint_as_float(rr[0]), __uint_as_float(rr[1])); }
  if (__builtin_expect(__all(pmax - m_reg <= thr_s), 1)) { mn = m_reg; alpha = 1.f; }
  else { mn = fmaxf(m_reg, pmax); alpha = __builtin_amdgcn_exp2f((m_reg - mn) * C); m_reg = mn; }
  float mnC = -mn * C;
#pragma unroll
  for (int r = 0; r < 16; ++r) p0[r] = fmaf(p0[r], C, mnC);
#pragma unroll
  for (int r = 0; r < 16; ++r) p1[r] = fmaf(p1[r], C, mnC);
#pragma unroll
  for (int r = 0; r < 16; ++r) p0[r] = __builtin_amdgcn_exp2f(p0[r]);
}
__device__ __forceinline__ void finishSM(f32x16& p0, f32x16& p1, float alpha, float& l_reg, bf16x8& pa0, bf16x8& pa1, bf16x8& pa2, bf16x8& pa3) {
#pragma unroll
  for (int r = 0; r < 16; ++r) p1[r] = __builtin_amdgcn_exp2f(p1[r]);
  float ps = 0;
#pragma unroll
  for (int r = 0; r < 16; ++r) ps += p0[r];
#pragma unroll
  for (int r = 0; r < 16; ++r) ps += p1[r];
  { auto rr = __builtin_amdgcn_permlane32_swap(__float_as_uint(ps), __float_as_uint(ps), false, false);
    ps = __uint_as_float(rr[0]) + __uint_as_float(rr[1]); }
  l_reg = l_reg * alpha + ps;
#define PK4(P, BASE, OUT) do { unsigned a0 = cvtpk(P[BASE + 0], P[BASE + 1]), a1 = cvtpk(P[BASE + 2], P[BASE + 3]);   \
    unsigned b0 = cvtpk(P[BASE + 4], P[BASE + 5]), b1 = cvtpk(P[BASE + 6], P[BASE + 7]);                              \
    auto r0 = __builtin_amdgcn_permlane32_swap(a0, b0, false, false); auto r1 = __builtin_amdgcn_permlane32_swap(a1, b1, false, false); \
    u32x4 w = {r0[0], r1[0], r0[1], r1[1]}; OUT = *reinterpret_cast<bf16x8*>(&w); } while (0)
  PK4(p0, 0, pa0); PK4(p0, 8, pa1); PK4(p1, 0, pa2); PK4(p1, 8, pa3);
#undef PK4
}
template <int DQK>
__device__ __forceinline__ void qkt(f32x16& p0, f32x16& p1, const char* Ks, const char* K2s, const bf16x8* qr, const char* q2l, int r32, int hi) {
#pragma unroll
  for (int r = 0; r < 16; ++r) { p0[r] = 0.f; p1[r] = 0.f; }
#pragma unroll
  for (int d0 = 0; d0 < 8; ++d0) { int cb = (d0 * 16 + hi * 8) * 2;
    bf16x8 b0 = *reinterpret_cast<const bf16x8*>(Ks + KSWZ(r32, cb));
    bf16x8 b1 = *reinterpret_cast<const bf16x8*>(Ks + KSWZ(32 + r32, cb));
    p0 = __builtin_amdgcn_mfma_f32_32x32x16_bf16(b0, qr[d0], p0, 0, 0, 0);
    p1 = __builtin_amdgcn_mfma_f32_32x32x16_bf16(b1, qr[d0], p1, 0, 0, 0); }
  if constexpr (DQK == 192) {
#pragma unroll
    for (int d0 = 0; d0 < 4; ++d0) { int cb = (d0 * 16 + hi * 8) * 2;
      bf16x8 b0 = *reinterpret_cast<const bf16x8*>(K2s + K2SWZ(r32, cb));
      bf16x8 b1 = *reinterpret_cast<const bf16x8*>(K2s + K2SWZ(32 + r32, cb));
      const bf16x8 q2 = *reinterpret_cast<const bf16x8*>(q2l + d0 * 1024);
      p0 = __builtin_amdgcn_mfma_f32_32x32x16_bf16(b0, q2, p0, 0, 0, 0);
      p1 = __builtin_amdgcn_mfma_f32_32x32x16_bf16(b1, q2, p1, 0, 0, 0); }
  }
}
__device__ __forceinline__ int v_st(int k, int c) { const int kk = (k & ~0xC) | ((k & 4) << 1) | ((k & 8) >> 1); return ((kk >> 3) * 4 + (c >> 5)) * 512 + ((kk & 7) * 32 + (c & 31)) * 2; }
__device__ __forceinline__ int v_rd_base(int lane) { return ((lane & 3) << 3) | (((lane >> 2) & 3) << 6) | (((lane >> 4) & 1) << 5) | (((lane >> 5) & 1) << 8); }
constexpr int v_rd_off(int d0, int ks, int half) { return d0 * 512 + ks * 4096 + half * 2048; }
template <int OFF> __device__ __forceinline__ s16x4 tr_read(int vb) {
  s16x4 r; asm volatile("ds_read_b64_tr_b16 %0, %1 offset:%2" : "=&v"(r) : "v"(vb), "i"(OFF) : "memory"); return r;
}
template <int D0> __device__ __forceinline__ void pv_one(f32x16& od, int vb, bf16x8 pa0, bf16x8 pa1, bf16x8 pa2, bf16x8 pa3) {
  const s16x4 l0 = tr_read<v_rd_off(D0, 0, 0)>(vb), h0 = tr_read<v_rd_off(D0, 0, 1)>(vb), l1 = tr_read<v_rd_off(D0, 1, 0)>(vb), h1 = tr_read<v_rd_off(D0, 1, 1)>(vb);
  const s16x4 l2 = tr_read<v_rd_off(D0, 2, 0)>(vb), h2 = tr_read<v_rd_off(D0, 2, 1)>(vb), l3 = tr_read<v_rd_off(D0, 3, 0)>(vb), h3 = tr_read<v_rd_off(D0, 3, 1)>(vb);
  asm volatile("s_waitcnt lgkmcnt(0)" ::: "memory"); SBAR();
#define PK(L, H) (bf16x8){L[0], L[1], L[2], L[3], H[0], H[1], H[2], H[3]}
  od = __builtin_amdgcn_mfma_f32_32x32x16_bf16(pa0, PK(l0, h0), od, 0, 0, 0);
  od = __builtin_amdgcn_mfma_f32_32x32x16_bf16(pa1, PK(l1, h1), od, 0, 0, 0);
  od = __builtin_amdgcn_mfma_f32_32x32x16_bf16(pa2, PK(l2, h2), od, 0, 0, 0);
  od = __builtin_amdgcn_mfma_f32_32x32x16_bf16(pa3, PK(l3, h3), od, 0, 0, 0);
#undef PK
}
__device__ __forceinline__ void pv_d0(f32x16* o, int vb, bf16x8 pa0, bf16x8 pa1, bf16x8 pa2, bf16x8 pa3) {
  pv_one<0>(o[0], vb, pa0, pa1, pa2, pa3); pv_one<1>(o[1], vb, pa0, pa1, pa2, pa3); pv_one<2>(o[2], vb, pa0, pa1, pa2, pa3); pv_one<3>(o[3], vb, pa0, pa1, pa2, pa3);
}

template <int DQK, int SDEPTH>
__device__ __forceinline__ void attn_body(const bf16_t* __restrict__ Qb, const bf16_t* __restrict__ Q2b, int ldq, const bf16_t* __restrict__ Kh, int ldk, const bf16_t* __restrict__ K2h, int ldk2,
                                          const bf16_t* __restrict__ Vh, int ldv, bf16_t* __restrict__ Ob, int ldo, int seq, float scale, char* lds) {
  constexpr int ND = 8;
  const int tid = opaque_tid(), wid = tid >> 6, lane = tid & 63, r32 = lane & 31, hi = lane >> 5;
  const float C = scale * 1.4426950408889634f, thr_s = THR / scale;
  char* V_lds = lds; char* K_lds = lds + OFF_K; char* K2_lds = lds + OFF_K2;
  float* ws = (float*)(lds + OFF_WS) + wid * 64; float* li_l = ws; float* al_l = ws + 32;
  float m_reg = -1e30f, l_reg = 0; f32x16 o[4]; bf16x8 qr[ND];
#pragma unroll
  for (int d = 0; d < 4; ++d)
#pragma unroll
    for (int r = 0; r < 16; ++r) o[d][r] = 0.f;
  const bf16_t* Qw = Qb + (long)(wid * QBLK + r32) * ldq + hi * 8;
#pragma unroll
  for (int d0 = 0; d0 < ND; ++d0) qr[d0] = *reinterpret_cast<const bf16x8*>(Qw + d0 * 16);
  char* q2l = lds + OFF_Q2 + (wid * 4 * 64 + lane) * 16;
  __syncthreads();
  if constexpr (DQK == 192) {
#pragma unroll
    for (int d0 = 0; d0 < 4; ++d0) *reinterpret_cast<bf16x8*>(q2l + d0 * 1024) = *reinterpret_cast<const bf16x8*>(Q2b + (long)(wid * QBLK + r32) * ldq + hi * 8 + d0 * 16);
  }
  const int sr = tid >> 4, sc = (tid & 15) * 8, vst0 = v_st(sr, sc), vst1 = v_st(32 + sr, sc);
  const int sr2 = tid >> 3, sc2 = (tid & 7) * 8;
  const unsigned voffV = (unsigned)(sr * ldv + sc) * 2u, voffK = (unsigned)(sr * ldk + sc) * 2u, voffK2 = (unsigned)(sr2 * ldk2 + sc2) * 2u;
  const size_t tsV = (size_t)ldv * 2, tsK = (size_t)ldk * 2, tsK2 = (size_t)ldk2 * 2;
  const int vb0 = (int)(uintptr_t)V_lds + v_rd_base(lane);
  struct { bf16x8 vs0, vs1, ks0, ks1, k2; } sr_[SDEPTH];
#define SLOAD(i, k0) do { const char* vb_ = (const char*)Vh + (size_t)(k0) * tsV; const char* kb_ = (const char*)Kh + (size_t)(k0) * tsK; \
    sr_[i].vs0 = *(const bf16x8*)(vb_ + voffV); sr_[i].vs1 = *(const bf16x8*)(vb_ + 32 * tsV + voffV); \
    sr_[i].ks0 = *(const bf16x8*)(kb_ + voffK); sr_[i].ks1 = *(const bf16x8*)(kb_ + 32 * tsK + voffK); \
    if constexpr (DQK == 192) sr_[i].k2 = *(const bf16x8*)((const char*)K2h + (size_t)(k0) * tsK2 + voffK2); } while (0)
#define SWRITE(b, i) do { *(bf16x8*)(V_lds + (b) * SHM_V + vst0) = sr_[i].vs0;          \
    *(bf16x8*)(V_lds + (b) * SHM_V + vst1) = sr_[i].vs1; int kc = sc * 2;               \
    *(bf16x8*)(K_lds + (b) * SHM_K + KSWZ(sr, kc)) = sr_[i].ks0;                       \
    *(bf16x8*)(K_lds + (b) * SHM_K + KSWZ(32 + sr, kc)) = sr_[i].ks1;                  \
    if constexpr (DQK == 192) *(bf16x8*)(K2_lds + (b) * SHM_K2 + K2SWZ(sr2, sc2 * 2)) = sr_[i].k2; } while (0)
#define SWAIT() do { if constexpr (SDEPTH == 1) asm volatile("s_waitcnt vmcnt(0)" ::: "memory"); else if constexpr (DQK == 192) asm volatile("s_waitcnt vmcnt(5)" ::: "memory"); else asm volatile("s_waitcnt vmcnt(4)" ::: "memory"); } while (0)
#define RESC(a) do { if (__any((a) < 1.f)) { if (hi == 0) al_l[r32] = (a); asm volatile("s_waitcnt lgkmcnt(0)" ::: "memory"); \
    _Pragma("unroll") for (int d = 0; d < 4; ++d) _Pragma("unroll") for (int r = 0; r < 16; ++r) o[d][r] *= al_l[crow(r, hi)]; } } while (0)
  f32x16 pA0, pA1, pB0, pB1; float mnA, mnB, alA, alB; bf16x8 pa0, pa1, pa2, pa3; const int NT = seq / KVBLK;
  constexpr int SE = 0, SO = SDEPTH - 1;
  SLOAD(SE, 0); asm volatile("s_waitcnt vmcnt(0)" ::: "memory"); SWRITE(0, SE); __syncthreads();
  qkt<DQK>(pA0, pA1, K_lds, K2_lds, qr, q2l, r32, hi); partialSM(pA0, pA1, m_reg, mnA, alA, C, thr_s);
  SLOAD(SO, KVBLK); if constexpr (SDEPTH == 2) { if (2 < NT) SLOAD(SE, 2 * KVBLK); }
  SWAIT(); SWRITE(1, SO); __syncthreads();
  for (int j = 1; j + 1 < NT; j += 2) {
    SBAR(); qkt<DQK>(pB0, pB1, K_lds + SHM_K, K2_lds + SHM_K2, qr, q2l, r32, hi);
    finishSM(pA0, pA1, alA, l_reg, pa0, pa1, pa2, pa3); SBAR();
    SLOAD(SO, (j + SDEPTH) * KVBLK); SBAR();
    pv_d0(o, vb0, pa0, pa1, pa2, pa3); partialSM(pB0, pB1, m_reg, mnB, alB, C, thr_s);
    __syncthreads(); SWAIT(); SWRITE(0, SE);
    RESC(alB); __syncthreads();
    SBAR(); qkt<DQK>(pA0, pA1, K_lds, K2_lds, qr, q2l, r32, hi);
    finishSM(pB0, pB1, alB, l_reg, pa0, pa1, pa2, pa3); SBAR();
    if (SDEPTH == 1 || j + 3 < NT) SLOAD(SE, (j + 1 + SDEPTH) * KVBLK); SBAR();
    pv_d0(o, vb0 + SHM_V, pa0, pa1, pa2, pa3); partialSM(pA0, pA1, m_reg, mnA, alA, C, thr_s);
    __syncthreads(); SWAIT(); SWRITE(1, SO);
    RESC(alA); __syncthreads();
  }
  SBAR(); qkt<DQK>(pB0, pB1, K_lds + SHM_K, K2_lds + SHM_K2, qr, q2l, r32, hi);
  finishSM(pA0, pA1, alA, l_reg, pa0, pa1, pa2, pa3); SBAR();
  pv_d0(o, vb0, pa0, pa1, pa2, pa3); partialSM(pB0, pB1, m_reg, mnB, alB, C, thr_s);
  __syncthreads(); RESC(alB);
  finishSM(pB0, pB1, alB, l_reg, pa0, pa1, pa2, pa3); SBAR();
  pv_d0(o, vb0 + SHM_V, pa0, pa1, pa2, pa3);
  if (hi == 0) li_l[r32] = l_reg; asm volatile("s_waitcnt lgkmcnt(0)" ::: "memory");
  float rli[16];
#pragma unroll
  for (int r = 0; r < 16; ++r) rli[r] = __builtin_amdgcn_rcpf(li_l[crow(r, hi)]);
  bf16_t* Ow = Ob + (long)(wid * QBLK) * ldo;
#pragma unroll
  for (int r = 0; r < 16; ++r) { int orow = crow(r, hi);
#pragma unroll
    for (int d0 = 0; d0 < 4; ++d0) Ow[(long)orow * ldo + d0 * 32 + r32] = f2bf(o[d0][r] * rli[r]); }
#undef SLOAD
#undef SWRITE
#undef SWAIT
#undef RESC
}
struct AttnJob { const bf16_t* Q; const bf16_t* Q2; int ldq, qhs; const bf16_t* K; int ldk, khs; long kbs; const bf16_t* K2; int ldk2; const bf16_t* V; int ldv; bf16_t* O; int H, gshift, seq, nunits; float scale; };
template <int DQK, int SDEPTH>
__device__ __forceinline__ void run_attn(const AttnJob& a, char* lds) {
  for (int u = blockIdx.x; u < a.nunits; u += gridDim.x) {
    const int per_b = a.H * 32, b = u / per_b, rest = u - b * per_b, h = rest % a.H, qb = rest / a.H, kh = h >> a.gshift;
    const long tok0 = (long)b * SEQ + qb * 256;
    attn_body<DQK, SDEPTH>(a.Q + tok0 * a.ldq + h * a.qhs, a.Q2 + tok0 * a.ldq + h * 64, a.ldq, a.K + (long)b * a.kbs + kh * a.khs, a.ldk, a.K2 + (long)b * SEQ * a.ldk2, a.ldk2,
                           a.V + (long)b * a.kbs + kh * a.khs, a.ldv, a.O + tok0 * 1536 + h * 128, 1536, a.seq, a.scale, lds);
  }
}
}

__device__ __forceinline__ void rms_rows(const float* __restrict__ src, const float* __restrict__ gain, bf16_t* __restrict__ dst, int nrows) {
  const int tid_ = opaque_tid(), wid = tid_ >> 6, lane = tid_ & 63;
  for (int row = blockIdx.x * 8 + wid; row < nrows; row += gridDim.x * 8) {
    const f32x4* s = (const f32x4*)(src + (size_t)row * DM);
    f32x4 v[4]; float ss = 0.f;
#pragma unroll
    for (int j = 0; j < 4; ++j) { v[j] = s[lane + 64 * j]; ss += v[j][0] * v[j][0] + v[j][1] * v[j][1] + v[j][2] * v[j][2] + v[j][3] * v[j][3]; }
    ss = wave_sum(ss);
    const float rs = rsqrtf(ss * (1.f / DM) + EPS);
#pragma unroll
    for (int j = 0; j < 4; ++j) { const f32x4 g = ((const f32x4*)gain)[lane + 64 * j];
      u32x2 w; w.x = cvtpk(v[j][0] * rs * g[0], v[j][1] * rs * g[1]); w.y = cvtpk(v[j][2] * rs * g[2], v[j][3] * rs * g[3]);
      *(u32x2*)(dst + (size_t)row * DM + (lane + 64 * j) * 4) = w; }
  }
}
template <int MODE>
__device__ __forceinline__ void prep_w(const float* __restrict__ src, int K, int Nsrc, bf16_t* __restrict__ dst, int Ndst, const float* __restrict__ kgain) {
  const long total = (long)Ndst * (K / 8);
  for (long i = (long)blockIdx.x * 512 + opaque_tid(); i < total; i += (long)gridDim.x * 512) {
    const int n = (int)(i % Ndst), k8 = (int)(i / Ndst);
    int ns = n;
    if (MODE == 1) { const int pn = n >> 8, r = n & 255, bj = r >> 7, ii = r & 127; ns = bj * DFF + pn * 128 + ii; }
    if (MODE == 2) { ns = n < 640 ? n : (n < 1152 ? n + 64 : (n < 1216 ? n - 512 : Nsrc)); }
    if (MODE == 3) { ns = n < 1024 ? (n >> 7) * 192 + (n & 127) : ((n - 1024) >> 6) * 192 + 128 + ((n - 1024) & 63); }
    float x[8];
#pragma unroll
    for (int j = 0; j < 8; ++j) x[j] = (ns < Nsrc) ? src[(size_t)(k8 * 8 + j) * Nsrc + ns] : 0.f;
    if (kgain) {
#pragma unroll
      for (int j = 0; j < 8; ++j) x[j] *= kgain[k8 * 8 + j];
    }
    u32x4 w; w.x = cvtpk(x[0], x[1]); w.y = cvtpk(x[2], x[3]); w.z = cvtpk(x[4], x[5]); w.w = cvtpk(x[6], x[7]);
    *(u32x4*)(dst + (size_t)n * K + k8 * 8) = w;
  }
}
__device__ __forceinline__ void unpack8(u32x4 w, float* v) {
#pragma unroll
  for (int i = 0; i < 4; ++i) { v[2 * i] = __uint_as_float(w[i] << 16); v[2 * i + 1] = __uint_as_float(w[i] & 0xffff0000u); }
}
__device__ __forceinline__ u32x4 pack8(const float* v) { u32x4 w; w.x = cvtpk(v[0], v[1]); w.y = cvtpk(v[2], v[3]); w.z = cvtpk(v[4], v[5]); w.w = cvtpk(v[6], v[7]); return w; }
__device__ __forceinline__ float sumsq8(const float* v) { float s = 0.f;
#pragma unroll
  for (int j = 0; j < 8; ++j) s += v[j] * v[j];
  return s; }
template <int GL> __device__ __forceinline__ float group_sum(float s) {
#pragma unroll
  for (int o = 1; o < GL; o <<= 1) s += __shfl_xor(s, o, 64);
  return s;
}
__device__ __forceinline__ void load8(float* g, const float* __restrict__ p) { const f32x4 a = *(const f32x4*)p, b = *(const f32x4*)(p + 4);
  g[0] = a[0]; g[1] = a[1]; g[2] = a[2]; g[3] = a[3]; g[4] = b[0]; g[5] = b[1]; g[6] = b[2]; g[7] = b[3]; }
template <int GL> __device__ __forceinline__ void norm8(float* v, const float* g) {
  const float ss = group_sum<GL>(sumsq8(v)); const float rs = rsqrtf(ss * (1.f / (GL * 8)) + EPS);
#pragma unroll
  for (int j = 0; j < 8; ++j) v[j] *= rs * g[j];
}
template <int XM> __device__ __forceinline__ void rope8(float* v, const float* inv, float pos, bool first) {
#pragma unroll
  for (int j = 0; j < 8; ++j) {
    const float partner = __shfl_xor(v[j], XM, 64);
    float rev = pos * inv[j] * INV2PI; rev -= floorf(rev);
    const float c = __builtin_amdgcn_cosf(rev), s = __builtin_amdgcn_sinf(rev);
    v[j] = first ? v[j] * c - partner * s : v[j] * c + partner * s;
  }
}
template <int NE> __device__ __forceinline__ void ld_seg(float* v, const bf16_t* p, int lane) {
#pragma unroll
  for (int j = 0; j < NE; ++j) v[j] = bf2f(p[lane + 64 * j]);
}
template <int NE> __device__ __forceinline__ void st_seg(const float* v, bf16_t* p, int lane) {
#pragma unroll
  for (int j = 0; j < NE; ++j) p[lane + 64 * j] = f2bf(v[j]);
}
template <int NE, int ROPE> __device__ __forceinline__ void norm_seg(float* v, const float* __restrict__ gain, int lane, int prow, int pcol) {
  float ss = 0.f;
#pragma unroll
  for (int j = 0; j < NE; ++j) ss += v[j] * v[j];
  ss = wave_sum(ss);
  const float rs = rsqrtf(ss * (1.f / (64 * NE)) + EPS);
#pragma unroll
  for (int j = 0; j < NE; ++j) v[j] = v[j] * rs * gain[lane + 64 * j];
  if constexpr (ROPE && NE == 2) {
    const int f = lane & 31; const float inv = exp2f(-(float)(2 * f) * (1.f / 64.f) * LOG2_THETA);
#pragma unroll
    for (int j = 0; j < 2; ++j) {
      const float partner = __shfl_xor(v[j], 32, 64);
      const float ang = (float)(j == 0 ? prow : pcol) * inv;
      float rev = ang * INV2PI; rev -= floorf(rev);
      const float c = __builtin_amdgcn_cosf(rev), s = __builtin_amdgcn_sinf(rev);
      v[j] = (lane < 32) ? v[j] * c - partner * s : v[j] * c + partner * s;
    }
  }
  if constexpr (ROPE && NE == 1) {
    const int f = lane & 15; const float inv = exp2f(-(float)(2 * f) * (1.f / 32.f) * LOG2_THETA);
    const float partner = __shfl_xor(v[0], 16, 64);
    const float ang = (float)(lane < 32 ? prow : pcol) * inv;
    float rev = ang * INV2PI; rev -= floorf(rev);
    const float c = __builtin_amdgcn_cosf(rev), s = __builtin_amdgcn_sinf(rev);
    v[0] = (lane & 16) ? v[0] * c + partner * s : v[0] * c - partner * s;
  }
}

#define XB_TMO      128
#define XB_XCNT(j)  (256  + 64 * (j))
#define XB_XSUB(j)  (1280 + 64 * (j))
#define XB_XGEN(j)  (2304 + 64 * (j))
#define XB_TOP      3328
#define XB_TOPGEN   3392
#define XCD_BAR_WORDS 3456
#define XB_SPIN_CAP (1u << 22)
__device__ __forceinline__ unsigned xb_ld(unsigned* p)              { return __hip_atomic_load(p, __ATOMIC_RELAXED, __HIP_MEMORY_SCOPE_AGENT); }
__device__ __forceinline__ unsigned xb_add(unsigned* p, unsigned v) { return __hip_atomic_fetch_add(p, v, __ATOMIC_RELAXED, __HIP_MEMORY_SCOPE_AGENT); }
__device__ __forceinline__ unsigned xb_xcc_id() { return (unsigned)__builtin_amdgcn_s_getreg((3 << 11) | 20) & 0xFu; }
#define XB_SPIN(cond, bar) do { unsigned _sp = 0; while (cond) { __builtin_amdgcn_s_sleep(1); \
    if ((++_sp & 255u) == 0u) { if (xb_ld(&(bar)[XB_TMO])) break; if (_sp > XB_SPIN_CAP) { atomicAdd(&(bar)[XB_TMO], 1u); break; } } } } while (0)
struct XcdBarrier { unsigned* bar; unsigned x; volatile LAS unsigned* st; };
__device__ __forceinline__ XcdBarrier xcd_barrier_post(unsigned* bar, volatile LAS unsigned* st) {
  XcdBarrier b; b.bar = bar; b.x = xb_xcc_id(); b.st = st;
  if (threadIdx.x == 0) (void)xb_add(&bar[XB_XCNT(b.x)], 1u);
  return b;
}
__device__ __forceinline__ void xcd_barrier_complete(unsigned* bar, unsigned x, unsigned& nloc, unsigned& nx) {
  const unsigned G = gridDim.x * gridDim.y * gridDim.z;
  unsigned sum, cnt, mine, sp = 0u;
  for (;;) {
    sum = 0u; cnt = 0u; mine = 0u;
#pragma unroll
    for (unsigned j = 0; j < 16; ++j) { const unsigned c = xb_ld(&bar[XB_XCNT(j)]); sum += c; cnt += (c > 0u) ? 1u : 0u; mine = (j == x) ? c : mine; }
    if (sum == G) break;
    __builtin_amdgcn_s_sleep(1);
    if ((++sp & 255u) == 0u) { if (xb_ld(&bar[XB_TMO])) break; if (sp > XB_SPIN_CAP) { atomicAdd(&bar[XB_TMO], 1u); break; } }
  }
  nloc = mine > 0u ? mine : 1u; nx = cnt > 0u ? cnt : 1u;
}
__device__ __forceinline__ void xcd_barrier(const XcdBarrier& b) {
  asm volatile("s_waitcnt vmcnt(0)" ::: "memory");
  __syncthreads();
  if (threadIdx.x == 0) {
    unsigned* bar = b.bar;
    __builtin_amdgcn_s_waitcnt(0);
    unsigned nloc = b.st[0], nx = b.st[1];
    if (nloc == 0u) { xcd_barrier_complete(bar, b.x, nloc, nx); b.st[0] = nloc; b.st[1] = nx; }
    const unsigned old = xb_add(&bar[XB_XSUB(b.x)], 1u);
    const unsigned gen = old / nloc;
    if (old + 1u == (gen + 1u) * nloc) {
      __builtin_amdgcn_fence(__ATOMIC_RELEASE, "agent");
      asm volatile("s_waitcnt vmcnt(0)" ::: "memory");
      const unsigned og = xb_add(&bar[XB_TOP], 1u);
      const unsigned tg = og / nx;
      if (og + 1u == (tg + 1u) * nx) xb_add(&bar[XB_TOPGEN], 1u);
      else XB_SPIN(xb_ld(&bar[XB_TOPGEN]) == tg, bar);
      __builtin_amdgcn_fence(__ATOMIC_ACQUIRE, "agent");
      xb_add(&bar[XB_XGEN(b.x)], 1u);
      asm volatile("s_waitcnt vmcnt(0)" ::: "memory");
    } else {
      XB_SPIN(xb_ld(&bar[XB_XGEN(b.x)]) == gen, bar);
      __builtin_amdgcn_fence(__ATOMIC_ACQUIRE, "agent");
      asm volatile("s_waitcnt vmcnt(0)" ::: "memory");
    }
  }
  __syncthreads();
}

constexpr int LDS_MAIN = pg8::STAGE_BYTES;
constexpr int LDS_BYTES = LDS_MAIN + 16;
static_assert(att::SHM_ATTN <= LDS_MAIN, "lds");
constexpr int NPHASE = 18;
#ifndef PHMASK
#define PHMASK 0xf
#endif
#ifndef REPMASK
#define REPMASK 0
#endif
#ifndef A128_SD
#define A128_SD 1
#endif
#ifndef KARG
#define KARG 0
#endif
#define wt_in0 ((bf16_t*)(p.ws + WS_WT_IN0))
#define wt_qb ((bf16_t*)(p.ws + WS_WT_QB))
#define wt_kvb ((bf16_t*)(p.ws + WS_WT_KVB))
#define wt_out ((bf16_t*)(p.ws + WS_WT_OUT))
#define wt_memkv ((bf16_t*)(p.ws + WS_WT_MEMKV))
#define wt_gu ((bf16_t*)(p.ws + WS_WT_GU))
#define wt_dn ((bf16_t*)(p.ws + WS_WT_DN))
#define wt_in1 ((bf16_t*)(p.ws + WS_WT_IN1))
#define memn ((bf16_t*)(p.ws + WS_MEMN))
#define memkv ((bf16_t*)(p.ws + WS_MEMKV))
#define hbuf ((bf16_t*)(p.ws + WS_HM))
#define mix ((bf16_t*)(p.ws + WS_HM))
#define proj ((bf16_t*)(p.ws + WS_R))
#define act ((bf16_t*)(p.ws + WS_R))
#define qbuf ((bf16_t*)(p.ws + WS_Q))
#define kvbuf ((bf16_t*)(p.ws + WS_KV))

struct GemmJob { const bf16_t* A; int lda; const bf16_t* Bt; int M, N, K; int kind; bf16_t* O; int ldc; const float* res; int coff; const float* rs_in; float* rs_out; };

__device__ __forceinline__ int gemm_jobs(const Params& p, int ph, int gi, GemmJob& j) {
  const float* x = p.in[0];
  j.M = NTOK; j.res = nullptr; j.coff = 0; j.O = nullptr; j.ldc = 0; j.rs_in = nullptr; j.rs_out = nullptr;
  float* rowss = (float*)(p.ws + WS_ROWSS); bf16_t* xbuf = (bf16_t*)(p.ws + WS_XB);
  switch (ph) {
  case 1:
    if (gi == 0) { j.A = hbuf; j.lda = 1024; j.Bt = wt_in0; j.N = 1280; j.K = 1024; j.kind = 0; j.O = proj; j.ldc = 1280; }
    else { j.A = memn; j.lda = 1024; j.Bt = wt_memkv + (size_t)(gi - 1) * 1024 * 1024; j.M = NMEMROWS; j.N = 1024; j.K = 1024; j.kind = 0; j.O = memkv + (size_t)(gi - 1) * NMEMROWS * 1024; j.ldc = 1024; j.coff = (gi - 1) * 128; }
    return 3;
  case 3:
    if (gi == 0) { j.A = proj; j.lda = 1280; j.Bt = wt_qb; j.N = 1536; j.K = 384; j.kind = 0; j.O = qbuf; j.ldc = 1536; }
    else { j.A = proj + 384; j.lda = 1280; j.Bt = wt_kvb; j.N = 2048; j.K = 256; j.kind = 0; j.O = kvbuf; j.ldc = 2048; }
    return 2;
  case 6: case 14: { const int L = ph == 6 ? 0 : 1;
    j.A = mix; j.lda = 1536; j.Bt = wt_out + (size_t)L * 1024 * 1536; j.N = 1024; j.K = 1536; j.kind = 1; j.res = L == 0 ? x : p.out; j.rs_out = rowss + (size_t)(L == 0 ? 0 : 2) * NTOK; j.O = xbuf; return 1; }
  case 8: case 16: { const int L = ph == 8 ? 0 : 1;
    j.A = xbuf; j.lda = 1024; j.Bt = wt_gu + (size_t)L * 5632 * 1024; j.N = 5632; j.K = 1024; j.kind = 2; j.O = act; j.rs_in = rowss + (size_t)(L == 0 ? 0 : 2) * NTOK; return 1; }
  case 9: case 17: { const int L = ph == 9 ? 0 : 1;
    j.A = act; j.lda = DFF; j.Bt = wt_dn + (size_t)L * 1024 * 2816; j.N = 1024; j.K = DFF; j.kind = 1; j.res = p.out; if (L == 0) { j.rs_out = rowss + (size_t)NTOK; j.O = xbuf; } return 1; }
  case 11:
    j.A = xbuf; j.lda = 1024; j.Bt = wt_in1; j.N = 2048; j.K = 1024; j.kind = 0; j.O = proj; j.ldc = 2048; j.rs_in = rowss + (size_t)NTOK; return 1;
  default: return 0;
  }
}

__global__ __launch_bounds__(512) void mega(Params p_) {
  extern __shared__ __attribute__((aligned(16))) unsigned char shm[];
  LAS unsigned char* glds = (LAS unsigned char*)shm;
  char* alds = (char*)shm;
  const Params* pp = (const Params*)__builtin_amdgcn_kernarg_segment_ptr();
  const int ph_lo = p_.ph_lo, ph_hi = p_.ph_hi;
  volatile LAS unsigned* bst = (volatile LAS unsigned*)(glds + LDS_MAIN);
  if (threadIdx.x == 0) { bst[0] = 0u; bst[1] = 0u; }
  __syncthreads();
  const XcdBarrier xb = xcd_barrier_post((unsigned*)(p_.ws + WS_BAR), bst);
  if (ph_lo < 0) cg::this_grid().sync();

  for (int ph = ph_lo; ph < ph_hi; ++ph) {
    if (ph == 2 || ph == 7 || ph == 10 || ph == 15) continue;
#if KARG
    asm volatile("" : "+s"(pp));
    const Params& p = *pp;
#else
    const Params& p = p_;
#endif
    const float* x = p.in[0];
    for (int rep = 0; rep < 1 + ((REPMASK >> ph) & 1); ++rep) {
    const int tid_ = opaque_tid(), wid = tid_ >> 6, lane = tid_ & 63;
    const int gw = blockIdx.x * 8 + wid, nw = gridDim.x * 8;
    if (PHMASK & 1) switch (ph) {
    case 0: {
      prep_w<2>(p.in[11], 1024, 1216, wt_in0, 1280, nullptr);
      prep_w<3>(p.in[13], 384, 1536, wt_qb, 1536, p.in[12]);
      prep_w<0>(p.in[15], 256, 2048, wt_kvb, 2048, p.in[14]);
      for (int i = 0; i < 2; ++i) {
        prep_w<0>(p.in[5] + (size_t)i * 1536 * 1024, 1536, 1024, wt_out + (size_t)i * 1024 * 1536, 1024, nullptr);
        prep_w<0>(p.in[6] + (size_t)i * 1024 * 1024, 1024, 1024, wt_memkv + (size_t)i * 1024 * 1024, 1024, nullptr);
        prep_w<1>(p.in[9] + (size_t)i * 1024 * 5632, 1024, 5632, wt_gu + (size_t)i * 5632 * 1024, 5632, p.in[4] + i * 1024);
        prep_w<0>(p.in[10] + (size_t)i * 2816 * 1024, 2816, 1024, wt_dn + (size_t)i * 1024 * 2816, 1024, nullptr);
      }
      prep_w<0>(p.in[18], 1024, 2048, wt_in1, 2048, p.in[3] + 1024);
      for (int i = blockIdx.x * 512 + tid_; i < 3 * NTOK; i += gridDim.x * 512) ((float*)(p.ws + WS_ROWSS))[i] = 0.f;
      rms_rows(p.in[1], p.in[2], memn, NMEMROWS);
      rms_rows(x, p.in[3], hbuf, NTOK);
    } break;
    case 4: {
      const int l16 = lane & 15, l8 = lane & 7;
      float inv64[8], g_mq[8], g_qn[8], g_qp[8], g_kn[8], g_kp[8];
#pragma unroll
      for (int j = 0; j < 8; ++j) inv64[j] = exp2f(-(float)(2 * ((l8 & 1) * 8 + j)) * (1.f / 32.f) * LOG2_THETA);
      load8(g_mq, p.in[7] + l16 * 8); load8(g_qn, p.in[16] + l16 * 8); load8(g_qp, p.in[16] + 128 + l8 * 8); load8(g_kn, p.in[17] + l16 * 8); load8(g_kp, p.in[17] + 128 + l8 * 8);
      const bool first64 = !(l8 & 2);
      for (int t = gw; t < NTOK; t += nw) {
        const int sq = t & (SEQ - 1); const float pos64 = (float)((l8 < 4) ? (sq >> 6) : (sq & 63));
        bf16_t* pr = proj + (size_t)t * 1280 + lane * 8; bf16_t* qrow = qbuf + (size_t)t * 1536 + lane * 8; bf16_t* kvrow = kvbuf + (size_t)t * 2048 + lane * 8;
        const bool dry = ((REPMASK >> 4) & 1) && rep == 0; bf16_t* qdst = dry ? (bf16_t*)(p.ws + WS_HM) + (size_t)t * 1536 + lane * 8 : qrow; bf16_t* kvdst = dry ? (bf16_t*)p.out + (size_t)t * 2048 + lane * 8 : kvrow;
        const u32x4 P0 = *(const u32x4*)pr, P1 = *(const u32x4*)(pr + 512);
        u32x4 P2 = {0u, 0u, 0u, 0u}; if (lane < 32) P2 = *(const u32x4*)(pr + 1024);
        const u32x4 Q0 = *(const u32x4*)qrow, Q1 = *(const u32x4*)(qrow + 512), Q2 = *(const u32x4*)(qrow + 1024);
        const u32x4 KV0 = *(const u32x4*)kvrow, KV1 = *(const u32x4*)(kvrow + 512), KV2 = *(const u32x4*)(kvrow + 1024), KV3 = *(const u32x4*)(kvrow + 1536);
        float a[8], b[8];
        unpack8(P0, a); unpack8(P1, b);
        const float s0 = sumsq8(a), s1 = sumsq8(b);
        const float ssq = wave_sum(lane < 48 ? s0 : 0.f), sskv = wave_sum((lane >= 48 ? s0 : 0.f) + (lane < 16 ? s1 : 0.f));
        const float rs_q = rsqrtf(ssq * (1.f / 384.f) + EPS), rs_kv = rsqrtf(sskv * (1.f / 256.f) + EPS);
        norm8<16>(b, g_mq); if (lane >= 16 && !dry) *(u32x4*)(pr + 512) = pack8(b);
        unpack8(P2, a);
        { const float s8 = group_sum<8>(sumsq8(a)), s16 = s8 + __shfl_xor(s8, 8, 64);
          const float rsA = rsqrtf(s16 * (1.f / 128.f) + EPS), rsB = rsqrtf(s8 * (1.f / 64.f) + EPS);
#pragma unroll
          for (int j = 0; j < 8; ++j) { b[j] = a[j] * rsB * g_kp[j]; a[j] = a[j] * rsA * g_mq[j]; }
          rope8<2>(b, inv64, pos64, first64);
#pragma unroll
          for (int j = 0; j < 8; ++j) a[j] = lane < 16 ? a[j] : b[j];
          if (lane < 24 && !dry) *(u32x4*)(pr + 1024) = pack8(a); }
        unpack8(Q0, a);
#pragma unroll
        for (int j = 0; j < 8; ++j) a[j] *= rs_q;
        norm8<16>(a, g_qn); *(u32x4*)qdst = pack8(a);
        unpack8(Q1, a);
#pragma unroll
        for (int j = 0; j < 8; ++j) a[j] *= rs_q;
        norm8<16>(a, g_qn); *(u32x4*)(qdst + 512) = pack8(a);
        unpack8(Q2, a);
#pragma unroll
        for (int j = 0; j < 8; ++j) a[j] *= rs_q;
        norm8<8>(a, g_qp); rope8<2>(a, inv64, pos64, first64); *(u32x4*)(qdst + 1024) = pack8(a);
        const bool is_k = !((lane >> 4) & 1);
#define KVCHUNK(W, OFF) do { unpack8(W, a); _Pragma("unroll") for (int j = 0; j < 8; ++j) { a[j] *= rs_kv; b[j] = a[j]; } norm8<16>(b, g_kn); \
          _Pragma("unroll") for (int j = 0; j < 8; ++j) a[j] = is_k ? b[j] : a[j]; *(u32x4*)(kvdst + (OFF)) = pack8(a); } while (0)
        KVCHUNK(KV0, 0); KVCHUNK(KV1, 512); KVCHUNK(KV2, 1024); KVCHUNK(KV3, 1536);
#undef KVCHUNK
      }
      if (!(((REPMASK >> 4) & 1) && rep == 0)) for (int r = gw; r < 2 * NMEMROWS; r += nw) {
        float g_mk[8]; load8(g_mk, p.in[8] + (r / NMEMROWS) * 128 + l16 * 8);
        bf16_t* row = memkv + (size_t)r * 1024 + lane * 8;
        float a[8]; unpack8(*(const u32x4*)row, a); norm8<16>(a, g_mk); *(u32x4*)row = pack8(a);
      }
    } break;
    case 7: case 15: rms_rows(p.out, p.in[4] + (ph == 7 ? 0 : 1024), hbuf, NTOK); break;
    case 10: rms_rows(p.out, p.in[3] + 1024, hbuf, NTOK); break;
    case 12: {
      const int l16 = lane & 15;
      float inv128[8], g_q[8], g_k[8], g_mq[8];
#pragma unroll
      for (int j = 0; j < 8; ++j) inv128[j] = exp2f(-(float)(2 * ((l16 & 3) * 8 + j)) * (1.f / 64.f) * LOG2_THETA);
      load8(g_q, p.in[19] + l16 * 8); load8(g_k, p.in[20] + l16 * 8); load8(g_mq, p.in[7] + 128 + l16 * 8);
      const bool first128 = !(l16 & 4);
      for (int t = gw; t < NTOK; t += nw) {
        const int sq = t & (SEQ - 1); const float pos128 = (float)((l16 < 8) ? (sq >> 6) : (sq & 63));
        bf16_t* row = proj + (size_t)t * 2048 + lane * 8;
        bf16_t* dst = (((REPMASK >> 12) & 1) && rep == 0) ? row + 128ull * MiB : row;
        const u32x4 W0 = *(const u32x4*)row, W1 = *(const u32x4*)(row + 512), W2 = *(const u32x4*)(row + 1024), W3 = *(const u32x4*)(row + 1536);
        float a[8];
        unpack8(W0, a); norm8<16>(a, g_q); rope8<4>(a, inv128, pos128, first128); *(u32x4*)dst = pack8(a);
        unpack8(W1, a); norm8<16>(a, g_q); rope8<4>(a, inv128, pos128, first128); *(u32x4*)(dst + 512) = pack8(a);
        unpack8(W2, a); norm8<16>(a, g_k); rope8<4>(a, inv128, pos128, first128); if (lane < 32) *(u32x4*)(dst + 1024) = pack8(a);
        unpack8(W3, a); norm8<16>(a, g_mq); *(u32x4*)(dst + 1536) = pack8(a);
      }
    } break;
    default: break;
    }
    if (PHMASK & 2) {
      GemmJob j; const int ng = gemm_jobs(p, ph, 0, j);
      for (int gi = 0; gi < ng; ++gi) {
        if (gi) gemm_jobs(p, ph, gi, j);
        if (j.kind == 0) pg8::run_gemm(glds, j.A, j.lda, j.Bt, j.M, j.N, j.K, pg8::EpiBf16{j.O, j.ldc, j.rs_in}, j.coff);
        else if (j.kind == 1) pg8::run_gemm(glds, j.A, j.lda, j.Bt, j.M, j.N, j.K, pg8::EpiResF32{p.out, j.res, j.rs_out ? j.O : nullptr, j.rs_out}, j.coff);
        else pg8::run_gemm(glds, j.A, j.lda, j.Bt, j.M, j.N, j.K, pg8::EpiSwiGLU{j.O, j.rs_in}, j.coff);
      }
    }
    if ((PHMASK & 12) && (ph == 5 || ph == 13)) {
      const int L = ph == 5 ? 0 : 1;
      att::AttnJob a;
      if (L == 0) {
        a.Q = qbuf; a.Q2 = qbuf + 1024; a.ldq = 1536; a.qhs = 128; a.K = kvbuf; a.ldk = 2048; a.khs = 256; a.kbs = (long)SEQ * 2048; a.K2 = proj + 1152; a.ldk2 = 1280;
        a.V = kvbuf + 128; a.ldv = 2048; a.O = mix; a.H = 8; a.gshift = 0; a.seq = SEQ; a.nunits = 2048; a.scale = 0.072168783648703220f;
        if (PHMASK & 4) att::run_attn<192, 1>(a, alds);
      } else {
        a.Q = proj; a.Q2 = proj; a.ldq = 2048; a.qhs = 128; a.K = proj + 1024; a.ldk = 2048; a.khs = 128; a.kbs = (long)SEQ * 2048; a.K2 = proj; a.ldk2 = 0;
        a.V = proj + 1280; a.ldv = 2048; a.O = mix; a.H = 8; a.gshift = 2; a.seq = SEQ; a.nunits = 2048; a.scale = 0.088388347648318440f;
      }
      for (int pass = (L == 0 ? 1 : 0); pass < 2; ++pass) {
        if (pass == 1) {
          a.Q = L == 0 ? proj + 640 : proj + 1536; a.Q2 = a.Q; a.ldq = L == 0 ? 1280 : 2048; a.qhs = 128;
          a.K = memkv + (size_t)L * NMEMROWS * 1024; a.ldk = 1024; a.khs = 128; a.kbs = 256 * 1024; a.K2 = a.K; a.ldk2 = 0;
          a.V = a.K + 512; a.ldv = 1024; a.O = mix + 1024; a.H = 4; a.gshift = 0; a.seq = 256; a.nunits = 1024; a.scale = 0.088388347648318440f;
        }
        if (PHMASK & 8) att::run_attn<128, A128_SD>(a, alds);
      }
    }
    }
    if (ph + 1 < ph_hi) xcd_barrier(xb);
  }
}

extern "C" void kernel_launch(void* const* d_in, const int* in_sizes, int n_in, void* d_out, int out_size, void* d_ws, size_t ws_size, hipStream_t stream) {
  static int grid = 0;
  if (grid == 0) {
    if (n_in != 21 || in_sizes[0] != NTOK * DM || out_size != NTOK * DM || ws_size < WS_END) {
      fprintf(stderr, "kernel_launch: shape/workspace mismatch (n_in %d, in0 %d, out %d, ws %zu, need %zu)\n", n_in, n_in > 0 ? in_sizes[0] : -1, out_size, ws_size, (size_t)WS_END);
      grid = -1; return; }
    int dev = 0, cus = 0, per_cu = 0;
    (void)hipGetDevice(&dev); (void)hipDeviceGetAttribute(&cus, hipDeviceAttributeMultiprocessorCount, dev);
    if (hipFuncSetAttribute((const void*)mega, hipFuncAttributeMaxDynamicSharedMemorySize, LDS_BYTES) != hipSuccess) { fprintf(stderr, "kernel_launch: hipFuncSetAttribute failed\n"); grid = -1; return; }
    if (hipOccupancyMaxActiveBlocksPerMultiprocessor(&per_cu, (const void*)mega, 512, LDS_BYTES) != hipSuccess || per_cu < 1) { fprintf(stderr, "kernel_launch: occupancy query says %d\n", per_cu); per_cu = 1; }
    (void)hipGetLastError();
    grid = cus * 1;
    if (grid <= 0) grid = 256;
  }
  if (grid < 0) return;
  if (hipMemsetAsync((char*)d_ws + WS_BAR, 0, XCD_BAR_WORDS * 4, stream) != hipSuccess) { fprintf(stderr, "kernel_launch: memset of barrier words failed\n"); return; }
  Params p{};
  for (int i = 0; i < 21; ++i) p.in[i] = (const float*)d_in[i];
  p.out = (float*)d_out; p.ws = (unsigned char*)d_ws;
#if MK_ONE_LAUNCH
  p.ph_lo = 0; p.ph_hi = NPHASE;
  void* args[] = {&p};
  hipError_t e = hipLaunchCooperativeKernel((const void*)mega, dim3(grid), dim3(512), args, LDS_BYTES, stream);
  if (e != hipSuccess) fprintf(stderr, "kernel_launch: cooperative launch failed: %s (grid %d)\n", hipGetErrorString(e), grid);
#else
  for (int ph = 0; ph < NPHASE; ++ph) {
    p.ph_lo = ph; p.ph_hi = ph + 1;
    hipLaunchKernelGGL(mega, dim3(grid), dim3(512), LDS_BYTES, stream, p);
  }
#endif
}
```

```cpp
#include <hip/hip_runtime.h>
#include <hip/hip_cooperative_groups.h>
#include <cstdio>
#include <cstdint>
namespace cg = cooperative_groups;

#ifndef MK_ONE_LAUNCH
#define MK_ONE_LAUNCH 1
#endif

typedef unsigned short bf16_t;
typedef short bf16x8 __attribute__((ext_vector_type(8)));
typedef short s16x4 __attribute__((ext_vector_type(4)));
typedef float f32x4 __attribute__((ext_vector_type(4)));
typedef float f32x16 __attribute__((ext_vector_type(16)));
typedef unsigned u32x4 __attribute__((ext_vector_type(4)));
typedef unsigned u32x2 __attribute__((ext_vector_type(2)));
#define LAS __attribute__((address_space(3)))

constexpr int NTOK = 65536, SEQ = 8192, DM = 1024, DFF = 2816, NMEMROWS = 2048;
constexpr float EPS = 1e-6f;
constexpr float LOG2_THETA = 13.287712379549449f;
constexpr float INV2PI = 0.15915494309189535f;
constexpr size_t MiB = 1ull << 20;
constexpr size_t WS_WT_IN0 = 0;
constexpr size_t WS_WT_QB = WS_WT_IN0 + 1280ull * 1024 * 2;
constexpr size_t WS_WT_KVB = WS_WT_QB + 1536ull * 384 * 2;
constexpr size_t WS_WT_OUT = WS_WT_KVB + 2048ull * 256 * 2;
constexpr size_t WS_WT_MEMKV = WS_WT_OUT + 2ull * 1024 * 1536 * 2;
constexpr size_t WS_WT_GU = WS_WT_MEMKV + 2ull * 1024 * 1024 * 2;
constexpr size_t WS_WT_DN = WS_WT_GU + 2ull * 5632 * 1024 * 2;
constexpr size_t WS_WT_IN1 = WS_WT_DN + 2ull * 1024 * 2816 * 2;
constexpr size_t WS_WT_END = WS_WT_IN1 + 2048ull * 1024 * 2;
static_assert(WS_WT_END <= 56 * MiB, "weights region");
constexpr size_t WS_MEMN = 56 * MiB;
constexpr size_t WS_MEMKV = 60 * MiB;
constexpr size_t WS_BAR = 70 * MiB;
constexpr size_t WS_ROWSS = 70 * MiB + 65536;
constexpr size_t WS_HM = 72 * MiB;
constexpr size_t WS_R = 264 * MiB;
constexpr size_t WS_Q = WS_R + 160 * MiB;
constexpr size_t WS_KV = WS_Q + 192 * MiB;
constexpr size_t WS_XB = WS_R + 352 * MiB;
constexpr size_t WS_END = WS_KV + 256 * MiB;

struct Params { const float* in[21]; float* out; unsigned char* ws; int ph_lo, ph_hi; };

__device__ __forceinline__ float bf2f(bf16_t v) { return __uint_as_float(((unsigned)v) << 16); }
__device__ __forceinline__ bf16_t f2bf(float f) { unsigned u = __float_as_uint(f); u += 0x7FFFu + ((u >> 16) & 1u); return (bf16_t)(u >> 16); }
__device__ __forceinline__ unsigned cvtpk(float lo, float hi) { unsigned r; asm volatile("v_cvt_pk_bf16_f32 %0, %1, %2" : "=v"(r) : "v"(lo), "v"(hi)); return r; }
__device__ __forceinline__ float wave_sum(float v) {
#pragma unroll
  for (int o = 32; o > 0; o >>= 1) v += __shfl_xor(v, o, 64);
  return v;
}

__device__ __forceinline__ int opaque_tid() { int t = threadIdx.x; asm volatile("" : "+v"(t)); return t; }

namespace pg8 {
constexpr int BM = 256, BK = 64, HALF = 128, HTB = HALF * BK * 2, STAGE_BYTES = 8 * HTB, NXCD = 8, WGM = 4;
__device__ __forceinline__ int lds_byte(int r, int c) { const int st = (r >> 4) * 2 + (c >> 5), rr = r & 15, cc = c & 31, ob = rr * 64 + cc * 2; return st * 1024 + (ob ^ (((ob >> 9) & 1) << 5)); }
__device__ __forceinline__ void stage_rc(int b, int& R, int& C) { const int st = b / 1024, sb = b % 1024, swz = sb ^ (((sb >> 9) & 1) << 5); R = (st >> 1) * 16 + swz / 64; C = (st & 1) * 32 + (swz % 64) / 2; }
__device__ __forceinline__ int perm32(int rho) { const int n = rho >> 4, i = rho & 15; return 8 * (i >> 2) + 4 * n + (i & 3); }
struct Unit { int pm, pn; };
struct Gemm { const bf16_t* A; const bf16_t* Bt; int M, N, K, lda; };
struct StaticOrder {
  int nM, nN, nwg, G, c;
  __device__ void init(int M, int N, int G_, int c_) { nM = M / BM; nN = N / BM; nwg = nM * nN; G = G_; c = c_; }
  __device__ bool next(int i, Unit& u) const {
    const long L = (long)i * G + c; if (L >= nwg) return false;
    int wgid = (int)L; { const int q = nwg / NXCD, r = nwg % NXCD, xcd = wgid % NXCD, off = wgid / NXCD; wgid = (xcd < r ? xcd * (q + 1) : r * (q + 1) + (xcd - r) * q) + off; }
    const int nig = WGM * nN, gid = wgid / nig, fm = gid * WGM, gsz = (nM - fm) < WGM ? (nM - fm) : WGM;
    u.pm = fm + ((wgid % nig) % gsz); u.pn = (wgid % nig) / gsz; return true;
  }
};

struct EpiBf16 {
  static constexpr bool PERM = true;
  bf16_t* O; int ldc; const float* rowss; float inv_n; float* csq; float* ckv;
  __device__ __forceinline__ void pre(const Unit& u, int wr, int fr, float (&rsv)[2][4]) const {
    const int row0 = u.pm * BM + wr * 64 + fr;
#pragma unroll
    for (int ai = 0; ai < 2; ++ai)
#pragma unroll
      for (int m = 0; m < 4; ++m) rsv[ai][m] = rowss ? rowss[row0 + ai * HALF + m * 16] : 0.f;
  }
  __device__ __forceinline__ void operator()(const f32x4 (&acc)[2][2][4][2], const Unit& u, int wr, int wc, int fr, int fq, const float (&rsv)[2][4]) const {
    const int row0 = u.pm * BM + wr * 64 + fr, col0 = u.pn * BM + wc * 32 + 8 * fq;
    float* tgt0 = nullptr; float* tgt1 = nullptr;
    if (csq) { if (u.pn == 0) { tgt0 = csq; tgt1 = csq; } else if (u.pn == 1) { tgt0 = csq; tgt1 = ckv; } else if (u.pn == 2) { tgt0 = ckv; } }
#pragma unroll
    for (int ai = 0; ai < 2; ++ai)
#pragma unroll
      for (int m = 0; m < 4; ++m) { const int row = row0 + ai * HALF + m * 16; bf16_t* rowp = O + (size_t)row * ldc + col0;
        const float rs = rowss ? rsqrtf(rsv[ai][m] * inv_n + EPS) : 1.f;
#pragma unroll
        for (int bj = 0; bj < 2; ++bj) { const f32x4 v0 = acc[ai][bj][m][0] * rs, v1 = acc[ai][bj][m][1] * rs;
          u32x4 w; w.x = cvtpk(v0[0], v0[1]); w.y = cvtpk(v0[2], v0[3]); w.z = cvtpk(v1[0], v1[1]); w.w = cvtpk(v1[2], v1[3]);
          *(u32x4*)(rowp + bj * HALF) = w;
          float* tg = bj ? tgt1 : tgt0;
          if (tg) { float ss = v0[0] * v0[0] + v0[1] * v0[1] + v0[2] * v0[2] + v0[3] * v0[3] + v1[0] * v1[0] + v1[1] * v1[1] + v1[2] * v1[2] + v1[3] * v1[3];
            ss += __shfl_xor(ss, 16, 64); ss += __shfl_xor(ss, 32, 64); if (fq == 0) unsafeAtomicAdd(tg + row, ss); } } }
  }
};
struct EpiResF32 {
  static constexpr bool PERM = false;
  float* out; const float* res; bf16_t* xb; float* rowss;
  __device__ __forceinline__ void pre(const Unit&, int, int, float (&)[2][4]) const {}
  __device__ __forceinline__ void operator()(const f32x4 (&acc)[2][2][4][2], const Unit& u, int wr, int wc, int fr, int fq, const float (&)[2][4]) const {
    const int row0 = u.pm * BM + wr * 64 + fr, col0 = u.pn * BM + wc * 32 + 4 * fq;
    f32x4 r[2][2][2][2];
#define ER_LOAD(buf, ai, mp) do { _Pragma("unroll") for (int mm = 0; mm < 2; ++mm) { const size_t off = (size_t)(row0 + (ai) * HALF + ((mp) + mm) * 16) * DM + col0; \
      _Pragma("unroll") for (int bj = 0; bj < 2; ++bj) _Pragma("unroll") for (int n = 0; n < 2; ++n) r[buf][mm][bj][n] = *(const f32x4*)(res + off + bj * HALF + n * 16); } } while (0)
#define ER_STORE(buf, ai, mp) do { _Pragma("unroll") for (int mm = 0; mm < 2; ++mm) { const int row = row0 + (ai) * HALF + ((mp) + mm) * 16; const size_t off = (size_t)row * DM + col0; float ss = 0.f; \
      _Pragma("unroll") for (int bj = 0; bj < 2; ++bj) _Pragma("unroll") for (int n = 0; n < 2; ++n) { const f32x4 v = r[buf][mm][bj][n] + acc[ai][bj][(mp) + mm][n]; \
        *(f32x4*)(out + off + bj * HALF + n * 16) = v; \
        if (xb) { u32x2 w; w.x = cvtpk(v[0], v[1]); w.y = cvtpk(v[2], v[3]); *(u32x2*)(xb + off + bj * HALF + n * 16) = w; ss += v[0] * v[0] + v[1] * v[1] + v[2] * v[2] + v[3] * v[3]; } } \
      if (xb) { ss += __shfl_xor(ss, 16, 64); ss += __shfl_xor(ss, 32, 64); if (fq == 0) unsafeAtomicAdd(rowss + row, ss); } } } while (0)
    ER_LOAD(0, 0, 0); ER_LOAD(1, 0, 2);
    ER_STORE(0, 0, 0); ER_LOAD(0, 1, 0);
    ER_STORE(1, 0, 2); ER_LOAD(1, 1, 2);
    ER_STORE(0, 1, 0); ER_STORE(1, 1, 2);
#undef ER_LOAD
#undef ER_STORE
  }
};
struct EpiSwiGLU {
  static constexpr bool PERM = true;
  bf16_t* O; const float* rowss;
  __device__ __forceinline__ void pre(const Unit& u, int wr, int fr, float (&rsv)[2][4]) const {
    const int row0 = u.pm * BM + wr * 64 + fr;
#pragma unroll
    for (int ai = 0; ai < 2; ++ai)
#pragma unroll
      for (int m = 0; m < 4; ++m) rsv[ai][m] = rowss[row0 + ai * HALF + m * 16];
  }
  __device__ __forceinline__ void operator()(const f32x4 (&acc)[2][2][4][2], const Unit& u, int wr, int wc, int fr, int fq, const float (&rsv)[2][4]) const {
    const int row0 = u.pm * BM + wr * 64 + fr, col0 = u.pn * HALF + wc * 32 + 8 * fq;
#pragma unroll
    for (int ai = 0; ai < 2; ++ai)
#pragma unroll
      for (int m = 0; m < 4; ++m) { const int row = row0 + ai * HALF + m * 16; bf16_t* rowp = O + (size_t)row * DFF + col0;
        const float rs = rsqrtf(rsv[ai][m] * (1.f / DM) + EPS);
        float y[8];
#pragma unroll
        for (int n = 0; n < 2; ++n)
#pragma unroll
          for (int j = 0; j < 4; ++j) { const float g = acc[ai][0][m][n][j] * rs, up = acc[ai][1][m][n][j] * rs;
            const float e = __builtin_amdgcn_exp2f(-g * 1.4426950408889634f);
            y[n * 4 + j] = g * __builtin_amdgcn_rcpf(1.0f + e) * up; }
        u32x4 w; w.x = cvtpk(y[0], y[1]); w.y = cvtpk(y[2], y[3]); w.z = cvtpk(y[4], y[5]); w.w = cvtpk(y[6], y[7]);
        __builtin_nontemporal_store(w, (u32x4*)rowp); }
  }
};

template <class Epi>
__device__ __forceinline__ void gemm_phase(LAS unsigned char* lds, const Gemm g, const StaticOrder& S, const Epi& E) {
  const int tid = opaque_tid(), wid = __builtin_amdgcn_readfirstlane(tid >> 6), lane = tid & 63, wr = wid >> 2, wc = wid & 3, fr = lane & 15, fq = lane >> 4;
  const int K = g.K, nt = K / BK, lda = g.lda;
  unsigned voffA[2], voffB[2];
#pragma unroll
  for (int i = 0; i < 2; ++i) { int R, C; stage_rc(tid * 16 + i * 8192, R, C); const int Rb = Epi::PERM ? ((R & ~31) + perm32(R & 31)) : R;
    voffA[i] = (unsigned)(R * lda + C) * 2u; voffB[i] = (unsigned)(Rb * K + C) * 2u; }
  const size_t kstep = (size_t)(BK * 2);
  const size_t hstepA = (size_t)HALF * lda * 2, hstepB = (size_t)HALF * K * 2;
  const size_t tstepA = 2 * hstepA, tstepB = 2 * hstepB;
  const unsigned ldsw = (unsigned)wid * 1024u;
  const int aoff = lds_byte(wr * 64 + fr, fq * 8), boff = lds_byte(wc * 32 + fr, fq * 8);
#define PG8_SA(b, h) (((b) * 2 + (h)) * HTB)
#define PG8_SB(b, h) ((4 + (b) * 2 + (h)) * HTB)
#define PG8_STAGE(bufoff, gbase, voff) do { _Pragma("unroll") for (int _i = 0; _i < 2; ++_i) \
    __builtin_amdgcn_global_load_lds((const unsigned*)((const char*)(gbase) + (voff)[_i]), (LAS unsigned*)(lds + (bufoff) + ldsw + _i * 8192), 16, 0, 0); } while (0)
#define PG8_LDA(dst, b, h) do { _Pragma("unroll") for (int m = 0; m < 4; ++m) _Pragma("unroll") for (int k = 0; k < 2; ++k) dst[m][k] = *(const LAS bf16x8*)(lds + PG8_SA(b, h) + aoff + m * 2048 + k * 1024); } while (0)
#define PG8_LDB(dst, b, h) do { _Pragma("unroll") for (int n = 0; n < 2; ++n) _Pragma("unroll") for (int k = 0; k < 2; ++k) dst[n][k] = *(const LAS bf16x8*)(lds + PG8_SB(b, h) + boff + n * 2048 + k * 1024); } while (0)
#define PG8_MMA(ai, bj, At, Bt) do { __builtin_amdgcn_s_setprio(1); _Pragma("unroll") for (int m = 0; m < 4; ++m) _Pragma("unroll") for (int n = 0; n < 2; ++n) _Pragma("unroll") for (int k = 0; k < 2; ++k) \
    acc[ai][bj][m][n] = __builtin_amdgcn_mfma_f32_16x16x32_bf16(Bt[n][k], At[m][k], acc[ai][bj][m][n], 0, 0, 0); __builtin_amdgcn_s_setprio(0); } while (0)
#define PG8_WAIT_V(n) asm volatile("s_waitcnt vmcnt(" #n ")" ::: "memory")
#define PG8_WAIT_L(n) asm volatile("s_waitcnt lgkmcnt(" #n ")" ::: "memory")
#define PG8_BAR __builtin_amdgcn_s_barrier()
#define PG8_SCHED __builtin_amdgcn_sched_barrier(0)
  Unit cur, nxt; int ui = 0;
  if (!S.next(0, cur)) return;
  f32x4 acc[2][2][4][2];
#pragma unroll
  for (int a = 0; a < 2; ++a)
#pragma unroll
    for (int b = 0; b < 2; ++b)
#pragma unroll
      for (int m = 0; m < 4; ++m)
#pragma unroll
        for (int n = 0; n < 2; ++n) acc[a][b][m][n] = (f32x4){0.f, 0.f, 0.f, 0.f};
  bf16x8 At[4][2], B0[2][2], B1[2][2];
  float rsv[2][4] = {};
  const char* cA = (const char*)g.A + (size_t)cur.pm * tstepA; const char* cB = (const char*)g.Bt + (size_t)cur.pn * tstepB;
  PG8_STAGE(PG8_SB(0, 0), cB, voffB); PG8_STAGE(PG8_SA(0, 0), cA, voffA); PG8_STAGE(PG8_SB(0, 1), cB + hstepB, voffB); PG8_STAGE(PG8_SA(0, 1), cA + hstepA, voffA);
  if (wr == 1) PG8_BAR;
  PG8_WAIT_V(4); PG8_BAR;
  PG8_STAGE(PG8_SB(1, 0), cB + kstep, voffB); PG8_STAGE(PG8_SA(1, 0), cA + kstep, voffA); PG8_STAGE(PG8_SB(1, 1), cB + hstepB + kstep, voffB);
  PG8_WAIT_V(6); PG8_BAR;
  for (;;) {
    const bool has_next = S.next(ui + 1, nxt);
    const char* nA = has_next ? (const char*)g.A + (size_t)nxt.pm * tstepA : cA; const char* nB = has_next ? (const char*)g.Bt + (size_t)nxt.pn * tstepB : cB;
    for (int t = 0; t < nt; t += 2) {
      const bool last = (t == nt - 2);
      if (last) E.pre(cur, wr, fr, rsv);
      const char* a1 = cA + (size_t)(t + 1) * kstep;
      const char* a2 = last ? nA : cA + (size_t)(t + 2) * kstep; const char* b2 = last ? nB : cB + (size_t)(t + 2) * kstep;
      const char* a3 = a2 + kstep; const char* b3 = b2 + kstep;
      PG8_LDB(B0, 0, 0); PG8_SCHED; PG8_LDA(At, 0, 0); PG8_STAGE(PG8_SA(1, 1), a1 + hstepA, voffA);
      PG8_WAIT_L(8); PG8_BAR; PG8_WAIT_L(0); PG8_MMA(0, 0, At, B0); PG8_BAR; PG8_SCHED;
      PG8_LDB(B1, 0, 1); PG8_STAGE(PG8_SB(0, 0), b2, voffB);
      PG8_BAR; PG8_WAIT_L(0); PG8_MMA(0, 1, At, B1); PG8_BAR;
      PG8_LDA(At, 0, 1); PG8_STAGE(PG8_SA(0, 0), a2, voffA);
      PG8_BAR; PG8_WAIT_L(0); PG8_MMA(1, 0, At, B0); PG8_BAR; PG8_SCHED;
      PG8_STAGE(PG8_SB(0, 1), b2 + hstepB, voffB);
      PG8_WAIT_V(6); PG8_BAR; PG8_MMA(1, 1, At, B1); PG8_BAR;
      PG8_LDB(B0, 1, 0); PG8_SCHED; PG8_LDA(At, 1, 0); PG8_STAGE(PG8_SA(0, 1), a2 + hstepA, voffA);
      PG8_WAIT_L(8); PG8_BAR; PG8_WAIT_L(0); PG8_MMA(0, 0, At, B0); PG8_BAR; PG8_SCHED;
      PG8_LDB(B1, 1, 1); PG8_STAGE(PG8_SB(1, 0), b3, voffB);
      PG8_BAR; PG8_WAIT_L(0); PG8_MMA(0, 1, At, B1); PG8_BAR;
      PG8_LDA(At, 1, 1); PG8_STAGE(PG8_SA(1, 0), a3, voffA);
      PG8_BAR; PG8_WAIT_L(0); PG8_MMA(1, 0, At, B0); PG8_BAR; PG8_SCHED;
      PG8_STAGE(PG8_SB(1, 1), b3 + hstepB, voffB);
      PG8_WAIT_V(6); PG8_BAR; PG8_MMA(1, 1, At, B1); PG8_BAR;
    }
    E(acc, cur, wr, wc, fr, fq, rsv);
    if (!has_next) break;
#pragma unroll
    for (int a = 0; a < 2; ++a)
#pragma unroll
      for (int b = 0; b < 2; ++b)
#pragma unroll
        for (int m = 0; m < 4; ++m)
#pragma unroll
          for (int n = 0; n < 2; ++n) acc[a][b][m][n] = (f32x4){0.f, 0.f, 0.f, 0.f};
    cur = nxt; cA = nA; cB = nB; ++ui;
  }
  PG8_WAIT_V(0);
  if (wr == 0) PG8_BAR;
  PG8_BAR;
#undef PG8_SA
#undef PG8_SB
#undef PG8_STAGE
#undef PG8_LDA
#undef PG8_LDB
#undef PG8_MMA
#undef PG8_WAIT_V
#undef PG8_WAIT_L
#undef PG8_BAR
#undef PG8_SCHED
}
template <class Epi>
__device__ __forceinline__ void run_gemm(LAS unsigned char* lds, const bf16_t* A, int lda, const bf16_t* Bt, int M, int N, int K, const Epi& E, int coff, int stagger_ticks) {
  if (stagger_ticks > 0) {
    const unsigned long long t0 = __builtin_amdgcn_s_memrealtime(); const unsigned long long d = (unsigned long long)(((blockIdx.x >> 3) & 7) * stagger_ticks) >> 3;
    while (__builtin_amdgcn_s_memrealtime() - t0 < d) __builtin_amdgcn_s_sleep(8);
  }
  Gemm g{A, Bt, M, N, K, lda};
  StaticOrder S; S.init(M, N, (int)gridDim.x, (int)((blockIdx.x + coff) % gridDim.x));
  gemm_phase<Epi>(lds, g, S, E);
}
}

namespace att {
constexpr int NW = 8, QBLK = 32, KVBLK = 64;
constexpr float THR = 8.f;
constexpr int SHM_V = KVBLK * 128 * 2, SHM_K = KVBLK * 128 * 2, SHM_K2 = KVBLK * 64 * 2;
constexpr int NBUF = 3;
constexpr int OFF_K = NBUF * SHM_V, OFF_K2 = OFF_K + NBUF * SHM_K, OFF_WS = OFF_K2 + NBUF * SHM_K2, OFF_Q2 = OFF_WS + NW * 64 * 4, SHM_ATTN = OFF_Q2 + 32768;
#define KSWZ(row, colB) ((row) * 256 + ((colB) ^ (((row) & 7) << 4)))
#define K2SWZ(row, colB) ((row) * 128 + ((colB) ^ ((((row) >> 1) & 7) << 4)))
#define SBAR() __builtin_amdgcn_sched_barrier(0)
__device__ __forceinline__ int crow(int r, int hi) { return (r & 3) + 8 * (r >> 2) + 4 * hi; }
__device__ __forceinline__ void partialSM(f32x16& p0, f32x16& p1, float& m_reg, float& mn, float& alpha, float C, float thr_s) {
  float pmax = p0[0];
#pragma unroll
  for (int r = 1; r < 16; ++r) pmax = fmaxf(pmax, p0[r]);
#pragma unroll
  for (int r = 0; r < 16; ++r) pmax = fmaxf(pmax, p1[r]);
  { auto rr = __builtin_amdgcn_permlane32_swap(__float_as_uint(pmax), __float_as_uint(pmax), false, false);
    pmax = fmaxf(__uint_as_float(rr[0]), __uint_as_float(rr[1])); }
  if (__builtin_expect(__all(pmax - m_reg <= thr_s), 1)) { mn = m_reg; alpha = 1.f; }
  else { mn = fmaxf(m_reg, pmax); alpha = __builtin_amdgcn_exp2f((m_reg - mn) * C); m_reg = mn; }
  float mnC = -mn * C;
#pragma unroll
  for (int r = 0; r < 16; ++r) p0[r] = fmaf(p0[r], C, mnC);
#pragma unroll
  for (int r = 0; r < 16; ++r) p1[r] = fmaf(p1[r], C, mnC);
#pragma unroll
  for (int r = 0; r < 16; ++r) p0[r] = __builtin_amdgcn_exp2f(p0[r]);
}
__device__ __forceinline__ void finishSM(f32x16& p0, f32x16& p1, float alpha, float& l_reg, bf16x8& pa0, bf16x8& pa1, bf16x8& pa2, bf16x8& pa3) {
#pragma unroll
  for (int r = 0; r < 16; ++r) p1[r] = __builtin_amdgcn_exp2f(p1[r]);
  float ps = 0;
#pragma unroll
  for (int r = 0; r < 16; ++r) ps += p0[r];
#pragma unroll
  for (int r = 0; r < 16; ++r) ps += p1[r];
  { auto rr = __builtin_amdgcn_permlane32_swap(__float_as_uint(ps), __float_as_uint(ps), false, false);
    ps = __uint_as_float(rr[0]) + __uint_as_float(rr[1]); }
  l_reg = l_reg * alpha + ps;
#define PK4(P, BASE, OUT) do { unsigned a0 = cvtpk(P[BASE + 0], P[BASE + 1]), a1 = cvtpk(P[BASE + 2], P[BASE + 3]);   \
    unsigned b0 = cvtpk(P[BASE + 4], P[BASE + 5]), b1 = cvtpk(P[BASE + 6], P[BASE + 7]);                              \
    auto r0 = __builtin_amdgcn_permlane32_swap(a0, b0, false, false); auto r1 = __builtin_amdgcn_permlane32_swap(a1, b1, false, false); \
    u32x4 w = {r0[0], r1[0], r0[1], r1[1]}; OUT = *reinterpret_cast<bf16x8*>(&w); } while (0)
  PK4(p0, 0, pa0); PK4(p0, 8, pa1); PK4(p1, 0, pa2); PK4(p1, 8, pa3);
#undef PK4
}
template <int DQK>
__device__ __forceinline__ void qkt(f32x16& p0, f32x16& p1, const char* Ks, const char* K2s, const bf16x8* qr, const char* q2l, int r32, int hi) {
#pragma unroll
  for (int r = 0; r < 16; ++r) { p0[r] = 0.f; p1[r] = 0.f; }
#pragma unroll
  for (int d0 = 0; d0 < 8; ++d0) { int cb = (d0 * 16 + hi * 8) * 2;
    bf16x8 b0 = *reinterpret_cast<const bf16x8*>(Ks + KSWZ(r32, cb));
    bf16x8 b1 = *reinterpret_cast<const bf16x8*>(Ks + KSWZ(32 + r32, cb));
    p0 = __builtin_amdgcn_mfma_f32_32x32x16_bf16(b0, qr[d0], p0, 0, 0, 0);
    p1 = __builtin_amdgcn_mfma_f32_32x32x16_bf16(b1, qr[d0], p1, 0, 0, 0); }
  if constexpr (DQK == 192) {
#pragma unroll
    for (int d0 = 0; d0 < 4; ++d0) { int cb = (d0 * 16 + hi * 8) * 2;
      bf16x8 b0 = *reinterpret_cast<const bf16x8*>(K2s + K2SWZ(r32, cb));
      bf16x8 b1 = *reinterpret_cast<const bf16x8*>(K2s + K2SWZ(32 + r32, cb));
      const bf16x8 q2 = *reinterpret_cast<const bf16x8*>(q2l + d0 * 1024);
      p0 = __builtin_amdgcn_mfma_f32_32x32x16_bf16(b0, q2, p0, 0, 0, 0);
      p1 = __builtin_amdgcn_mfma_f32_32x32x16_bf16(b1, q2, p1, 0, 0, 0); }
  }
}
__device__ __forceinline__ int v_st(int k, int c) { const int kk = (k & ~0xC) | ((k & 4) << 1) | ((k & 8) >> 1); return ((kk >> 3) * 4 + (c >> 5)) * 512 + ((kk & 7) * 32 + (c & 31)) * 2; }
__device__ __forceinline__ int v_rd_base(int lane) { return ((lane & 3) << 3) | (((lane >> 2) & 3) << 6) | (((lane >> 4) & 1) << 5) | (((lane >> 5) & 1) << 8); }
constexpr int v_rd_off(int d0, int ks, int half) { return d0 * 512 + ks * 4096 + half * 2048; }
template <int OFF> __device__ __forceinline__ s16x4 tr_read(int vb) {
  s16x4 r; asm volatile("ds_read_b64_tr_b16 %0, %1 offset:%2" : "=&v"(r) : "v"(vb), "i"(OFF) : "memory"); return r;
}
template <int D0> __device__ __forceinline__ void pv_one(f32x16& od, int vb, bf16x8 pa0, bf16x8 pa1, bf16x8 pa2, bf16x8 pa3) {
  const s16x4 l0 = tr_read<v_rd_off(D0, 0, 0)>(vb), h0 = tr_read<v_rd_off(D0, 0, 1)>(vb), l1 = tr_read<v_rd_off(D0, 1, 0)>(vb), h1 = tr_read<v_rd_off(D0, 1, 1)>(vb);
  const s16x4 l2 = tr_read<v_rd_off(D0, 2, 0)>(vb), h2 = tr_read<v_rd_off(D0, 2, 1)>(vb), l3 = tr_read<v_rd_off(D0, 3, 0)>(vb), h3 = tr_read<v_rd_off(D0, 3, 1)>(vb);
  asm volatile("s_waitcnt lgkmcnt(0)" ::: "memory"); SBAR();
#define PK(L, H) (bf16x8){L[0], L[1], L[2], L[3], H[0], H[1], H[2], H[3]}
  od = __builtin_amdgcn_mfma_f32_32x32x16_bf16(pa0, PK(l0, h0), od, 0, 0, 0);
  od = __builtin_amdgcn_mfma_f32_32x32x16_bf16(pa1, PK(l1, h1), od, 0, 0, 0);
  od = __builtin_amdgcn_mfma_f32_32x32x16_bf16(pa2, PK(l2, h2), od, 0, 0, 0);
  od = __builtin_amdgcn_mfma_f32_32x32x16_bf16(pa3, PK(l3, h3), od, 0, 0, 0);
#undef PK
}
__device__ __forceinline__ void pv_d0(f32x16* o, int vb, bf16x8 pa0, bf16x8 pa1, bf16x8 pa2, bf16x8 pa3) {
  pv_one<0>(o[0], vb, pa0, pa1, pa2, pa3); pv_one<1>(o[1], vb, pa0, pa1, pa2, pa3); pv_one<2>(o[2], vb, pa0, pa1, pa2, pa3); pv_one<3>(o[3], vb, pa0, pa1, pa2, pa3);
}

template <int DQK, int SDEPTH>
__device__ __forceinline__ void attn_body(const bf16_t* __restrict__ Qb, const bf16_t* __restrict__ Q2b, int ldq, const bf16_t* __restrict__ Kh, int ldk, const bf16_t* __restrict__ K2h, int ldk2,
                                          const bf16_t* __restrict__ Vh, int ldv, bf16_t* __restrict__ Ob, int ldo, int seq, float scale, char* lds, LAS unsigned char* ldsl,
                                          const float* __restrict__ qgain, int sq0, const float* __restrict__ rsq, int qrope) {
  constexpr int ND = 8;
  const int tid = opaque_tid(), wid = tid >> 6, lane = tid & 63, r32 = lane & 31, hi = lane >> 5;
  const float C = scale * 1.4426950408889634f, thr_s = THR / scale;
  char* V_lds = lds; char* K_lds = lds + OFF_K; char* K2_lds = lds + OFF_K2;
  float* ws = (float*)(lds + OFF_WS) + wid * 64; float* li_l = ws; float* al_l = ws + 32;
  float m_reg = -1e30f, l_reg = 0; f32x16 o[4]; bf16x8 qr[ND];
#pragma unroll
  for (int d = 0; d < 4; ++d)
#pragma unroll
    for (int r = 0; r < 16; ++r) o[d][r] = 0.f;
  const bf16_t* Qw = Qb + (long)(wid * QBLK + r32) * ldq + hi * 8;
#pragma unroll
  for (int d0 = 0; d0 < ND; ++d0) qr[d0] = *reinterpret_cast<const bf16x8*>(Qw + d0 * 16);
  float mla_rsq = 1.f;
  if (DQK == 192 && qgain != nullptr) {
    if (rsq) mla_rsq = rsq[wid * QBLK + r32];
    float ss = 0.f;
#pragma unroll
    for (int d0 = 0; d0 < 8; ++d0) { const u32x4 w = *reinterpret_cast<const u32x4*>(&qr[d0]);
#pragma unroll
      for (int i = 0; i < 4; ++i) { const float lo = __uint_as_float(w[i] << 16) * mla_rsq, hi_ = __uint_as_float(w[i] & 0xffff0000u) * mla_rsq; ss += lo * lo + hi_ * hi_; } }
    ss += __shfl_xor(ss, 32, 64);
    const float rs = rsqrtf(ss * (1.f / 128.f) + EPS);
#pragma unroll
    for (int d0 = 0; d0 < 8; ++d0) { const u32x4 w = *reinterpret_cast<const u32x4*>(&qr[d0]);
      const f32x4 g0 = *(const f32x4*)(qgain + d0 * 16 + hi * 8), g1 = *(const f32x4*)(qgain + d0 * 16 + hi * 8 + 4);
      float x[8];
#pragma unroll
      for (int i = 0; i < 4; ++i) { x[2 * i] = __uint_as_float(w[i] << 16) * mla_rsq; x[2 * i + 1] = __uint_as_float(w[i] & 0xffff0000u) * mla_rsq; }
#pragma unroll
      for (int j = 0; j < 8; ++j) x[j] *= rs * (j < 4 ? g0[j & 3] : g1[j & 3]);
      u32x4 ow; ow.x = cvtpk(x[0], x[1]); ow.y = cvtpk(x[2], x[3]); ow.z = cvtpk(x[4], x[5]); ow.w = cvtpk(x[6], x[7]);
      qr[d0] = *reinterpret_cast<bf16x8*>(&ow); }
  }
  if (DQK == 128 && qgain != nullptr) {
    float ss = 0.f;
#pragma unroll
    for (int d0 = 0; d0 < 8; ++d0) { const u32x4 w = *reinterpret_cast<const u32x4*>(&qr[d0]);
#pragma unroll
      for (int i = 0; i < 4; ++i) { const float lo = __uint_as_float(w[i] << 16), hi_ = __uint_as_float(w[i] & 0xffff0000u); ss += lo * lo + hi_ * hi_; } }
    ss += __shfl_xor(ss, 32, 64);
    const float rs = rsqrtf(ss * (1.f / 128.f) + EPS);
    const int sq = sq0 + wid * QBLK + r32;
#pragma unroll
    for (int part = 0; part < 2; ++part) { const float pos = (float)(part ? (sq & 63) : (sq >> 6));
#pragma unroll
      for (int dp = 0; dp < 2; ++dp) { const int da = part * 4 + dp, db = da + 2;
        const u32x4 wa = *reinterpret_cast<const u32x4*>(&qr[da]), wb = *reinterpret_cast<const u32x4*>(&qr[db]);
        float xa[8], xb_[8];
#pragma unroll
        for (int i = 0; i < 4; ++i) { xa[2 * i] = __uint_as_float(wa[i] << 16); xa[2 * i + 1] = __uint_as_float(wa[i] & 0xffff0000u); xb_[2 * i] = __uint_as_float(wb[i] << 16); xb_[2 * i + 1] = __uint_as_float(wb[i] & 0xffff0000u); }
        const f32x4 ga0 = *(const f32x4*)(qgain + da * 16 + hi * 8), ga1 = *(const f32x4*)(qgain + da * 16 + hi * 8 + 4), gb0 = *(const f32x4*)(qgain + db * 16 + hi * 8), gb1 = *(const f32x4*)(qgain + db * 16 + hi * 8 + 4);
#pragma unroll
        for (int j = 0; j < 8; ++j) { float c = 1.f, sn = 0.f;
          if (qrope) { const float inv = exp2f(-(float)(2 * (dp * 16 + hi * 8 + j)) * (1.f / 64.f) * LOG2_THETA);
            float rev = pos * inv * INV2PI; rev -= floorf(rev); c = __builtin_amdgcn_cosf(rev); sn = __builtin_amdgcn_sinf(rev); }
          const float x1 = xa[j] * rs * (j < 4 ? ga0[j & 3] : ga1[j & 3]), x2 = xb_[j] * rs * (j < 4 ? gb0[j & 3] : gb1[j & 3]);
          xa[j] = x1 * c - x2 * sn; xb_[j] = x2 * c + x1 * sn; }
        u32x4 oa, ob; oa.x = cvtpk(xa[0], xa[1]); oa.y = cvtpk(xa[2], xa[3]); oa.z = cvtpk(xa[4], xa[5]); oa.w = cvtpk(xa[6], xa[7]);
        ob.x = cvtpk(xb_[0], xb_[1]); ob.y = cvtpk(xb_[2], xb_[3]); ob.z = cvtpk(xb_[4], xb_[5]); ob.w = cvtpk(xb_[6], xb_[7]);
        qr[da] = *reinterpret_cast<bf16x8*>(&oa); qr[db] = *reinterpret_cast<bf16x8*>(&ob); } }
  }
  char* q2l = lds + OFF_Q2 + (wid * 4 * 64 + lane) * 16;
  __syncthreads();
  if constexpr (DQK == 192) {
    u32x4 qp[4];
#pragma unroll
    for (int d0 = 0; d0 < 4; ++d0) qp[d0] = *reinterpret_cast<const u32x4*>(Q2b + (long)(wid * QBLK + r32) * ldq + hi * 8 + d0 * 16);
    if (qgain != nullptr) {
      float ss = 0.f;
#pragma unroll
      for (int d = 0; d < 4; ++d)
#pragma unroll
        for (int i = 0; i < 4; ++i) { const float lo = __uint_as_float(qp[d][i] << 16) * mla_rsq, hi_ = __uint_as_float(qp[d][i] & 0xffff0000u) * mla_rsq; ss += lo * lo + hi_ * hi_; }
      ss += __shfl_xor(ss, 32, 64);
      const float rs = rsqrtf(ss * (1.f / 64.f) + EPS) * mla_rsq;
      const int sq = sq0 + wid * QBLK + r32;
#pragma unroll
      for (int part = 0; part < 2; ++part) { const float pos = (float)(part ? (sq & 63) : (sq >> 6)); const int da = 2 * part, db = da + 1;
        const f32x4 ga0 = *(const f32x4*)(qgain + 128 + da * 16 + hi * 8), ga1 = *(const f32x4*)(qgain + 128 + da * 16 + hi * 8 + 4);
        const f32x4 gb0 = *(const f32x4*)(qgain + 128 + db * 16 + hi * 8), gb1 = *(const f32x4*)(qgain + 128 + db * 16 + hi * 8 + 4);
        float xa[8], xb_[8];
#pragma unroll
        for (int i = 0; i < 4; ++i) { xa[2 * i] = __uint_as_float(qp[da][i] << 16); xa[2 * i + 1] = __uint_as_float(qp[da][i] & 0xffff0000u); xb_[2 * i] = __uint_as_float(qp[db][i] << 16); xb_[2 * i + 1] = __uint_as_float(qp[db][i] & 0xffff0000u); }
#pragma unroll
        for (int j = 0; j < 8; ++j) { const float inv = exp2f(-(float)(2 * (hi * 8 + j)) * (1.f / 32.f) * LOG2_THETA);
          float rev = pos * inv * INV2PI; rev -= floorf(rev);
          const float c = __builtin_amdgcn_cosf(rev), sn = __builtin_amdgcn_sinf(rev);
          const float x1 = xa[j] * rs * (j < 4 ? ga0[j & 3] : ga1[j & 3]), x2 = xb_[j] * rs * (j < 4 ? gb0[j & 3] : gb1[j & 3]);
          xa[j] = x1 * c - x2 * sn; xb_[j] = x2 * c + x1 * sn; }
        qp[da].x = cvtpk(xa[0], xa[1]); qp[da].y = cvtpk(xa[2], xa[3]); qp[da].z = cvtpk(xa[4], xa[5]); qp[da].w = cvtpk(xa[6], xa[7]);
        qp[db].x = cvtpk(xb_[0], xb_[1]); qp[db].y = cvtpk(xb_[2], xb_[3]); qp[db].z = cvtpk(xb_[4], xb_[5]); qp[db].w = cvtpk(xb_[6], xb_[7]); }
    }
#pragma unroll
    for (int d0 = 0; d0 < 4; ++d0) *reinterpret_cast<u32x4*>(q2l + d0 * 1024) = qp[d0];
  }
  const int wu = __builtin_amdgcn_readfirstlane(wid);
  unsigned voffK[2], voffV[2], voffK2;
#pragma unroll
  for (int i = 0; i < 2; ++i) {
    const int blk = i * 8 + wid;
    { const int row = blk * 4 + (lane >> 4), colB = ((lane & 15) << 4) ^ ((row & 7) << 4); voffK[i] = (unsigned)(row * ldk * 2 + colB); }
    { const int st = blk * 2 + (lane >> 5), kk = (st >> 2) * 8 + ((lane & 31) >> 2), c = (st & 3) * 32 + (lane & 3) * 8;
      const int k = (kk & ~0xC) | ((kk & 4) << 1) | ((kk & 8) >> 1); voffV[i] = (unsigned)((k * ldv + c) * 2); }
  }
  { const int row = wid * 8 + (lane >> 3), colB = ((lane & 7) << 4) ^ (((row >> 1) & 7) << 4); voffK2 = (unsigned)(row * ldk2 * 2 + colB); }
  const size_t tsV = (size_t)ldv * 2, tsK = (size_t)ldk * 2, tsK2 = (size_t)ldk2 * 2;
  const int vb0 = (int)(uintptr_t)V_lds + v_rd_base(lane);
  constexpr int NDMA = (DQK == 192) ? 5 : 4;
#define DMA_K(t) do { const int b_ = (t) % 3; const char* kb_ = (const char*)Kh + (size_t)(t) * KVBLK * tsK; \
    _Pragma("unroll") for (int i = 0; i < 2; ++i) __builtin_amdgcn_global_load_lds((const unsigned*)(kb_ + voffK[i]), (LAS unsigned*)(ldsl + OFF_K + b_ * SHM_K + (i * 8 + wu) * 1024), 16, 0, 0); \
    if constexpr (DQK == 192) __builtin_amdgcn_global_load_lds((const unsigned*)((const char*)K2h + (size_t)(t) * KVBLK * tsK2 + voffK2), (LAS unsigned*)(ldsl + OFF_K2 + b_ * SHM_K2 + wu * 1024), 16, 0, 0); } while (0)
#define DMA_V(t) do { const int b_ = (t) % 3; const char* vb_ = (const char*)Vh + (size_t)(t) * KVBLK * tsV; \
    _Pragma("unroll") for (int i = 0; i < 2; ++i) __builtin_amdgcn_global_load_lds((const unsigned*)(vb_ + voffV[i]), (LAS unsigned*)(ldsl + b_ * SHM_V + (i * 8 + wu) * 1024), 16, 0, 0); } while (0)
#define RAWBAR() do { asm volatile("" ::: "memory"); __builtin_amdgcn_s_barrier(); asm volatile("" ::: "memory"); } while (0)
#define RESC(a) do { if (__any((a) < 1.f)) { if (hi == 0) al_l[r32] = (a); asm volatile("s_waitcnt lgkmcnt(0)" ::: "memory"); \
    _Pragma("unroll") for (int d = 0; d < 4; ++d) _Pragma("unroll") for (int r = 0; r < 16; ++r) o[d][r] *= al_l[crow(r, hi)]; } } while (0)
  f32x16 pA0, pA1, pB0, pB1; float mnA, mnB, alA, alB; bf16x8 pa0, pa1, pa2, pa3; const int NT = seq / KVBLK;
  int ob_prev = 0, ob_cur = 1;
#define HALF_STEP(PN0, PN1, MNN, ALN, PO0, PO1, ALO, J, FULL) do { \
    if (FULL) { DMA_K((J) + 2); DMA_V((J) + 1); } else { if ((J) + 2 < NT) DMA_K((J) + 2); if ((J) + 1 < NT) DMA_V((J) + 1); } \
    qkt<DQK>(PN0, PN1, K_lds + ob_cur * SHM_K, K2_lds + ob_cur * SHM_K2, qr, q2l, r32, hi); \
    finishSM(PO0, PO1, ALO, l_reg, pa0, pa1, pa2, pa3); \
    pv_d0(o, vb0 + ob_prev * SHM_V, pa0, pa1, pa2, pa3); partialSM(PN0, PN1, m_reg, MNN, ALN, C, thr_s); \
    RESC(ALN); \
    if (FULL) { if constexpr (NDMA == 5) asm volatile("s_waitcnt vmcnt(5)" ::: "memory"); else asm volatile("s_waitcnt vmcnt(4)" ::: "memory"); } else asm volatile("s_waitcnt vmcnt(0)" ::: "memory"); \
    RAWBAR(); \
    ob_prev = ob_cur; ob_cur = (ob_cur == 2) ? 0 : ob_cur + 1; } while (0)
  DMA_K(0); DMA_V(0); DMA_K(1);
  asm volatile("s_waitcnt vmcnt(0)" ::: "memory"); RAWBAR();
  DMA_K(2); DMA_V(1);
  qkt<DQK>(pA0, pA1, K_lds, K2_lds, qr, q2l, r32, hi); partialSM(pA0, pA1, m_reg, mnA, alA, C, thr_s);
  if constexpr (NDMA == 5) asm volatile("s_waitcnt vmcnt(5)" ::: "memory"); else asm volatile("s_waitcnt vmcnt(4)" ::: "memory");
  RAWBAR();
  for (int j = 1; j + 3 < NT; j += 2) {
    HALF_STEP(pB0, pB1, mnB, alB, pA0, pA1, alA, j, true);
    HALF_STEP(pA0, pA1, mnA, alA, pB0, pB1, alB, j + 1, true);
  }
  HALF_STEP(pB0, pB1, mnB, alB, pA0, pA1, alA, NT - 3, false);
  HALF_STEP(pA0, pA1, mnA, alA, pB0, pB1, alB, NT - 2, false);
  HALF_STEP(pB0, pB1, mnB, alB, pA0, pA1, alA, NT - 1, false);
  finishSM(pB0, pB1, alB, l_reg, pa0, pa1, pa2, pa3); SBAR();
  pv_d0(o, vb0 + ob_prev * SHM_V, pa0, pa1, pa2, pa3);
#undef HALF_STEP
#undef DMA_K
#undef DMA_V
#undef RAWBAR
  if (hi == 0) li_l[r32] = l_reg; asm volatile("s_waitcnt lgkmcnt(0)" ::: "memory");
  float rli[16];
#pragma unroll
  for (int r = 0; r < 16; ++r) rli[r] = __builtin_amdgcn_rcpf(li_l[crow(r, hi)]);
  bf16_t* Ow = Ob + (long)(wid * QBLK) * ldo;
#pragma unroll
  for (int r = 0; r < 16; ++r) { int orow = crow(r, hi);
#pragma unroll
    for (int d0 = 0; d0 < 4; ++d0) Ow[(long)orow * ldo + d0 * 32 + r32] = f2bf(o[d0][r] * rli[r]); }
#undef RESC
}
struct AttnJob { const bf16_t* Q; const bf16_t* Q2; int ldq, qhs; const bf16_t* K; int ldk, khs; long kbs; const bf16_t* K2; int ldk2; const bf16_t* V; int ldv; bf16_t* O; int H, gshift, seq, nunits; float scale; const float* qgain; const float* rsq; int qrope; };
template <int DQK, int SDEPTH>
__device__ __forceinline__ void run_attn(const AttnJob& a, char* lds, LAS unsigned char* ldsl) {
  for (int u = blockIdx.x; u < a.nunits; u += gridDim.x) {
    const int per_b = a.H * 32, b = u / per_b, rest = u - b * per_b, h = rest % a.H, qb = rest / a.H, kh = h >> a.gshift;
    const long tok0 = (long)b * SEQ + qb * 256;
    attn_body<DQK, SDEPTH>(a.Q + tok0 * a.ldq + h * a.qhs, a.Q2 + tok0 * a.ldq + h * 64, a.ldq, a.K + (long)b * a.kbs + kh * a.khs, a.ldk, a.K2 + (long)b * SEQ * a.ldk2, a.ldk2,
                           a.V + (long)b * a.kbs + kh * a.khs, a.ldv, a.O + tok0 * 1536 + h * 128, 1536, a.seq, a.scale, lds, ldsl, a.qgain, qb * 256, a.rsq ? a.rsq + tok0 : nullptr, a.qrope);
  }
}
}

__device__ __forceinline__ void rms_rows(const float* __restrict__ src, const float* __restrict__ gain, bf16_t* __restrict__ dst, int nrows) {
  const int tid_ = opaque_tid(), wid = tid_ >> 6, lane = tid_ & 63;
  for (int row = blockIdx.x * 8 + wid; row < nrows; row += gridDim.x * 8) {
    const f32x4* s = (const f32x4*)(src + (size_t)row * DM);
    f32x4 v[4]; float ss = 0.f;
#pragma unroll
    for (int j = 0; j < 4; ++j) { v[j] = __builtin_nontemporal_load(&s[lane + 64 * j]); ss += v[j][0] * v[j][0] + v[j][1] * v[j][1] + v[j][2] * v[j][2] + v[j][3] * v[j][3]; }
    ss = wave_sum(ss);
    const float rs = rsqrtf(ss * (1.f / DM) + EPS);
#pragma unroll
    for (int j = 0; j < 4; ++j) { const f32x4 g = ((const f32x4*)gain)[lane + 64 * j];
      u32x2 w; w.x = cvtpk(v[j][0] * rs * g[0], v[j][1] * rs * g[1]); w.y = cvtpk(v[j][2] * rs * g[2], v[j][3] * rs * g[3]);
      *(u32x2*)(dst + (size_t)row * DM + (lane + 64 * j) * 4) = w; }
  }
}
template <int MODE>
__device__ __forceinline__ void prep_w(const float* __restrict__ src, int K, int Nsrc, bf16_t* __restrict__ dst, int Ndst, const float* __restrict__ kgain) {
  const long total = (long)Ndst * (K / 8);
  for (long i = (long)blockIdx.x * 512 + opaque_tid(); i < total; i += (long)gridDim.x * 512) {
    const long i8 = i >> 3; const int n = (int)(i8 % Ndst), k8 = (int)(i8 / Ndst) * 8 + (int)(i & 7);
    int ns = n;
    if (MODE == 1) { const int pn = n >> 8, r = n & 255, bj = r >> 7, ii = r & 127; ns = bj * DFF + pn * 128 + ii; }
    if (MODE == 2) { ns = n < 640 ? n : (n < 1152 ? n + 64 : (n < 1216 ? n - 512 : Nsrc)); }
    if (MODE == 3) { ns = n < 1024 ? (n >> 7) * 192 + (n & 127) : ((n - 1024) >> 6) * 192 + 128 + ((n - 1024) & 63); }
    float x[8];
#pragma unroll
    for (int j = 0; j < 8; ++j) x[j] = (ns < Nsrc) ? __builtin_nontemporal_load(&src[(size_t)(k8 * 8 + j) * Nsrc + ns]) : 0.f;
    if (kgain) {
#pragma unroll
      for (int j = 0; j < 8; ++j) x[j] *= kgain[k8 * 8 + j];
    }
    u32x4 w; w.x = cvtpk(x[0], x[1]); w.y = cvtpk(x[2], x[3]); w.z = cvtpk(x[4], x[5]); w.w = cvtpk(x[6], x[7]);
    *(u32x4*)(dst + (size_t)n * K + k8 * 8) = w;
  }
}
__device__ __forceinline__ void unpack8(u32x4 w, float* v) {
#pragma unroll
  for (int i = 0; i < 4; ++i) { v[2 * i] = __uint_as_float(w[i] << 16); v[2 * i + 1] = __uint_as_float(w[i] & 0xffff0000u); }
}
__device__ __forceinline__ u32x4 pack8(const float* v) { u32x4 w; w.x = cvtpk(v[0], v[1]); w.y = cvtpk(v[2], v[3]); w.z = cvtpk(v[4], v[5]); w.w = cvtpk(v[6], v[7]); return w; }
__device__ __forceinline__ float sumsq8(const float* v) { float s = 0.f;
#pragma unroll
  for (int j = 0; j < 8; ++j) s += v[j] * v[j];
  return s; }
template <int GL> __device__ __forceinline__ float group_sum(float s) {
#pragma unroll
  for (int o = 1; o < GL; o <<= 1) s += __shfl_xor(s, o, 64);
  return s;
}
__device__ __forceinline__ void load8(float* g, const float* __restrict__ p) { const f32x4 a = *(const f32x4*)p, b = *(const f32x4*)(p + 4);
  g[0] = a[0]; g[1] = a[1]; g[2] = a[2]; g[3] = a[3]; g[4] = b[0]; g[5] = b[1]; g[6] = b[2]; g[7] = b[3]; }
template <int GL> __device__ __forceinline__ void norm8(float* v, const float* g) {
  const float ss = group_sum<GL>(sumsq8(v)); const float rs = rsqrtf(ss * (1.f / (GL * 8)) + EPS);
#pragma unroll
  for (int j = 0; j < 8; ++j) v[j] *= rs * g[j];
}
template <int XM> __device__ __forceinline__ void rope8(float* v, const float* inv, float pos, bool first) {
#pragma unroll
  for (int j = 0; j < 8; ++j) {
    const float partner = __shfl_xor(v[j], XM, 64);
    float rev = pos * inv[j] * INV2PI; rev -= floorf(rev);
    const float c = __builtin_amdgcn_cosf(rev), s = __builtin_amdgcn_sinf(rev);
    v[j] = first ? v[j] * c - partner * s : v[j] * c + partner * s;
  }
}
template <int NE> __device__ __forceinline__ void ld_seg(float* v, const bf16_t* p, int lane) {
#pragma unroll
  for (int j = 0; j < NE; ++j) v[j] = bf2f(p[lane + 64 * j]);
}
template <int NE> __device__ __forceinline__ void st_seg(const float* v, bf16_t* p, int lane) {
#pragma unroll
  for (int j = 0; j < NE; ++j) p[lane + 64 * j] = f2bf(v[j]);
}
template <int NE, int ROPE> __device__ __forceinline__ void norm_seg(float* v, const float* __restrict__ gain, int lane, int prow, int pcol) {
  float ss = 0.f;
#pragma unroll
  for (int j = 0; j < NE; ++j) ss += v[j] * v[j];
  ss = wave_sum(ss);
  const float rs = rsqrtf(ss * (1.f / (64 * NE)) + EPS);
#pragma unroll
  for (int j = 0; j < NE; ++j) v[j] = v[j] * rs * gain[lane + 64 * j];
  if constexpr (ROPE && NE == 2) {
    const int f = lane & 31; const float inv = exp2f(-(float)(2 * f) * (1.f / 64.f) * LOG2_THETA);
#pragma unroll
    for (int j = 0; j < 2; ++j) {
      const float partner = __shfl_xor(v[j], 32, 64);
      const float ang = (float)(j == 0 ? prow : pcol) * inv;
      float rev = ang * INV2PI; rev -= floorf(rev);
      const float c = __builtin_amdgcn_cosf(rev), s = __builtin_amdgcn_sinf(rev);
      v[j] = (lane < 32) ? v[j] * c - partner * s : v[j] * c + partner * s;
    }
  }
  if constexpr (ROPE && NE == 1) {
    const int f = lane & 15; const float inv = exp2f(-(float)(2 * f) * (1.f / 32.f) * LOG2_THETA);
    const float partner = __shfl_xor(v[0], 16, 64);
    const float ang = (float)(lane < 32 ? prow : pcol) * inv;
    float rev = ang * INV2PI; rev -= floorf(rev);
    const float c = __builtin_amdgcn_cosf(rev), s = __builtin_amdgcn_sinf(rev);
    v[0] = (lane & 16) ? v[0] * c + partner * s : v[0] * c - partner * s;
  }
}

#define XB_TMO      128
#define XB_XCNT(j)  (256  + 64 * (j))
#define XB_XSUB(j)  (1280 + 64 * (j))
#define XB_XGEN(j)  (2304 + 64 * (j))
#define XB_TOP      3328
#define XB_TOPGEN   3392
#define XCD_BAR_WORDS 3456
#define XB_SPIN_CAP (1u << 22)
__device__ __forceinline__ unsigned xb_ld(unsigned* p)              { return __hip_atomic_load(p, __ATOMIC_RELAXED, __HIP_MEMORY_SCOPE_AGENT); }
__device__ __forceinline__ unsigned xb_add(unsigned* p, unsigned v) { return __hip_atomic_fetch_add(p, v, __ATOMIC_RELAXED, __HIP_MEMORY_SCOPE_AGENT); }
__device__ __forceinline__ unsigned xb_xcc_id() { return (unsigned)__builtin_amdgcn_s_getreg((3 << 11) | 20) & 0xFu; }
#define XB_SPIN(cond, bar) do { unsigned _sp = 0; while (cond) { __builtin_amdgcn_s_sleep(1); \
    if ((++_sp & 255u) == 0u) { if (xb_ld(&(bar)[XB_TMO])) break; if (_sp > XB_SPIN_CAP) { atomicAdd(&(bar)[XB_TMO], 1u); break; } } } } while (0)
struct XcdBarrier { unsigned* bar; unsigned x; volatile LAS unsigned* st; };
__device__ __forceinline__ XcdBarrier xcd_barrier_post(unsigned* bar, volatile LAS unsigned* st) {
  XcdBarrier b; b.bar = bar; b.x = xb_xcc_id(); b.st = st;
  if (threadIdx.x == 0) (void)xb_add(&bar[XB_XCNT(b.x)], 1u);
  return b;
}
__device__ __forceinline__ void xcd_barrier_complete(unsigned* bar, unsigned x, unsigned& nloc, unsigned& nx) {
  const unsigned G = gridDim.x * gridDim.y * gridDim.z;
  unsigned sum, cnt, mine, sp = 0u;
  for (;;) {
    sum = 0u; cnt = 0u; mine = 0u;
#pragma unroll
    for (unsigned j = 0; j < 16; ++j) { const unsigned c = xb_ld(&bar[XB_XCNT(j)]); sum += c; cnt += (c > 0u) ? 1u : 0u; mine = (j == x) ? c : mine; }
    if (sum == G) break;
    __builtin_amdgcn_s_sleep(1);
    if ((++sp & 255u) == 0u) { if (xb_ld(&bar[XB_TMO])) break; if (sp > XB_SPIN_CAP) { atomicAdd(&bar[XB_TMO], 1u); break; } }
  }
  nloc = mine > 0u ? mine : 1u; nx = cnt > 0u ? cnt : 1u;
}
__device__ __forceinline__ void xcd_barrier(const XcdBarrier& b) {
  asm volatile("s_waitcnt vmcnt(0)" ::: "memory");
  __syncthreads();
  if (threadIdx.x == 0) {
    unsigned* bar = b.bar;
    __builtin_amdgcn_s_waitcnt(0);
    unsigned nloc = b.st[0], nx = b.st[1];
    if (nloc == 0u) { xcd_barrier_complete(bar, b.x, nloc, nx); b.st[0] = nloc; b.st[1] = nx; }
    const unsigned old = xb_add(&bar[XB_XSUB(b.x)], 1u);
    const unsigned gen = old / nloc;
    if (old + 1u == (gen + 1u) * nloc) {
      __builtin_amdgcn_fence(__ATOMIC_RELEASE, "agent");
      asm volatile("s_waitcnt vmcnt(0)" ::: "memory");
      const unsigned og = xb_add(&bar[XB_TOP], 1u);
      const unsigned tg = og / nx;
      if (og + 1u == (tg + 1u) * nx) xb_add(&bar[XB_TOPGEN], 1u);
      else XB_SPIN(xb_ld(&bar[XB_TOPGEN]) == tg, bar);
      __builtin_amdgcn_fence(__ATOMIC_ACQUIRE, "agent");
      xb_add(&bar[XB_XGEN(b.x)], 1u);
      asm volatile("s_waitcnt vmcnt(0)" ::: "memory");
    } else {
      XB_SPIN(xb_ld(&bar[XB_XGEN(b.x)]) == gen, bar);
      __builtin_amdgcn_fence(__ATOMIC_ACQUIRE, "agent");
      asm volatile("s_waitcnt vmcnt(0)" ::: "memory");
    }
  }
  __syncthreads();
}

constexpr int LDS_MAIN = att::SHM_ATTN > pg8::STAGE_BYTES ? att::SHM_ATTN : pg8::STAGE_BYTES;
constexpr int LDS_BYTES = LDS_MAIN + 16;
static_assert(att::SHM_ATTN <= LDS_MAIN, "lds");
constexpr int NPHASE = 18;
#ifndef PHMASK
#define PHMASK 0xf
#endif
#ifndef STAG_GU
#define STAG_GU 0
#endif
#ifndef REPMASK
#define REPMASK 0
#endif
#ifndef A128_SD
#define A128_SD 1
#endif
#ifndef KARG
#define KARG 0
#endif
#define wt_in0 ((bf16_t*)(p.ws + WS_WT_IN0))
#define wt_qb ((bf16_t*)(p.ws + WS_WT_QB))
#define wt_kvb ((bf16_t*)(p.ws + WS_WT_KVB))
#define wt_out ((bf16_t*)(p.ws + WS_WT_OUT))
#define wt_memkv ((bf16_t*)(p.ws + WS_WT_MEMKV))
#define wt_gu ((bf16_t*)(p.ws + WS_WT_GU))
#define wt_dn ((bf16_t*)(p.ws + WS_WT_DN))
#define wt_in1 ((bf16_t*)(p.ws + WS_WT_IN1))
#define memn ((bf16_t*)(p.ws + WS_MEMN))
#define memkv ((bf16_t*)(p.ws + WS_MEMKV))
#define hbuf ((bf16_t*)(p.ws + WS_HM))
#define mix ((bf16_t*)(p.ws + WS_HM))
#define proj ((bf16_t*)(p.ws + WS_R))
#define act ((bf16_t*)(p.ws + WS_R))
#define qbuf ((bf16_t*)(p.ws + WS_Q))
#define kvbuf ((bf16_t*)(p.ws + WS_KV))

struct GemmJob { const bf16_t* A; int lda; const bf16_t* Bt; int M, N, K; int kind; bf16_t* O; int ldc; const float* res; int coff; const float* rs_in; float* rs_out; int stag; float inv_n; float* csq; float* ckv; };

__device__ __forceinline__ int gemm_jobs(const Params& p, int ph, int gi, GemmJob& j) {
  const float* x = p.in[0];
  j.M = NTOK; j.res = nullptr; j.coff = 0; j.O = nullptr; j.ldc = 0; j.rs_in = nullptr; j.rs_out = nullptr; j.stag = 0; j.inv_n = 1.f / DM; j.csq = nullptr; j.ckv = nullptr;
  float* rowss = (float*)(p.ws + WS_ROWSS); bf16_t* xbuf = (bf16_t*)(p.ws + WS_XB);
  switch (ph) {
  case 1:
    if (gi == 0) { j.A = hbuf; j.lda = 1024; j.Bt = wt_in0; j.N = 1280; j.K = 1024; j.kind = 0; j.O = proj; j.ldc = 1280; j.csq = rowss + 3 * (size_t)NTOK; j.ckv = rowss + 4 * (size_t)NTOK; }
    else { j.A = memn; j.lda = 1024; j.Bt = wt_memkv + (size_t)(gi - 1) * 1024 * 1024; j.M = NMEMROWS; j.N = 1024; j.K = 1024; j.kind = 0; j.O = memkv + (size_t)(gi - 1) * NMEMROWS * 1024; j.ldc = 1024; j.coff = (gi - 1) * 128; }
    return 3;
  case 3:
    if (gi == 0) { j.A = proj; j.lda = 1280; j.Bt = wt_qb; j.N = 1536; j.K = 384; j.kind = 0; j.O = qbuf; j.ldc = 1536; j.rs_in = rowss + 3 * (size_t)NTOK; j.inv_n = 1.f / 384.f; }
    else { j.A = proj + 384; j.lda = 1280; j.Bt = wt_kvb; j.N = 2048; j.K = 256; j.kind = 0; j.O = kvbuf; j.ldc = 2048; j.rs_in = rowss + 4 * (size_t)NTOK; j.inv_n = 1.f / 256.f; }
    return 2;
  case 6: case 14: { const int L = ph == 6 ? 0 : 1;
    j.A = mix; j.lda = 1536; j.Bt = wt_out + (size_t)L * 1024 * 1536; j.N = 1024; j.K = 1536; j.kind = 1; j.res = L == 0 ? x : p.out; j.rs_out = rowss + (size_t)(L == 0 ? 0 : 2) * NTOK; j.O = xbuf; return 1; }
  case 8: case 16: { const int L = ph == 8 ? 0 : 1;
    j.A = xbuf; j.lda = 1024; j.Bt = wt_gu + (size_t)L * 5632 * 1024; j.N = 5632; j.K = 1024; j.kind = 2; j.O = act; j.rs_in = rowss + (size_t)(L == 0 ? 0 : 2) * NTOK; j.stag = STAG_GU; return 1; }
  case 9: case 17: { const int L = ph == 9 ? 0 : 1;
    j.A = act; j.lda = DFF; j.Bt = wt_dn + (size_t)L * 1024 * 2816; j.N = 1024; j.K = DFF; j.kind = 1; j.res = p.out; if (L == 0) { j.rs_out = rowss + (size_t)NTOK; j.O = xbuf; } return 1; }
  case 11:
    j.A = xbuf; j.lda = 1024; j.Bt = wt_in1; j.N = 2048; j.K = 1024; j.kind = 0; j.O = proj; j.ldc = 2048; j.rs_in = rowss + (size_t)NTOK; return 1;
  default: return 0;
  }
}

__global__ __launch_bounds__(512) void mega(Params p_) {
  extern __shared__ __attribute__((aligned(16))) unsigned char shm[];
  LAS unsigned char* glds = (LAS unsigned char*)shm;
  char* alds = (char*)shm;
  const Params* pp = (const Params*)__builtin_amdgcn_kernarg_segment_ptr();
  const int ph_lo = p_.ph_lo, ph_hi = p_.ph_hi;
  volatile LAS unsigned* bst = (volatile LAS unsigned*)(glds + LDS_MAIN);
  if (threadIdx.x == 0) { bst[0] = 0u; bst[1] = 0u; }
  __syncthreads();
  const XcdBarrier xb = xcd_barrier_post((unsigned*)(p_.ws + WS_BAR), bst);
  if (ph_lo < 0) cg::this_grid().sync();

  for (int ph = ph_lo; ph < ph_hi; ++ph) {
    if (ph == 2 || ph == 7 || ph == 10 || ph == 15) continue;
#if KARG
    asm volatile("" : "+s"(pp));
    const Params& p = *pp;
#else
    const Params& p = p_;
#endif
    const float* x = p.in[0];
    for (int rep = 0; rep < 1 + ((REPMASK >> ph) & 1); ++rep) {
    const int tid_ = opaque_tid(), wid = tid_ >> 6, lane = tid_ & 63;
    const int gw = blockIdx.x * 8 + wid, nw = gridDim.x * 8;
    if (PHMASK & 1) switch (ph) {
    case 0: {
      prep_w<2>(p.in[11], 1024, 1216, wt_in0, 1280, nullptr);
      prep_w<3>(p.in[13], 384, 1536, wt_qb, 1536, p.in[12]);
      prep_w<0>(p.in[15], 256, 2048, wt_kvb, 2048, p.in[14]);
      for (int i = 0; i < 2; ++i) {
        prep_w<0>(p.in[5] + (size_t)i * 1536 * 1024, 1536, 1024, wt_out + (size_t)i * 1024 * 1536, 1024, nullptr);
        prep_w<0>(p.in[6] + (size_t)i * 1024 * 1024, 1024, 1024, wt_memkv + (size_t)i * 1024 * 1024, 1024, nullptr);
        prep_w<1>(p.in[9] + (size_t)i * 1024 * 5632, 1024, 5632, wt_gu + (size_t)i * 5632 * 1024, 5632, p.in[4] + i * 1024);
        prep_w<0>(p.in[10] + (size_t)i * 2816 * 1024, 2816, 1024, wt_dn + (size_t)i * 1024 * 2816, 1024, nullptr);
      }
      prep_w<0>(p.in[18], 1024, 2048, wt_in1, 2048, p.in[3] + 1024);
      for (int i = blockIdx.x * 512 + tid_; i < 5 * NTOK; i += gridDim.x * 512) ((float*)(p.ws + WS_ROWSS))[i] = 0.f;
      rms_rows(p.in[1], p.in[2], memn, NMEMROWS);
      rms_rows(x, p.in[3], hbuf, NTOK);
    } break;
    case 4: {
      const int l16 = lane & 15, l8 = lane & 7;
      float inv64[8], g_kn[8], g_kp[8];
#pragma unroll
      for (int j = 0; j < 8; ++j) inv64[j] = exp2f(-(float)(2 * ((l8 & 1) * 8 + j)) * (1.f / 32.f) * LOG2_THETA);
      load8(g_kn, p.in[17] + l16 * 8); load8(g_kp, p.in[17] + 128 + l8 * 8);
      const bool first64 = !(l8 & 2);
      const bool is_k = !((lane >> 4) & 1);
      for (int t = gw; t < NTOK; t += nw) {
        const int sq = t & (SEQ - 1); const float pos64 = (float)((l8 < 4) ? (sq >> 6) : (sq & 63));
        bf16_t* pr = proj + (size_t)t * 1280 + lane * 8; bf16_t* kvrow = kvbuf + (size_t)t * 2048 + lane * 8;
        const bool dry = ((REPMASK >> 4) & 1) && rep == 0; bf16_t* kvdst = dry ? (bf16_t*)p.out + (size_t)t * 2048 + lane * 8 : kvrow;
        u32x4 P2 = {0u, 0u, 0u, 0u}; if (lane >= 16 && lane < 24) P2 = *(const u32x4*)(pr + 1024);
        u32x4 KV0 = P2, KV1 = P2, KV2 = P2, KV3 = P2;
        if (is_k) { KV0 = *(const u32x4*)kvrow; KV1 = *(const u32x4*)(kvrow + 512); KV2 = *(const u32x4*)(kvrow + 1024); KV3 = *(const u32x4*)(kvrow + 1536); }
        float a[8], b[8];
        unpack8(P2, a);
        { const float s8 = group_sum<8>(sumsq8(a)); const float rsB = rsqrtf(s8 * (1.f / 64.f) + EPS);
#pragma unroll
          for (int j = 0; j < 8; ++j) b[j] = a[j] * rsB * g_kp[j];
          rope8<2>(b, inv64, pos64, first64);
          if (lane >= 16 && lane < 24 && !dry) *(u32x4*)(pr + 1024) = pack8(b); }
#define KCHUNK(W, OFF) do { unpack8(W, a); norm8<16>(a, g_kn); if (is_k) *(u32x4*)(kvdst + (OFF)) = pack8(a); } while (0)
        KCHUNK(KV0, 0); KCHUNK(KV1, 512); KCHUNK(KV2, 1024); KCHUNK(KV3, 1536);
#undef KCHUNK
      }
      if (!(((REPMASK >> 4) & 1) && rep == 0)) for (int r = gw; r < 2 * NMEMROWS; r += nw) {
        float g_mk[8]; load8(g_mk, p.in[8] + (r / NMEMROWS) * 128 + l16 * 8);
        bf16_t* row = memkv + (size_t)r * 1024 + lane * 8;
        float a[8]; unpack8(*(const u32x4*)row, a); norm8<16>(a, g_mk); *(u32x4*)row = pack8(a);
      }
    } break;
    case 7: case 15: rms_rows(p.out, p.in[4] + (ph == 7 ? 0 : 1024), hbuf, NTOK); break;
    case 10: rms_rows(p.out, p.in[3] + 1024, hbuf, NTOK); break;
    case 12: {
      const int l16 = lane & 15;
      float inv128[8], g_k[8];
#pragma unroll
      for (int j = 0; j < 8; ++j) inv128[j] = exp2f(-(float)(2 * ((l16 & 3) * 8 + j)) * (1.f / 64.f) * LOG2_THETA);
      load8(g_k, p.in[20] + l16 * 8);
      const bool first128 = !(l16 & 4);
      for (int t = gw; t < NTOK; t += nw) {
        const int sq = t & (SEQ - 1); const float pos128 = (float)((l16 < 8) ? (sq >> 6) : (sq & 63));
        bf16_t* row = proj + (size_t)t * 2048 + lane * 8;
        bf16_t* dst = (((REPMASK >> 12) & 1) && rep == 0) ? row + 128ull * MiB : row;
        const u32x4 W2 = *(const u32x4*)(row + 1024);
        float a[8];
        unpack8(W2, a); norm8<16>(a, g_k); rope8<4>(a, inv128, pos128, first128); if (lane < 32) *(u32x4*)(dst + 1024) = pack8(a);
      }
    } break;
    default: break;
    }
    if (PHMASK & 2) {
      GemmJob j; const int ng = gemm_jobs(p, ph, 0, j);
      for (int gi = 0; gi < ng; ++gi) {
        if (gi) gemm_jobs(p, ph, gi, j);
        if (j.kind == 0) pg8::run_gemm(glds, j.A, j.lda, j.Bt, j.M, j.N, j.K, pg8::EpiBf16{j.O, j.ldc, j.rs_in, j.inv_n, j.csq, j.ckv}, j.coff, j.stag);
        else if (j.kind == 1) pg8::run_gemm(glds, j.A, j.lda, j.Bt, j.M, j.N, j.K, pg8::EpiResF32{p.out, j.res, j.rs_out ? j.O : nullptr, j.rs_out}, j.coff, j.stag);
        else pg8::run_gemm(glds, j.A, j.lda, j.Bt, j.M, j.N, j.K, pg8::EpiSwiGLU{j.O, j.rs_in}, j.coff, j.stag);
      }
    }
    if ((PHMASK & 12) && (ph == 5 || ph == 13)) {
      const int L = ph == 5 ? 0 : 1;
      att::AttnJob a; a.qgain = nullptr; a.rsq = nullptr; a.qrope = 1;
      if (L == 0) {
        a.Q = qbuf; a.Q2 = qbuf + 1024; a.ldq = 1536; a.qhs = 128; a.K = kvbuf; a.ldk = 2048; a.khs = 256; a.kbs = (long)SEQ * 2048; a.K2 = proj + 1152; a.ldk2 = 1280;
        a.V = kvbuf + 128; a.ldv = 2048; a.O = mix; a.H = 8; a.gshift = 0; a.seq = SEQ; a.nunits = 2048; a.scale = 0.072168783648703220f; a.qgain = p.in[16];
        if (PHMASK & 4) att::run_attn<192, 1>(a, alds, glds);
      } else {
        a.Q = proj; a.Q2 = proj; a.ldq = 2048; a.qhs = 128; a.K = proj + 1024; a.ldk = 2048; a.khs = 128; a.kbs = (long)SEQ * 2048; a.K2 = proj; a.ldk2 = 0;
        a.V = proj + 1280; a.ldv = 2048; a.O = mix; a.H = 8; a.gshift = 2; a.seq = SEQ; a.nunits = 2048; a.scale = 0.088388347648318440f; a.qgain = p.in[19];
      }
      for (int pass = (L == 0 ? 1 : 0); pass < 2; ++pass) {
        if (pass == 1) {
          a.Q = L == 0 ? proj + 640 : proj + 1536; a.Q2 = a.Q; a.ldq = L == 0 ? 1280 : 2048; a.qhs = 128;
          a.K = memkv + (size_t)L * NMEMROWS * 1024; a.ldk = 1024; a.khs = 128; a.kbs = 256 * 1024; a.K2 = a.K; a.ldk2 = 0;
          a.V = a.K + 512; a.ldv = 1024; a.O = mix + 1024; a.H = 4; a.gshift = 0; a.seq = 256; a.nunits = 1024; a.scale = 0.088388347648318440f; a.qgain = p.in[7] + L * 128; a.qrope = 0;
        }
        if (PHMASK & 8) att::run_attn<128, A128_SD>(a, alds, glds);
      }
    }
    }
    if (ph + 1 < ph_hi) xcd_barrier(xb);
  }
}

extern "C" void kernel_launch(void* const* d_in, const int* in_sizes, int n_in, void* d_out, int out_size, void* d_ws, size_t ws_size, hipStream_t stream) {
  static int grid = 0;
  if (grid == 0) {
    if (n_in != 21 || in_sizes[0] != NTOK * DM || out_size != NTOK * DM || ws_size < WS_END) {
      fprintf(stderr, "kernel_launch: shape/workspace mismatch (n_in %d, in0 %d, out %d, ws %zu, need %zu)\n", n_in, n_in > 0 ? in_sizes[0] : -1, out_size, ws_size, (size_t)WS_END);
      grid = -1; return; }
    int dev = 0, cus = 0, per_cu = 0;
    (void)hipGetDevice(&dev); (void)hipDeviceGetAttribute(&cus, hipDeviceAttributeMultiprocessorCount, dev);
    if (hipFuncSetAttribute((const void*)mega, hipFuncAttributeMaxDynamicSharedMemorySize, LDS_BYTES) != hipSuccess) { fprintf(stderr, "kernel_launch: hipFuncSetAttribute failed\n"); grid = -1; return; }
    if (hipOccupancyMaxActiveBlocksPerMultiprocessor(&per_cu, (const void*)mega, 512, LDS_BYTES) != hipSuccess || per_cu < 1) { fprintf(stderr, "kernel_launch: occupancy query says %d\n", per_cu); per_cu = 1; }
    (void)hipGetLastError();
    grid = cus * 1;
    if (grid <= 0) grid = 256;
  }
  if (grid < 0) return;
  if (hipMemsetAsync((char*)d_ws + WS_BAR, 0, XCD_BAR_WORDS * 4, stream) != hipSuccess) { fprintf(stderr, "kernel_launch: memset of barrier words failed\n"); return; }
  Params p{};
  for (int i = 0; i < 21; ++i) p.in[i] = (const float*)d_in[i];
  p.out = (float*)d_out; p.ws = (unsigned char*)d_ws;
#if MK_ONE_LAUNCH
  p.ph_lo = 0; p.ph_hi = NPHASE;
  void* args[] = {&p};
  hipError_t e = hipLaunchCooperativeKernel((const void*)mega, dim3(grid), dim3(512), args, LDS_BYTES, stream);
  if (e != hipSuccess) fprintf(stderr, "kernel_launch: cooperative launch failed: %s (grid %d)\n", hipGetErrorString(e), grid);
#else
  for (int ph = 0; ph < NPHASE; ++ph) {
    p.ph_lo = ph; p.ph_hi = ph + 1;
    hipLaunchKernelGGL(mega, dim3(grid), dim3(512), LDS_BYTES, stream, p);
  }
#endif
}
```

```cpp
#include <hip/hip_runtime.h>
#include <hip/hip_cooperative_groups.h>
#include <cstdio>
#include <cstdint>
namespace cg = cooperative_groups;

#ifndef MK_ONE_LAUNCH
#define MK_ONE_LAUNCH 1
#endif

typedef unsigned short bf16_t;
typedef short bf16x8 __attribute__((ext_vector_type(8)));
typedef short s16x4 __attribute__((ext_vector_type(4)));
typedef float f32x4 __attribute__((ext_vector_type(4)));
typedef float f32x16 __attribute__((ext_vector_type(16)));
typedef unsigned u32x4 __attribute__((ext_vector_type(4)));
typedef unsigned u32x2 __attribute__((ext_vector_type(2)));
#define LAS __attribute__((address_space(3)))

constexpr int NTOK = 65536, SEQ = 8192, DM = 1024, DFF = 2816, NMEMROWS = 2048;
constexpr float EPS = 1e-6f;
constexpr float LOG2_THETA = 13.287712379549449f;
constexpr float INV2PI = 0.15915494309189535f;
constexpr size_t MiB = 1ull << 20;
constexpr size_t WS_WT_IN0 = 0;
constexpr size_t WS_WT_QB = WS_WT_IN0 + 1280ull * 1024 * 2;
constexpr size_t WS_WT_KVB = WS_WT_QB + 1536ull * 384 * 2;
constexpr size_t WS_WT_OUT = WS_WT_KVB + 2048ull * 256 * 2;
constexpr size_t WS_WT_MEMKV = WS_WT_OUT + 2ull * 1024 * 1536 * 2;
constexpr size_t WS_WT_GU = WS_WT_MEMKV + 2ull * 1024 * 1024 * 2;
constexpr size_t WS_WT_DN = WS_WT_GU + 2ull * 5632 * 1024 * 2;
constexpr size_t WS_WT_IN1 = WS_WT_DN + 2ull * 1024 * 2816 * 2;
constexpr size_t WS_WT_END = WS_WT_IN1 + 2048ull * 1024 * 2;
static_assert(WS_WT_END <= 56 * MiB, "weights region");
constexpr size_t WS_MEMN = 56 * MiB;
constexpr size_t WS_MEMKV = 60 * MiB;
constexpr size_t WS_BAR = 70 * MiB;
constexpr size_t WS_ROWSS = 70 * MiB + 65536;
constexpr size_t WS_HM = 72 * MiB;
constexpr size_t WS_R = 264 * MiB;
constexpr size_t WS_Q = WS_R + 160 * MiB;
constexpr size_t WS_KV = WS_Q + 192 * MiB;
constexpr size_t WS_XB = WS_R + 352 * MiB;
constexpr size_t WS_END = WS_KV + 256 * MiB;

struct Params { const float* in[21]; float* out; unsigned char* ws; int ph_lo, ph_hi; };

__device__ __forceinline__ float bf2f(bf16_t v) { return __uint_as_float(((unsigned)v) << 16); }
__device__ __forceinline__ bf16_t f2bf(float f) { unsigned u = __float_as_uint(f); u += 0x7FFFu + ((u >> 16) & 1u); return (bf16_t)(u >> 16); }
__device__ __forceinline__ unsigned cvtpk(float lo, float hi) { unsigned r; asm volatile("v_cvt_pk_bf16_f32 %0, %1, %2" : "=v"(r) : "v"(lo), "v"(hi)); return r; }
__device__ __forceinline__ float wave_sum(float v) {
#pragma unroll
  for (int o = 32; o > 0; o >>= 1) v += __shfl_xor(v, o, 64);
  return v;
}

__device__ __forceinline__ int opaque_tid() { int t = threadIdx.x; asm volatile("" : "+v"(t)); return t; }

namespace pg8 {
constexpr int BM = 256, BK = 64, HALF = 128, HTB = HALF * BK * 2, STAGE_BYTES = 8 * HTB, NXCD = 8, WGM = 4;
__device__ __forceinline__ int lds_byte(int r, int c) { const int st = (r >> 4) * 2 + (c >> 5), rr = r & 15, cc = c & 31, ob = rr * 64 + cc * 2; return st * 1024 + (ob ^ (((ob >> 9) & 1) << 5)); }
__device__ __forceinline__ void stage_rc(int b, int& R, int& C) { const int st = b / 1024, sb = b % 1024, swz = sb ^ (((sb >> 9) & 1) << 5); R = (st >> 1) * 16 + swz / 64; C = (st & 1) * 32 + (swz % 64) / 2; }
__device__ __forceinline__ int perm32(int rho) { const int n = rho >> 4, i = rho & 15; return 8 * (i >> 2) + 4 * n + (i & 3); }
struct Unit { int pm, pn; };
struct Gemm { const bf16_t* A; const bf16_t* Bt; int M, N, K, lda; };
struct StaticOrder {
  int nM, nN, nwg, G, c;
  __device__ void init(int M, int N, int G_, int c_) { nM = M / BM; nN = N / BM; nwg = nM * nN; G = G_; c = c_; }
  __device__ bool next(int i, Unit& u) const {
    const long L = (long)i * G + c; if (L >= nwg) return false;
    int wgid = (int)L; { const int q = nwg / NXCD, r = nwg % NXCD, xcd = wgid % NXCD, off = wgid / NXCD; wgid = (xcd < r ? xcd * (q + 1) : r * (q + 1) + (xcd - r) * q) + off; }
    const int nig = WGM * nN, gid = wgid / nig, fm = gid * WGM, gsz = (nM - fm) < WGM ? (nM - fm) : WGM;
    u.pm = fm + ((wgid % nig) % gsz); u.pn = (wgid % nig) / gsz; return true;
  }
};

struct EpiBf16 {
  static constexpr bool PERM = true;
  bf16_t* O; int ldc; const float* rowss; float inv_n; float* csq; float* ckv; int nt;
  __device__ __forceinline__ void pre(const Unit& u, int wr, int fr, float (&rsv)[2][4]) const {
    const int row0 = u.pm * BM + wr * 64 + fr;
#pragma unroll
    for (int ai = 0; ai < 2; ++ai)
#pragma unroll
      for (int m = 0; m < 4; ++m) rsv[ai][m] = rowss ? rowss[row0 + ai * HALF + m * 16] : 0.f;
  }
  __device__ __forceinline__ void operator()(const f32x4 (&acc)[2][2][4][2], const Unit& u, int wr, int wc, int fr, int fq, const float (&rsv)[2][4]) const {
    const int row0 = u.pm * BM + wr * 64 + fr, col0 = u.pn * BM + wc * 32 + 8 * fq;
    float* tgt0 = nullptr; float* tgt1 = nullptr;
    if (csq) { if (u.pn == 0) { tgt0 = csq; tgt1 = csq; } else if (u.pn == 1) { tgt0 = csq; tgt1 = ckv; } else if (u.pn == 2) { tgt0 = ckv; } }
#pragma unroll
    for (int ai = 0; ai < 2; ++ai)
#pragma unroll
      for (int m = 0; m < 4; ++m) { const int row = row0 + ai * HALF + m * 16; bf16_t* rowp = O + (size_t)row * ldc + col0;
        const float rs = rowss ? rsqrtf(rsv[ai][m] * inv_n + EPS) : 1.f;
#pragma unroll
        for (int bj = 0; bj < 2; ++bj) { const f32x4 v0 = acc[ai][bj][m][0] * rs, v1 = acc[ai][bj][m][1] * rs;
          u32x4 w; w.x = cvtpk(v0[0], v0[1]); w.y = cvtpk(v0[2], v0[3]); w.z = cvtpk(v1[0], v1[1]); w.w = cvtpk(v1[2], v1[3]);
          if (nt) __builtin_nontemporal_store(w, (u32x4*)(rowp + bj * HALF)); else *(u32x4*)(rowp + bj * HALF) = w;
          float* tg = bj ? tgt1 : tgt0;
          if (tg) { float ss = v0[0] * v0[0] + v0[1] * v0[1] + v0[2] * v0[2] + v0[3] * v0[3] + v1[0] * v1[0] + v1[1] * v1[1] + v1[2] * v1[2] + v1[3] * v1[3];
            ss += __shfl_xor(ss, 16, 64); ss += __shfl_xor(ss, 32, 64); if (fq == 0) unsafeAtomicAdd(tg + row, ss); } } }
  }
};
struct EpiResF32 {
  static constexpr bool PERM = false;
  float* out; const float* res; bf16_t* xb; float* rowss;
  __device__ __forceinline__ void pre(const Unit&, int, int, float (&)[2][4]) const {}
  __device__ __forceinline__ void operator()(const f32x4 (&acc)[2][2][4][2], const Unit& u, int wr, int wc, int fr, int fq, const float (&)[2][4]) const {
    const int row0 = u.pm * BM + wr * 64 + fr, col0 = u.pn * BM + wc * 32 + 4 * fq;
    f32x4 r[2][2][2][2];
#define ER_LOAD(buf, ai, mp) do { _Pragma("unroll") for (int mm = 0; mm < 2; ++mm) { const size_t off = (size_t)(row0 + (ai) * HALF + ((mp) + mm) * 16) * DM + col0; \
      _Pragma("unroll") for (int bj = 0; bj < 2; ++bj) _Pragma("unroll") for (int n = 0; n < 2; ++n) r[buf][mm][bj][n] = *(const f32x4*)(res + off + bj * HALF + n * 16); } } while (0)
#define ER_STORE(buf, ai, mp) do { _Pragma("unroll") for (int mm = 0; mm < 2; ++mm) { const int row = row0 + (ai) * HALF + ((mp) + mm) * 16; const size_t off = (size_t)row * DM + col0; float ss = 0.f; \
      _Pragma("unroll") for (int bj = 0; bj < 2; ++bj) _Pragma("unroll") for (int n = 0; n < 2; ++n) { const f32x4 v = r[buf][mm][bj][n] + acc[ai][bj][(mp) + mm][n]; \
        *(f32x4*)(out + off + bj * HALF + n * 16) = v; \
        if (xb) { u32x2 w; w.x = cvtpk(v[0], v[1]); w.y = cvtpk(v[2], v[3]); *(u32x2*)(xb + off + bj * HALF + n * 16) = w; ss += v[0] * v[0] + v[1] * v[1] + v[2] * v[2] + v[3] * v[3]; } } \
      if (xb) { ss += __shfl_xor(ss, 16, 64); ss += __shfl_xor(ss, 32, 64); if (fq == 0) unsafeAtomicAdd(rowss + row, ss); } } } while (0)
    ER_LOAD(0, 0, 0); ER_LOAD(1, 0, 2);
    ER_STORE(0, 0, 0); ER_LOAD(0, 1, 0);
    ER_STORE(1, 0, 2); ER_LOAD(1, 1, 2);
    ER_STORE(0, 1, 0); ER_STORE(1, 1, 2);
#undef ER_LOAD
#undef ER_STORE
  }
};
struct EpiSwiGLU {
  static constexpr bool PERM = true;
  bf16_t* O; const float* rowss;
  __device__ __forceinline__ void pre(const Unit& u, int wr, int fr, float (&rsv)[2][4]) const {
    const int row0 = u.pm * BM + wr * 64 + fr;
#pragma unroll
    for (int ai = 0; ai < 2; ++ai)
#pragma unroll
      for (int m = 0; m < 4; ++m) rsv[ai][m] = rowss[row0 + ai * HALF + m * 16];
  }
  __device__ __forceinline__ void operator()(const f32x4 (&acc)[2][2][4][2], const Unit& u, int wr, int wc, int fr, int fq, const float (&rsv)[2][4]) const {
    const int row0 = u.pm * BM + wr * 64 + fr, col0 = u.pn * HALF + wc * 32 + 8 * fq;
#pragma unroll
    for (int ai = 0; ai < 2; ++ai)
#pragma unroll
      for (int m = 0; m < 4; ++m) { const int row = row0 + ai * HALF + m * 16; bf16_t* rowp = O + (size_t)row * DFF + col0;
        const float rs = rsqrtf(rsv[ai][m] * (1.f / DM) + EPS);
        float y[8];
#pragma unroll
        for (int n = 0; n < 2; ++n)
#pragma unroll
          for (int j = 0; j < 4; ++j) { const float g = acc[ai][0][m][n][j] * rs, up = acc[ai][1][m][n][j] * rs;
            const float e = __builtin_amdgcn_exp2f(-g * 1.4426950408889634f);
            y[n * 4 + j] = g * __builtin_amdgcn_rcpf(1.0f + e) * up; }
        u32x4 w; w.x = cvtpk(y[0], y[1]); w.y = cvtpk(y[2], y[3]); w.z = cvtpk(y[4], y[5]); w.w = cvtpk(y[6], y[7]);
        __builtin_nontemporal_store(w, (u32x4*)rowp); }
  }
};

template <class Epi>
__device__ __forceinline__ void gemm_phase(LAS unsigned char* lds, const Gemm g, const StaticOrder& S, const Epi& E) {
  const int tid = opaque_tid(), wid = __builtin_amdgcn_readfirstlane(tid >> 6), lane = tid & 63, wr = wid >> 2, wc = wid & 3, fr = lane & 15, fq = lane >> 4;
  const int K = g.K, nt = K / BK, lda = g.lda;
  unsigned voffA[2], voffB[2];
#pragma unroll
  for (int i = 0; i < 2; ++i) { int R, C; stage_rc(tid * 16 + i * 8192, R, C); const int Rb = Epi::PERM ? ((R & ~31) + perm32(R & 31)) : R;
    voffA[i] = (unsigned)(R * lda + C) * 2u; voffB[i] = (unsigned)(Rb * K + C) * 2u; }
  const size_t kstep = (size_t)(BK * 2);
  const size_t hstepA = (size_t)HALF * lda * 2, hstepB = (size_t)HALF * K * 2;
  const size_t tstepA = 2 * hstepA, tstepB = 2 * hstepB;
  const unsigned ldsw = (unsigned)wid * 1024u;
  const int aoff = lds_byte(wr * 64 + fr, fq * 8), boff = lds_byte(wc * 32 + fr, fq * 8);
#define PG8_SA(b, h) (((b) * 2 + (h)) * HTB)
#define PG8_SB(b, h) ((4 + (b) * 2 + (h)) * HTB)
#define PG8_STAGE(bufoff, gbase, voff) do { _Pragma("unroll") for (int _i = 0; _i < 2; ++_i) \
    __builtin_amdgcn_global_load_lds((const unsigned*)((const char*)(gbase) + (voff)[_i]), (LAS unsigned*)(lds + (bufoff) + ldsw + _i * 8192), 16, 0, 0); } while (0)
#define PG8_LDA(dst, b, h) do { _Pragma("unroll") for (int m = 0; m < 4; ++m) _Pragma("unroll") for (int k = 0; k < 2; ++k) dst[m][k] = *(const LAS bf16x8*)(lds + PG8_SA(b, h) + aoff + m * 2048 + k * 1024); } while (0)
#define PG8_LDB(dst, b, h) do { _Pragma("unroll") for (int n = 0; n < 2; ++n) _Pragma("unroll") for (int k = 0; k < 2; ++k) dst[n][k] = *(const LAS bf16x8*)(lds + PG8_SB(b, h) + boff + n * 2048 + k * 1024); } while (0)
#define PG8_MMA(ai, bj, At, Bt) do { __builtin_amdgcn_s_setprio(1); _Pragma("unroll") for (int m = 0; m < 4; ++m) _Pragma("unroll") for (int n = 0; n < 2; ++n) _Pragma("unroll") for (int k = 0; k < 2; ++k) \
    acc[ai][bj][m][n] = __builtin_amdgcn_mfma_f32_16x16x32_bf16(Bt[n][k], At[m][k], acc[ai][bj][m][n], 0, 0, 0); __builtin_amdgcn_s_setprio(0); } while (0)
#define PG8_WAIT_V(n) asm volatile("s_waitcnt vmcnt(" #n ")" ::: "memory")
#define PG8_WAIT_L(n) asm volatile("s_waitcnt lgkmcnt(" #n ")" ::: "memory")
#define PG8_BAR __builtin_amdgcn_s_barrier()
#define PG8_SCHED __builtin_amdgcn_sched_barrier(0)
  Unit cur, nxt; int ui = 0;
  if (!S.next(0, cur)) return;
  f32x4 acc[2][2][4][2];
#pragma unroll
  for (int a = 0; a < 2; ++a)
#pragma unroll
    for (int b = 0; b < 2; ++b)
#pragma unroll
      for (int m = 0; m < 4; ++m)
#pragma unroll
        for (int n = 0; n < 2; ++n) acc[a][b][m][n] = (f32x4){0.f, 0.f, 0.f, 0.f};
  bf16x8 At[4][2], B0[2][2], B1[2][2];
  float rsv[2][4] = {};
  const char* cA = (const char*)g.A + (size_t)cur.pm * tstepA; const char* cB = (const char*)g.Bt + (size_t)cur.pn * tstepB;
  PG8_STAGE(PG8_SB(0, 0), cB, voffB); PG8_STAGE(PG8_SA(0, 0), cA, voffA); PG8_STAGE(PG8_SB(0, 1), cB + hstepB, voffB); PG8_STAGE(PG8_SA(0, 1), cA + hstepA, voffA);
  if (wr == 1) PG8_BAR;
  PG8_WAIT_V(4); PG8_BAR;
  PG8_STAGE(PG8_SB(1, 0), cB + kstep, voffB); PG8_STAGE(PG8_SA(1, 0), cA + kstep, voffA); PG8_STAGE(PG8_SB(1, 1), cB + hstepB + kstep, voffB);
  PG8_WAIT_V(6); PG8_BAR;
  for (;;) {
    const bool has_next = S.next(ui + 1, nxt);
    const char* nA = has_next ? (const char*)g.A + (size_t)nxt.pm * tstepA : cA; const char* nB = has_next ? (const char*)g.Bt + (size_t)nxt.pn * tstepB : cB;
    for (int t = 0; t < nt; t += 2) {
      const bool last = (t == nt - 2);
      if (last) E.pre(cur, wr, fr, rsv);
      const char* a1 = cA + (size_t)(t + 1) * kstep;
      const char* a2 = last ? nA : cA + (size_t)(t + 2) * kstep; const char* b2 = last ? nB : cB + (size_t)(t + 2) * kstep;
      const char* a3 = a2 + kstep; const char* b3 = b2 + kstep;
      PG8_LDB(B0, 0, 0); PG8_SCHED; PG8_LDA(At, 0, 0); PG8_STAGE(PG8_SA(1, 1), a1 + hstepA, voffA);
      PG8_WAIT_L(8); PG8_BAR; PG8_WAIT_L(0); PG8_MMA(0, 0, At, B0); PG8_BAR; PG8_SCHED;
      PG8_LDB(B1, 0, 1); PG8_STAGE(PG8_SB(0, 0), b2, voffB);
      PG8_BAR; PG8_WAIT_L(0); PG8_MMA(0, 1, At, B1); PG8_BAR;
      PG8_LDA(At, 0, 1); PG8_STAGE(PG8_SA(0, 0), a2, voffA);
      PG8_BAR; PG8_WAIT_L(0); PG8_MMA(1, 0, At, B0); PG8_BAR; PG8_SCHED;
      PG8_STAGE(PG8_SB(0, 1), b2 + hstepB, voffB);
      PG8_WAIT_V(6); PG8_BAR; PG8_MMA(1, 1, At, B1); PG8_BAR;
      PG8_LDB(B0, 1, 0); PG8_SCHED; PG8_LDA(At, 1, 0); PG8_STAGE(PG8_SA(0, 1), a2 + hstepA, voffA);
      PG8_WAIT_L(8); PG8_BAR; PG8_WAIT_L(0); PG8_MMA(0, 0, At, B0); PG8_BAR; PG8_SCHED;
      PG8_LDB(B1, 1, 1); PG8_STAGE(PG8_SB(1, 0), b3, voffB);
      PG8_BAR; PG8_WAIT_L(0); PG8_MMA(0, 1, At, B1); PG8_BAR;
      PG8_LDA(At, 1, 1); PG8_STAGE(PG8_SA(1, 0), a3, voffA);
      PG8_BAR; PG8_WAIT_L(0); PG8_MMA(1, 0, At, B0); PG8_BAR; PG8_SCHED;
      PG8_STAGE(PG8_SB(1, 1), b3 + hstepB, voffB);
      PG8_WAIT_V(6); PG8_BAR; PG8_MMA(1, 1, At, B1); PG8_BAR;
    }
    E(acc, cur, wr, wc, fr, fq, rsv);
    if (!has_next) break;
#pragma unroll
    for (int a = 0; a < 2; ++a)
#pragma unroll
      for (int b = 0; b < 2; ++b)
#pragma unroll
        for (int m = 0; m < 4; ++m)
#pragma unroll
          for (int n = 0; n < 2; ++n) acc[a][b][m][n] = (f32x4){0.f, 0.f, 0.f, 0.f};
    cur = nxt; cA = nA; cB = nB; ++ui;
  }
  PG8_WAIT_V(0);
  if (wr == 0) PG8_BAR;
  PG8_BAR;
#undef PG8_SA
#undef PG8_SB
#undef PG8_STAGE
#undef PG8_LDA
#undef PG8_LDB
#undef PG8_MMA
#undef PG8_WAIT_V
#undef PG8_WAIT_L
#undef PG8_BAR
#undef PG8_SCHED
}
template <class Epi>
__device__ __forceinline__ void run_gemm(LAS unsigned char* lds, const bf16_t* A, int lda, const bf16_t* Bt, int M, int N, int K, const Epi& E, int coff, int stagger_ticks) {
  if (stagger_ticks > 0) {
    const unsigned long long t0 = __builtin_amdgcn_s_memrealtime(); const unsigned long long d = (unsigned long long)(((blockIdx.x >> 3) & 7) * stagger_ticks) >> 3;
    while (__builtin_amdgcn_s_memrealtime() - t0 < d) __builtin_amdgcn_s_sleep(8);
  }
  Gemm g{A, Bt, M, N, K, lda};
  StaticOrder S; S.init(M, N, (int)gridDim.x, (int)((blockIdx.x + coff) % gridDim.x));
  gemm_phase<Epi>(lds, g, S, E);
}
}

namespace att {
constexpr int NW = 8, QBLK = 32, KVBLK = 64;
constexpr float THR = 8.f;
constexpr int SHM_V = KVBLK * 128 * 2, SHM_K = KVBLK * 128 * 2, SHM_K2 = KVBLK * 64 * 2;
constexpr int NBUF = 3;
constexpr int OFF_K = NBUF * SHM_V, OFF_K2 = OFF_K + NBUF * SHM_K, OFF_WS = OFF_K2 + NBUF * SHM_K2, OFF_Q2 = OFF_WS + NW * 64 * 4, SHM_ATTN = OFF_Q2 + 32768;
#define KSWZ(row, colB) ((row) * 256 + ((colB) ^ (((row) & 7) << 4)))
#define K2SWZ(row, colB) ((row) * 128 + ((colB) ^ ((((row) >> 1) & 7) << 4)))
#define SBAR() __builtin_amdgcn_sched_barrier(0)
__device__ __forceinline__ int crow(int r, int hi) { return (r & 3) + 8 * (r >> 2) + 4 * hi; }
__device__ __forceinline__ void partialSM(f32x16& p0, f32x16& p1, float& m_reg, float& mn, float& alpha, float C, float thr_s) {
  float pmax = p0[0];
#pragma unroll
  for (int r = 1; r < 16; ++r) pmax = fmaxf(pmax, p0[r]);
#pragma unroll
  for (int r = 0; r < 16; ++r) pmax = fmaxf(pmax, p1[r]);
  { auto rr = __builtin_amdgcn_permlane32_swap(__float_as_uint(pmax), __float_as_uint(pmax), false, false);
    pmax = fmaxf(__uint_as_float(rr[0]), __uint_as_float(rr[1])); }
  if (__builtin_expect(__all(pmax - m_reg <= thr_s), 1)) { mn = m_reg; alpha = 1.f; }
  else { mn = fmaxf(m_reg, pmax); alpha = __builtin_amdgcn_exp2f((m_reg - mn) * C); m_reg = mn; }
  float mnC = -mn * C;
#pragma unroll
  for (int r = 0; r < 16; ++r) p0[r] = fmaf(p0[r], C, mnC);
#pragma unroll
  for (int r = 0; r < 16; ++r) p1[r] = fmaf(p1[r], C, mnC);
#pragma unroll
  for (int r = 0; r < 16; ++r) p0[r] = __builtin_amdgcn_exp2f(p0[r]);
}
__device__ __forceinline__ void finishSM(f32x16& p0, f32x16& p1, float alpha, float& l_reg, bf16x8& pa0, bf16x8& pa1, bf16x8& pa2, bf16x8& pa3) {
#pragma unroll
  for (int r = 0; r < 16; ++r) p1[r] = __builtin_amdgcn_exp2f(p1[r]);
  float ps = 0;
#pragma unroll
  for (int r = 0; r < 16; ++r) ps += p0[r];
#pragma unroll
  for (int r = 0; r < 16; ++r) ps += p1[r];
  { auto rr = __builtin_amdgcn_permlane32_swap(__float_as_uint(ps), __float_as_uint(ps), false, false);
    ps = __uint_as_float(rr[0]) + __uint_as_float(rr[1]); }
  l_reg = l_reg * alpha + ps;
#define PK4(P, BASE, OUT) do { unsigned a0 = cvtpk(P[BASE + 0], P[BASE + 1]), a1 = cvtpk(P[BASE + 2], P[BASE + 3]);   \
    unsigned b0 = cvtpk(P[BASE + 4], P[BASE + 5]), b1 = cvtpk(P[BASE + 6], P[BASE + 7]);                              \
    auto r0 = __builtin_amdgcn_permlane32_swap(a0, b0, false, false); auto r1 = __builtin_amdgcn_permlane32_swap(a1, b1, false, false); \
    u32x4 w = {r0[0], r1[0], r0[1], r1[1]}; OUT = *reinterpret_cast<bf16x8*>(&w); } while (0)
  PK4(p0, 0, pa0); PK4(p0, 8, pa1); PK4(p1, 0, pa2); PK4(p1, 8, pa3);
#undef PK4
}
template <int DQK>
__device__ __forceinline__ void qkt(f32x16& p0, f32x16& p1, const char* Ks, const char* K2s, const bf16x8* qr, const char* q2l, int r32, int hi) {
#pragma unroll
  for (int r = 0; r < 16; ++r) { p0[r] = 0.f; p1[r] = 0.f; }
#pragma unroll
  for (int d0 = 0; d0 < 8; ++d0) { int cb = (d0 * 16 + hi * 8) * 2;
    bf16x8 b0 = *reinterpret_cast<const bf16x8*>(Ks + KSWZ(r32, cb));
    bf16x8 b1 = *reinterpret_cast<const bf16x8*>(Ks + KSWZ(32 + r32, cb));
    p0 = __builtin_amdgcn_mfma_f32_32x32x16_bf16(b0, qr[d0], p0, 0, 0, 0);
    p1 = __builtin_amdgcn_mfma_f32_32x32x16_bf16(b1, qr[d0], p1, 0, 0, 0); }
  if constexpr (DQK == 192) {
#pragma unroll
    for (int d0 = 0; d0 < 4; ++d0) { int cb = (d0 * 16 + hi * 8) * 2;
      bf16x8 b0 = *reinterpret_cast<const bf16x8*>(K2s + K2SWZ(r32, cb));
      bf16x8 b1 = *reinterpret_cast<const bf16x8*>(K2s + K2SWZ(32 + r32, cb));
      const bf16x8 q2 = *reinterpret_cast<const bf16x8*>(q2l + d0 * 1024);
      p0 = __builtin_amdgcn_mfma_f32_32x32x16_bf16(b0, q2, p0, 0, 0, 0);
      p1 = __builtin_amdgcn_mfma_f32_32x32x16_bf16(b1, q2, p1, 0, 0, 0); }
  }
}
__device__ __forceinline__ int v_st(int k, int c) { const int kk = (k & ~0xC) | ((k & 4) << 1) | ((k & 8) >> 1); return ((kk >> 3) * 4 + (c >> 5)) * 512 + ((kk & 7) * 32 + (c & 31)) * 2; }
__device__ __forceinline__ int v_rd_base(int lane) { return ((lane & 3) << 3) | (((lane >> 2) & 3) << 6) | (((lane >> 4) & 1) << 5) | (((lane >> 5) & 1) << 8); }
constexpr int v_rd_off(int d0, int ks, int half) { return d0 * 512 + ks * 4096 + half * 2048; }
template <int OFF> __device__ __forceinline__ s16x4 tr_read(int vb) {
  s16x4 r; asm volatile("ds_read_b64_tr_b16 %0, %1 offset:%2" : "=&v"(r) : "v"(vb), "i"(OFF) : "memory"); return r;
}
template <int D0> __device__ __forceinline__ void pv_one(f32x16& od, int vb, bf16x8 pa0, bf16x8 pa1, bf16x8 pa2, bf16x8 pa3) {
  const s16x4 l0 = tr_read<v_rd_off(D0, 0, 0)>(vb), h0 = tr_read<v_rd_off(D0, 0, 1)>(vb), l1 = tr_read<v_rd_off(D0, 1, 0)>(vb), h1 = tr_read<v_rd_off(D0, 1, 1)>(vb);
  const s16x4 l2 = tr_read<v_rd_off(D0, 2, 0)>(vb), h2 = tr_read<v_rd_off(D0, 2, 1)>(vb), l3 = tr_read<v_rd_off(D0, 3, 0)>(vb), h3 = tr_read<v_rd_off(D0, 3, 1)>(vb);
  asm volatile("s_waitcnt lgkmcnt(0)" ::: "memory"); SBAR();
#define PK(L, H) (bf16x8){L[0], L[1], L[2], L[3], H[0], H[1], H[2], H[3]}
  od = __builtin_amdgcn_mfma_f32_32x32x16_bf16(pa0, PK(l0, h0), od, 0, 0, 0);
  od = __builtin_amdgcn_mfma_f32_32x32x16_bf16(pa1, PK(l1, h1), od, 0, 0, 0);
  od = __builtin_amdgcn_mfma_f32_32x32x16_bf16(pa2, PK(l2, h2), od, 0, 0, 0);
  od = __builtin_amdgcn_mfma_f32_32x32x16_bf16(pa3, PK(l3, h3), od, 0, 0, 0);
#undef PK
}
__device__ __forceinline__ void pv_d0(f32x16* o, int vb, bf16x8 pa0, bf16x8 pa1, bf16x8 pa2, bf16x8 pa3) {
  pv_one<0>(o[0], vb, pa0, pa1, pa2, pa3); pv_one<1>(o[1], vb, pa0, pa1, pa2, pa3); pv_one<2>(o[2], vb, pa0, pa1, pa2, pa3); pv_one<3>(o[3], vb, pa0, pa1, pa2, pa3);
}

template <int DQK, int SDEPTH>
__device__ __forceinline__ void attn_body(const bf16_t* __restrict__ Qb, const bf16_t* __restrict__ Q2b, int ldq, const bf16_t* __restrict__ Kh, int ldk, const bf16_t* __restrict__ K2h, int ldk2,
                                          const bf16_t* __restrict__ Vh, int ldv, bf16_t* __restrict__ Ob, int ldo, int seq, float scale, char* lds, LAS unsigned char* ldsl,
                                          const float* __restrict__ qgain, int sq0, const float* __restrict__ rsq, int qrope) {
  constexpr int ND = 8;
  const int tid = opaque_tid(), wid = tid >> 6, lane = tid & 63, r32 = lane & 31, hi = lane >> 5;
  const float C = scale * 1.4426950408889634f, thr_s = THR / scale;
  char* V_lds = lds; char* K_lds = lds + OFF_K; char* K2_lds = lds + OFF_K2;
  float* ws = (float*)(lds + OFF_WS) + wid * 64; float* li_l = ws; float* al_l = ws + 32;
  float m_reg = -1e30f, l_reg = 0; f32x16 o[4]; bf16x8 qr[ND];
#pragma unroll
  for (int d = 0; d < 4; ++d)
#pragma unroll
    for (int r = 0; r < 16; ++r) o[d][r] = 0.f;
  const bf16_t* Qw = Qb + (long)(wid * QBLK + r32) * ldq + hi * 8;
#pragma unroll
  for (int d0 = 0; d0 < ND; ++d0) qr[d0] = *reinterpret_cast<const bf16x8*>(Qw + d0 * 16);
  float mla_rsq = 1.f;
  if (DQK == 192 && qgain != nullptr) {
    if (rsq) mla_rsq = rsq[wid * QBLK + r32];
    float ss = 0.f;
#pragma unroll
    for (int d0 = 0; d0 < 8; ++d0) { const u32x4 w = *reinterpret_cast<const u32x4*>(&qr[d0]);
#pragma unroll
      for (int i = 0; i < 4; ++i) { const float lo = __uint_as_float(w[i] << 16) * mla_rsq, hi_ = __uint_as_float(w[i] & 0xffff0000u) * mla_rsq; ss += lo * lo + hi_ * hi_; } }
    ss += __shfl_xor(ss, 32, 64);
    const float rs = rsqrtf(ss * (1.f / 128.f) + EPS);
#pragma unroll
    for (int d0 = 0; d0 < 8; ++d0) { const u32x4 w = *reinterpret_cast<const u32x4*>(&qr[d0]);
      const f32x4 g0 = *(const f32x4*)(qgain + d0 * 16 + hi * 8), g1 = *(const f32x4*)(qgain + d0 * 16 + hi * 8 + 4);
      float x[8];
#pragma unroll
      for (int i = 0; i < 4; ++i) { x[2 * i] = __uint_as_float(w[i] << 16) * mla_rsq; x[2 * i + 1] = __uint_as_float(w[i] & 0xffff0000u) * mla_rsq; }
#pragma unroll
      for (int j = 0; j < 8; ++j) x[j] *= rs * (j < 4 ? g0[j & 3] : g1[j & 3]);
      u32x4 ow; ow.x = cvtpk(x[0], x[1]); ow.y = cvtpk(x[2], x[3]); ow.z = cvtpk(x[4], x[5]); ow.w = cvtpk(x[6], x[7]);
      qr[d0] = *reinterpret_cast<bf16x8*>(&ow); }
  }
  if (DQK == 128 && qgain != nullptr) {
    float ss = 0.f;
#pragma unroll
    for (int d0 = 0; d0 < 8; ++d0) { const u32x4 w = *reinterpret_cast<const u32x4*>(&qr[d0]);
#pragma unroll
      for (int i = 0; i < 4; ++i) { const float lo = __uint_as_float(w[i] << 16), hi_ = __uint_as_float(w[i] & 0xffff0000u); ss += lo * lo + hi_ * hi_; } }
    ss += __shfl_xor(ss, 32, 64);
    const float rs = rsqrtf(ss * (1.f / 128.f) + EPS);
    const int sq = sq0 + wid * QBLK + r32;
#pragma unroll
    for (int part = 0; part < 2; ++part) { const float pos = (float)(part ? (sq & 63) : (sq >> 6));
#pragma unroll
      for (int dp = 0; dp < 2; ++dp) { const int da = part * 4 + dp, db = da + 2;
        const u32x4 wa = *reinterpret_cast<const u32x4*>(&qr[da]), wb = *reinterpret_cast<const u32x4*>(&qr[db]);
        float xa[8], xb_[8];
#pragma unroll
        for (int i = 0; i < 4; ++i) { xa[2 * i] = __uint_as_float(wa[i] << 16); xa[2 * i + 1] = __uint_as_float(wa[i] & 0xffff0000u); xb_[2 * i] = __uint_as_float(wb[i] << 16); xb_[2 * i + 1] = __uint_as_float(wb[i] & 0xffff0000u); }
        const f32x4 ga0 = *(const f32x4*)(qgain + da * 16 + hi * 8), ga1 = *(const f32x4*)(qgain + da * 16 + hi * 8 + 4), gb0 = *(const f32x4*)(qgain + db * 16 + hi * 8), gb1 = *(const f32x4*)(qgain + db * 16 + hi * 8 + 4);
#pragma unroll
        for (int j = 0; j < 8; ++j) { float c = 1.f, sn = 0.f;
          if (qrope) { const float inv = exp2f(-(float)(2 * (dp * 16 + hi * 8 + j)) * (1.f / 64.f) * LOG2_THETA);
            float rev = pos * inv * INV2PI; rev -= floorf(rev); c = __builtin_amdgcn_cosf(rev); sn = __builtin_amdgcn_sinf(rev); }
          const float x1 = xa[j] * rs * (j < 4 ? ga0[j & 3] : ga1[j & 3]), x2 = xb_[j] * rs * (j < 4 ? gb0[j & 3] : gb1[j & 3]);
          xa[j] = x1 * c - x2 * sn; xb_[j] = x2 * c + x1 * sn; }
        u32x4 oa, ob; oa.x = cvtpk(xa[0], xa[1]); oa.y = cvtpk(xa[2], xa[3]); oa.z = cvtpk(xa[4], xa[5]); oa.w = cvtpk(xa[6], xa[7]);
        ob.x = cvtpk(xb_[0], xb_[1]); ob.y = cvtpk(xb_[2], xb_[3]); ob.z = cvtpk(xb_[4], xb_[5]); ob.w = cvtpk(xb_[6], xb_[7]);
        qr[da] = *reinterpret_cast<bf16x8*>(&oa); qr[db] = *reinterpret_cast<bf16x8*>(&ob); } }
  }
  char* q2l = lds + OFF_Q2 + (wid * 4 * 64 + lane) * 16;
  __syncthreads();
  if constexpr (DQK == 192) {
    u32x4 qp[4];
#pragma unroll
    for (int d0 = 0; d0 < 4; ++d0) qp[d0] = *reinterpret_cast<const u32x4*>(Q2b + (long)(wid * QBLK + r32) * ldq + hi * 8 + d0 * 16);
    if (qgain != nullptr) {
      float ss = 0.f;
#pragma unroll
      for (int d = 0; d < 4; ++d)
#pragma unroll
        for (int i = 0; i < 4; ++i) { const float lo = __uint_as_float(qp[d][i] << 16) * mla_rsq, hi_ = __uint_as_float(qp[d][i] & 0xffff0000u) * mla_rsq; ss += lo * lo + hi_ * hi_; }
      ss += __shfl_xor(ss, 32, 64);
      const float rs = rsqrtf(ss * (1.f / 64.f) + EPS) * mla_rsq;
      const int sq = sq0 + wid * QBLK + r32;
#pragma unroll
      for (int part = 0; part < 2; ++part) { const float pos = (float)(part ? (sq & 63) : (sq >> 6)); const int da = 2 * part, db = da + 1;
        const f32x4 ga0 = *(const f32x4*)(qgain + 128 + da * 16 + hi * 8), ga1 = *(const f32x4*)(qgain + 128 + da * 16 + hi * 8 + 4);
        const f32x4 gb0 = *(const f32x4*)(qgain + 128 + db * 16 + hi * 8), gb1 = *(const f32x4*)(qgain + 128 + db * 16 + hi * 8 + 4);
        float xa[8], xb_[8];
#pragma unroll
        for (int i = 0; i < 4; ++i) { xa[2 * i] = __uint_as_float(qp[da][i] << 16); xa[2 * i + 1] = __uint_as_float(qp[da][i] & 0xffff0000u); xb_[2 * i] = __uint_as_float(qp[db][i] << 16); xb_[2 * i + 1] = __uint_as_float(qp[db][i] & 0xffff0000u); }
#pragma unroll
        for (int j = 0; j < 8; ++j) { const float inv = exp2f(-(float)(2 * (hi * 8 + j)) * (1.f / 32.f) * LOG2_THETA);
          float rev = pos * inv * INV2PI; rev -= floorf(rev);
          const float c = __builtin_amdgcn_cosf(rev), sn = __builtin_amdgcn_sinf(rev);
          const float x1 = xa[j] * rs * (j < 4 ? ga0[j & 3] : ga1[j & 3]), x2 = xb_[j] * rs * (j < 4 ? gb0[j & 3] : gb1[j & 3]);
          xa[j] = x1 * c - x2 * sn; xb_[j] = x2 * c + x1 * sn; }
        qp[da].x = cvtpk(xa[0], xa[1]); qp[da].y = cvtpk(xa[2], xa[3]); qp[da].z = cvtpk(xa[4], xa[5]); qp[da].w = cvtpk(xa[6], xa[7]);
        qp[db].x = cvtpk(xb_[0], xb_[1]); qp[db].y = cvtpk(xb_[2], xb_[3]); qp[db].z = cvtpk(xb_[4], xb_[5]); qp[db].w = cvtpk(xb_[6], xb_[7]); }
    }
#pragma unroll
    for (int d0 = 0; d0 < 4; ++d0) *reinterpret_cast<u32x4*>(q2l + d0 * 1024) = qp[d0];
  }
  const int wu = __builtin_amdgcn_readfirstlane(wid);
  unsigned voffK[2], voffV[2], voffK2;
#pragma unroll
  for (int i = 0; i < 2; ++i) {
    const int blk = i * 8 + wid;
    { const int row = blk * 4 + (lane >> 4), colB = ((lane & 15) << 4) ^ ((row & 7) << 4); voffK[i] = (unsigned)(row * ldk * 2 + colB); }
    { const int st = blk * 2 + (lane >> 5), kk = (st >> 2) * 8 + ((lane & 31) >> 2), c = (st & 3) * 32 + (lane & 3) * 8;
      const int k = (kk & ~0xC) | ((kk & 4) << 1) | ((kk & 8) >> 1); voffV[i] = (unsigned)((k * ldv + c) * 2); }
  }
  { const int row = wid * 8 + (lane >> 3), colB = ((lane & 7) << 4) ^ (((row >> 1) & 7) << 4); voffK2 = (unsigned)(row * ldk2 * 2 + colB); }
  const size_t tsV = (size_t)ldv * 2, tsK = (size_t)ldk * 2, tsK2 = (size_t)ldk2 * 2;
  const int vb0 = (int)(uintptr_t)V_lds + v_rd_base(lane);
  constexpr int NDMA = (DQK == 192) ? 5 : 4;
#define DMA_K(t) do { const int b_ = (t) % 3; const char* kb_ = (const char*)Kh + (size_t)(t) * KVBLK * tsK; \
    _Pragma("unroll") for (int i = 0; i < 2; ++i) __builtin_amdgcn_global_load_lds((const unsigned*)(kb_ + voffK[i]), (LAS unsigned*)(ldsl + OFF_K + b_ * SHM_K + (i * 8 + wu) * 1024), 16, 0, 0); \
    if constexpr (DQK == 192) __builtin_amdgcn_global_load_lds((const unsigned*)((const char*)K2h + (size_t)(t) * KVBLK * tsK2 + voffK2), (LAS unsigned*)(ldsl + OFF_K2 + b_ * SHM_K2 + wu * 1024), 16, 0, 0); } while (0)
#define DMA_V(t) do { const int b_ = (t) % 3; const char* vb_ = (const char*)Vh + (size_t)(t) * KVBLK * tsV; \
    _Pragma("unroll") for (int i = 0; i < 2; ++i) __builtin_amdgcn_global_load_lds((const unsigned*)(vb_ + voffV[i]), (LAS unsigned*)(ldsl + b_ * SHM_V + (i * 8 + wu) * 1024), 16, 0, 0); } while (0)
#define RAWBAR() do { asm volatile("" ::: "memory"); __builtin_amdgcn_s_barrier(); asm volatile("" ::: "memory"); } while (0)
#define RESC(a) do { if (__any((a) < 1.f)) { if (hi == 0) al_l[r32] = (a); asm volatile("s_waitcnt lgkmcnt(0)" ::: "memory"); \
    _Pragma("unroll") for (int d = 0; d < 4; ++d) _Pragma("unroll") for (int r = 0; r < 16; ++r) o[d][r] *= al_l[crow(r, hi)]; } } while (0)
  f32x16 pA0, pA1, pB0, pB1; float mnA, mnB, alA, alB; bf16x8 pa0, pa1, pa2, pa3; const int NT = seq / KVBLK;
  int ob_prev = 0, ob_cur = 1;
#define HALF_STEP(PN0, PN1, MNN, ALN, PO0, PO1, ALO, J, FULL) do { \
    if (FULL) { DMA_K((J) + 2); DMA_V((J) + 1); } else { if ((J) + 2 < NT) DMA_K((J) + 2); if ((J) + 1 < NT) DMA_V((J) + 1); } \
    qkt<DQK>(PN0, PN1, K_lds + ob_cur * SHM_K, K2_lds + ob_cur * SHM_K2, qr, q2l, r32, hi); \
    finishSM(PO0, PO1, ALO, l_reg, pa0, pa1, pa2, pa3); \
    pv_d0(o, vb0 + ob_prev * SHM_V, pa0, pa1, pa2, pa3); partialSM(PN0, PN1, m_reg, MNN, ALN, C, thr_s); \
    RESC(ALN); \
    if (FULL) { if constexpr (NDMA == 5) asm volatile("s_waitcnt vmcnt(5)" ::: "memory"); else asm volatile("s_waitcnt vmcnt(4)" ::: "memory"); } else asm volatile("s_waitcnt vmcnt(0)" ::: "memory"); \
    RAWBAR(); \
    ob_prev = ob_cur; ob_cur = (ob_cur == 2) ? 0 : ob_cur + 1; } while (0)
  DMA_K(0); DMA_V(0); DMA_K(1);
  asm volatile("s_waitcnt vmcnt(0)" ::: "memory"); RAWBAR();
  DMA_K(2); DMA_V(1);
  qkt<DQK>(pA0, pA1, K_lds, K2_lds, qr, q2l, r32, hi); partialSM(pA0, pA1, m_reg, mnA, alA, C, thr_s);
  if constexpr (NDMA == 5) asm volatile("s_waitcnt vmcnt(5)" ::: "memory"); else asm volatile("s_waitcnt vmcnt(4)" ::: "memory");
  RAWBAR();
  for (int j = 1; j + 3 < NT; j += 2) {
    HALF_STEP(pB0, pB1, mnB, alB, pA0, pA1, alA, j, true);
    HALF_STEP(pA0, pA1, mnA, alA, pB0, pB1, alB, j + 1, true);
  }
  HALF_STEP(pB0, pB1, mnB, alB, pA0, pA1, alA, NT - 3, false);
  HALF_STEP(pA0, pA1, mnA, alA, pB0, pB1, alB, NT - 2, false);
  HALF_STEP(pB0, pB1, mnB, alB, pA0, pA1, alA, NT - 1, false);
  finishSM(pB0, pB1, alB, l_reg, pa0, pa1, pa2, pa3); SBAR();
  pv_d0(o, vb0 + ob_prev * SHM_V, pa0, pa1, pa2, pa3);
#undef HALF_STEP
#undef DMA_K
#undef DMA_V
#undef RAWBAR
  if (hi == 0) li_l[r32] = l_reg; asm volatile("s_waitcnt lgkmcnt(0)" ::: "memory");
  float rli[16];
#pragma unroll
  for (int r = 0; r < 16; ++r) rli[r] = __builtin_amdgcn_rcpf(li_l[crow(r, hi)]);
  bf16_t* Ow = Ob + (long)(wid * QBLK) * ldo;
#pragma unroll
  for (int r = 0; r < 16; ++r) { int orow = crow(r, hi);
#pragma unroll
    for (int d0 = 0; d0 < 4; ++d0) Ow[(long)orow * ldo + d0 * 32 + r32] = f2bf(o[d0][r] * rli[r]); }
#undef RESC
}
struct AttnJob { const bf16_t* Q; const bf16_t* Q2; int ldq, qhs; const bf16_t* K; int ldk, khs; long kbs; const bf16_t* K2; int ldk2; const bf16_t* V; int ldv; bf16_t* O; int H, gshift, seq, nunits; float scale; const float* qgain; const float* rsq; int qrope; };
template <int DQK, int SDEPTH>
__device__ __forceinline__ void run_attn(const AttnJob& a, char* lds, LAS unsigned char* ldsl) {
  for (int u = blockIdx.x; u < a.nunits; u += gridDim.x) {
    const int per_b = a.H * 32, b = u / per_b, rest = u - b * per_b, h = rest % a.H, qb = rest / a.H, kh = h >> a.gshift;
    const long tok0 = (long)b * SEQ + qb * 256;
    attn_body<DQK, SDEPTH>(a.Q + tok0 * a.ldq + h * a.qhs, a.Q2 + tok0 * a.ldq + h * 64, a.ldq, a.K + (long)b * a.kbs + kh * a.khs, a.ldk, a.K2 + (long)b * SEQ * a.ldk2, a.ldk2,
                           a.V + (long)b * a.kbs + kh * a.khs, a.ldv, a.O + tok0 * 1536 + h * 128, 1536, a.seq, a.scale, lds, ldsl, a.qgain, qb * 256, a.rsq ? a.rsq + tok0 : nullptr, a.qrope);
  }
}
}

__device__ __forceinline__ void rms_rows(const float* __restrict__ src, const float* __restrict__ gain, bf16_t* __restrict__ dst, int nrows) {
  const int tid_ = opaque_tid(), wid = tid_ >> 6, lane = tid_ & 63;
  for (int row = blockIdx.x * 8 + wid; row < nrows; row += gridDim.x * 8) {
    const f32x4* s = (const f32x4*)(src + (size_t)row * DM);
    f32x4 v[4]; float ss = 0.f;
#pragma unroll
    for (int j = 0; j < 4; ++j) { v[j] = s[lane + 64 * j]; ss += v[j][0] * v[j][0] + v[j][1] * v[j][1] + v[j][2] * v[j][2] + v[j][3] * v[j][3]; }
    ss = wave_sum(ss);
    const float rs = rsqrtf(ss * (1.f / DM) + EPS);
#pragma unroll
    for (int j = 0; j < 4; ++j) { const f32x4 g = ((const f32x4*)gain)[lane + 64 * j];
      u32x2 w; w.x = cvtpk(v[j][0] * rs * g[0], v[j][1] * rs * g[1]); w.y = cvtpk(v[j][2] * rs * g[2], v[j][3] * rs * g[3]);
      *(u32x2*)(dst + (size_t)row * DM + (lane + 64 * j) * 4) = w; }
  }
}
template <int MODE>
__device__ __forceinline__ void prep_w(const float* __restrict__ src, int K, int Nsrc, bf16_t* __restrict__ dst, int Ndst, const float* __restrict__ kgain) {
  const long total = (long)Ndst * (K / 8);
  for (long i = (long)blockIdx.x * 512 + opaque_tid(); i < total; i += (long)gridDim.x * 512) {
    const long i8 = i >> 3; const int n = (int)(i8 % Ndst), k8 = (int)(i8 / Ndst) * 8 + (int)(i & 7);
    int ns = n;
    if (MODE == 1) { const int pn = n >> 8, r = n & 255, bj = r >> 7, ii = r & 127; ns = bj * DFF + pn * 128 + ii; }
    if (MODE == 2) { ns = n < 640 ? n : (n < 1152 ? n + 64 : (n < 1216 ? n - 512 : Nsrc)); }
    if (MODE == 3) { ns = n < 1024 ? (n >> 7) * 192 + (n & 127) : ((n - 1024) >> 6) * 192 + 128 + ((n - 1024) & 63); }
    float x[8];
#pragma unroll
    for (int j = 0; j < 8; ++j) x[j] = (ns < Nsrc) ? src[(size_t)(k8 * 8 + j) * Nsrc + ns] : 0.f;
    if (kgain) {
#pragma unroll
      for (int j = 0; j < 8; ++j) x[j] *= kgain[k8 * 8 + j];
    }
    u32x4 w; w.x = cvtpk(x[0], x[1]); w.y = cvtpk(x[2], x[3]); w.z = cvtpk(x[4], x[5]); w.w = cvtpk(x[6], x[7]);
    *(u32x4*)(dst + (size_t)n * K + k8 * 8) = w;
  }
}
__device__ __forceinline__ void unpack8(u32x4 w, float* v) {
#pragma unroll
  for (int i = 0; i < 4; ++i) { v[2 * i] = __uint_as_float(w[i] << 16); v[2 * i + 1] = __uint_as_float(w[i] & 0xffff0000u); }
}
__device__ __forceinline__ u32x4 pack8(const float* v) { u32x4 w; w.x = cvtpk(v[0], v[1]); w.y = cvtpk(v[2], v[3]); w.z = cvtpk(v[4], v[5]); w.w = cvtpk(v[6], v[7]); return w; }
__device__ __forceinline__ float sumsq8(const float* v) { float s = 0.f;
#pragma unroll
  for (int j = 0; j < 8; ++j) s += v[j] * v[j];
  return s; }
template <int GL> __device__ __forceinline__ float group_sum(float s) {
#pragma unroll
  for (int o = 1; o < GL; o <<= 1) s += __shfl_xor(s, o, 64);
  return s;
}
__device__ __forceinline__ void load8(float* g, const float* __restrict__ p) { const f32x4 a = *(const f32x4*)p, b = *(const f32x4*)(p + 4);
  g[0] = a[0]; g[1] = a[1]; g[2] = a[2]; g[3] = a[3]; g[4] = b[0]; g[5] = b[1]; g[6] = b[2]; g[7] = b[3]; }
template <int GL> __device__ __forceinline__ void norm8(float* v, const float* g) {
  const float ss = group_sum<GL>(sumsq8(v)); const float rs = rsqrtf(ss * (1.f / (GL * 8)) + EPS);
#pragma unroll
  for (int j = 0; j < 8; ++j) v[j] *= rs * g[j];
}
template <int XM> __device__ __forceinline__ void rope8(float* v, const float* inv, float pos, bool first) {
#pragma unroll
  for (int j = 0; j < 8; ++j) {
    const float partner = __shfl_xor(v[j], XM, 64);
    float rev = pos * inv[j] * INV2PI; rev -= floorf(rev);
    const float c = __builtin_amdgcn_cosf(rev), s = __builtin_amdgcn_sinf(rev);
    v[j] = first ? v[j] * c - partner * s : v[j] * c + partner * s;
  }
}
template <int NE> __device__ __forceinline__ void ld_seg(float* v, const bf16_t* p, int lane) {
#pragma unroll
  for (int j = 0; j < NE; ++j) v[j] = bf2f(p[lane + 64 * j]);
}
template <int NE> __device__ __forceinline__ void st_seg(const float* v, bf16_t* p, int lane) {
#pragma unroll
  for (int j = 0; j < NE; ++j) p[lane + 64 * j] = f2bf(v[j]);
}
template <int NE, int ROPE> __device__ __forceinline__ void norm_seg(float* v, const float* __restrict__ gain, int lane, int prow, int pcol) {
  float ss = 0.f;
#pragma unroll
  for (int j = 0; j < NE; ++j) ss += v[j] * v[j];
  ss = wave_sum(ss);
  const float rs = rsqrtf(ss * (1.f / (64 * NE)) + EPS);
#pragma unroll
  for (int j = 0; j < NE; ++j) v[j] = v[j] * rs * gain[lane + 64 * j];
  if constexpr (ROPE && NE == 2) {
    const int f = lane & 31; const float inv = exp2f(-(float)(2 * f) * (1.f / 64.f) * LOG2_THETA);
#pragma unroll
    for (int j = 0; j < 2; ++j) {
      const float partner = __shfl_xor(v[j], 32, 64);
      const float ang = (float)(j == 0 ? prow : pcol) * inv;
      float rev = ang * INV2PI; rev -= floorf(rev);
      const float c = __builtin_amdgcn_cosf(rev), s = __builtin_amdgcn_sinf(rev);
      v[j] = (lane < 32) ? v[j] * c - partner * s : v[j] * c + partner * s;
    }
  }
  if constexpr (ROPE && NE == 1) {
    const int f = lane & 15; const float inv = exp2f(-(float)(2 * f) * (1.f / 32.f) * LOG2_THETA);
    const float partner = __shfl_xor(v[0], 16, 64);
    const float ang = (float)(lane < 32 ? prow : pcol) * inv;
    float rev = ang * INV2PI; rev -= floorf(rev);
    const float c = __builtin_amdgcn_cosf(rev), s = __builtin_amdgcn_sinf(rev);
    v[0] = (lane & 16) ? v[0] * c + partner * s : v[0] * c - partner * s;
  }
}

#define XB_TMO      128
#define XB_XCNT(j)  (256  + 64 * (j))
#define XB_XSUB(j)  (1280 + 64 * (j))
#define XB_XGEN(j)  (2304 + 64 * (j))
#define XB_TOP      3328
#define XB_TOPGEN   3392
#define XCD_BAR_WORDS 3456
#define XB_SPIN_CAP (1u << 22)
__device__ __forceinline__ unsigned xb_ld(unsigned* p)              { return __hip_atomic_load(p, __ATOMIC_RELAXED, __HIP_MEMORY_SCOPE_AGENT); }
__device__ __forceinline__ unsigned xb_add(unsigned* p, unsigned v) { return __hip_atomic_fetch_add(p, v, __ATOMIC_RELAXED, __HIP_MEMORY_SCOPE_AGENT); }
__device__ __forceinline__ unsigned xb_xcc_id() { return (unsigned)__builtin_amdgcn_s_getreg((3 << 11) | 20) & 0xFu; }
#define XB_SPIN(cond, bar) do { unsigned _sp = 0; while (cond) { __builtin_amdgcn_s_sleep(1); \
    if ((++_sp & 255u) == 0u) { if (xb_ld(&(bar)[XB_TMO])) break; if (_sp > XB_SPIN_CAP) { atomicAdd(&(bar)[XB_TMO], 1u); break; } } } } while (0)
struct XcdBarrier { unsigned* bar; unsigned x; volatile LAS unsigned* st; };
__device__ __forceinline__ XcdBarrier xcd_barrier_post(unsigned* bar, volatile LAS unsigned* st) {
  XcdBarrier b; b.bar = bar; b.x = xb_xcc_id(); b.st = st;
  if (threadIdx.x == 0) (void)xb_add(&bar[XB_XCNT(b.x)], 1u);
  return b;
}
__device__ __forceinline__ void xcd_barrier_complete(unsigned* bar, unsigned x, unsigned& nloc, unsigned& nx) {
  const unsigned G = gridDim.x * gridDim.y * gridDim.z;
  unsigned sum, cnt, mine, sp = 0u;
  for (;;) {
    sum = 0u; cnt = 0u; mine = 0u;
#pragma unroll
    for (unsigned j = 0; j < 16; ++j) { const unsigned c = xb_ld(&bar[XB_XCNT(j)]); sum += c; cnt += (c > 0u) ? 1u : 0u; mine = (j == x) ? c : mine; }
    if (sum == G) break;
    __builtin_amdgcn_s_sleep(1);
    if ((++sp & 255u) == 0u) { if (xb_ld(&bar[XB_TMO])) break; if (sp > XB_SPIN_CAP) { atomicAdd(&bar[XB_TMO], 1u); break; } }
  }
  nloc = mine > 0u ? mine : 1u; nx = cnt > 0u ? cnt : 1u;
}
__device__ __forceinline__ void xcd_barrier(const XcdBarrier& b) {
  asm volatile("s_waitcnt vmcnt(0)" ::: "memory");
  __syncthreads();
  if (threadIdx.x == 0) {
    unsigned* bar = b.bar;
    __builtin_amdgcn_s_waitcnt(0);
    unsigned nloc = b.st[0], nx = b.st[1];
    if (nloc == 0u) { xcd_barrier_complete(bar, b.x, nloc, nx); b.st[0] = nloc; b.st[1] = nx; }
    const unsigned old = xb_add(&bar[XB_XSUB(b.x)], 1u);
    const unsigned gen = old / nloc;
    if (old + 1u == (gen + 1u) * nloc) {
      __builtin_amdgcn_fence(__ATOMIC_RELEASE, "agent");
      asm volatile("s_waitcnt vmcnt(0)" ::: "memory");
      const unsigned og = xb_add(&bar[XB_TOP], 1u);
      const unsigned tg = og / nx;
      if (og + 1u == (tg + 1u) * nx) xb_add(&bar[XB_TOPGEN], 1u);
      else XB_SPIN(xb_ld(&bar[XB_TOPGEN]) == tg, bar);
      __builtin_amdgcn_fence(__ATOMIC_ACQUIRE, "agent");
      xb_add(&bar[XB_XGEN(b.x)], 1u);
      asm volatile("s_waitcnt vmcnt(0)" ::: "memory");
    } else {
      XB_SPIN(xb_ld(&bar[XB_XGEN(b.x)]) == gen, bar);
      __builtin_amdgcn_fence(__ATOMIC_ACQUIRE, "agent");
      asm volatile("s_waitcnt vmcnt(0)" ::: "memory");
    }
  }
  __syncthreads();
}

constexpr int LDS_MAIN = att::SHM_ATTN > pg8::STAGE_BYTES ? att::SHM_ATTN : pg8::STAGE_BYTES;
constexpr int LDS_BYTES = LDS_MAIN + 16;
static_assert(att::SHM_ATTN <= LDS_MAIN, "lds");
constexpr int NPHASE = 18;
#ifndef PHMASK
#define PHMASK 0xf
#endif
#ifndef STAG_GU
#define STAG_GU 0
#endif
#ifndef REPMASK
#define REPMASK 0
#endif
#ifndef A128_SD
#define A128_SD 1
#endif
#ifndef KARG
#define KARG 0
#endif
#define wt_in0 ((bf16_t*)(p.ws + WS_WT_IN0))
#define wt_qb ((bf16_t*)(p.ws + WS_WT_QB))
#define wt_kvb ((bf16_t*)(p.ws + WS_WT_KVB))
#define wt_out ((bf16_t*)(p.ws + WS_WT_OUT))
#define wt_memkv ((bf16_t*)(p.ws + WS_WT_MEMKV))
#define wt_gu ((bf16_t*)(p.ws + WS_WT_GU))
#define wt_dn ((bf16_t*)(p.ws + WS_WT_DN))
#define wt_in1 ((bf16_t*)(p.ws + WS_WT_IN1))
#define memn ((bf16_t*)(p.ws + WS_MEMN))
#define memkv ((bf16_t*)(p.ws + WS_MEMKV))
#define hbuf ((bf16_t*)(p.ws + WS_HM))
#define mix ((bf16_t*)(p.ws + WS_HM))
#define proj ((bf16_t*)(p.ws + WS_R))
#define act ((bf16_t*)(p.ws + WS_R))
#define qbuf ((bf16_t*)(p.ws + WS_Q))
#define kvbuf ((bf16_t*)(p.ws + WS_KV))

struct GemmJob { const bf16_t* A; int lda; const bf16_t* Bt; int M, N, K; int kind; bf16_t* O; int ldc; const float* res; int coff; const float* rs_in; float* rs_out; int stag; float inv_n; float* csq; float* ckv; int nt; };

__device__ __forceinline__ int gemm_jobs(const Params& p, int ph, int gi, GemmJob& j) {
  const float* x = p.in[0];
  j.M = NTOK; j.res = nullptr; j.coff = 0; j.O = nullptr; j.ldc = 0; j.rs_in = nullptr; j.rs_out = nullptr; j.stag = 0; j.inv_n = 1.f / DM; j.csq = nullptr; j.ckv = nullptr; j.nt = 0;
  float* rowss = (float*)(p.ws + WS_ROWSS); bf16_t* xbuf = (bf16_t*)(p.ws + WS_XB);
  switch (ph) {
  case 1:
    if (gi == 0) { j.A = hbuf; j.lda = 1024; j.Bt = wt_in0; j.N = 1280; j.K = 1024; j.kind = 0; j.O = proj; j.ldc = 1280; j.csq = rowss + 3 * (size_t)NTOK; j.ckv = rowss + 4 * (size_t)NTOK; }
    else { j.A = memn; j.lda = 1024; j.Bt = wt_memkv + (size_t)(gi - 1) * 1024 * 1024; j.M = NMEMROWS; j.N = 1024; j.K = 1024; j.kind = 0; j.O = memkv + (size_t)(gi - 1) * NMEMROWS * 1024; j.ldc = 1024; j.coff = (gi - 1) * 128; }
    return 3;
  case 3:
    if (gi == 0) { j.A = proj; j.lda = 1280; j.Bt = wt_qb; j.N = 1536; j.K = 384; j.kind = 0; j.O = qbuf; j.ldc = 1536; j.rs_in = rowss + 3 * (size_t)NTOK; j.inv_n = 1.f / 384.f; j.nt = 1; }
    else { j.A = proj + 384; j.lda = 1280; j.Bt = wt_kvb; j.N = 2048; j.K = 256; j.kind = 0; j.O = kvbuf; j.ldc = 2048; j.rs_in = rowss + 4 * (size_t)NTOK; j.inv_n = 1.f / 256.f; j.nt = 1; }
    return 2;
  case 6: case 14: { const int L = ph == 6 ? 0 : 1;
    j.A = mix; j.lda = 1536; j.Bt = wt_out + (size_t)L * 1024 * 1536; j.N = 1024; j.K = 1536; j.kind = 1; j.res = L == 0 ? x : p.out; j.rs_out = rowss + (size_t)(L == 0 ? 0 : 2) * NTOK; j.O = xbuf; return 1; }
  case 8: case 16: { const int L = ph == 8 ? 0 : 1;
    j.A = xbuf; j.lda = 1024; j.Bt = wt_gu + (size_t)L * 5632 * 1024; j.N = 5632; j.K = 1024; j.kind = 2; j.O = act; j.rs_in = rowss + (size_t)(L == 0 ? 0 : 2) * NTOK; j.stag = STAG_GU; return 1; }
  case 9: case 17: { const int L = ph == 9 ? 0 : 1;
    j.A = act; j.lda = DFF; j.Bt = wt_dn + (size_t)L * 1024 * 2816; j.N = 1024; j.K = DFF; j.kind = 1; j.res = p.out; if (L == 0) { j.rs_out = rowss + (size_t)NTOK; j.O = xbuf; } return 1; }
  case 11:
    j.A = xbuf; j.lda = 1024; j.Bt = wt_in1; j.N = 2048; j.K = 1024; j.kind = 0; j.O = proj; j.ldc = 2048; j.rs_in = rowss + (size_t)NTOK; return 1;
  default: return 0;
  }
}

__global__ __launch_bounds__(512) void mega(Params p_) {
  extern __shared__ __attribute__((aligned(16))) unsigned char shm[];
  LAS unsigned char* glds = (LAS unsigned char*)shm;
  char* alds = (char*)shm;
  const Params* pp = (const Params*)__builtin_amdgcn_kernarg_segment_ptr();
  const int ph_lo = p_.ph_lo, ph_hi = p_.ph_hi;
  volatile LAS unsigned* bst = (volatile LAS unsigned*)(glds + LDS_MAIN);
  if (threadIdx.x == 0) { bst[0] = 0u; bst[1] = 0u; }
  __syncthreads();
  const XcdBarrier xb = xcd_barrier_post((unsigned*)(p_.ws + WS_BAR), bst);
  if (ph_lo < 0) cg::this_grid().sync();

  for (int ph = ph_lo; ph < ph_hi; ++ph) {
    if (ph == 2 || ph == 7 || ph == 10 || ph == 15) continue;
#if KARG
    asm volatile("" : "+s"(pp));
    const Params& p = *pp;
#else
    const Params& p = p_;
#endif
    const float* x = p.in[0];
    for (int rep = 0; rep < 1 + ((REPMASK >> ph) & 1); ++rep) {
    const int tid_ = opaque_tid(), wid = tid_ >> 6, lane = tid_ & 63;
    const int gw = blockIdx.x * 8 + wid, nw = gridDim.x * 8;
    if (PHMASK & 1) switch (ph) {
    case 0: {
      prep_w<2>(p.in[11], 1024, 1216, wt_in0, 1280, nullptr);
      prep_w<3>(p.in[13], 384, 1536, wt_qb, 1536, p.in[12]);
      prep_w<0>(p.in[15], 256, 2048, wt_kvb, 2048, p.in[14]);
      for (int i = 0; i < 2; ++i) {
        prep_w<0>(p.in[5] + (size_t)i * 1536 * 1024, 1536, 1024, wt_out + (size_t)i * 1024 * 1536, 1024, nullptr);
        prep_w<0>(p.in[6] + (size_t)i * 1024 * 1024, 1024, 1024, wt_memkv + (size_t)i * 1024 * 1024, 1024, nullptr);
        prep_w<1>(p.in[9] + (size_t)i * 1024 * 5632, 1024, 5632, wt_gu + (size_t)i * 5632 * 1024, 5632, p.in[4] + i * 1024);
        prep_w<0>(p.in[10] + (size_t)i * 2816 * 1024, 2816, 1024, wt_dn + (size_t)i * 1024 * 2816, 1024, nullptr);
      }
      prep_w<0>(p.in[18], 1024, 2048, wt_in1, 2048, p.in[3] + 1024);
      for (int i = blockIdx.x * 512 + tid_; i < 5 * NTOK; i += gridDim.x * 512) ((float*)(p.ws + WS_ROWSS))[i] = 0.f;
      rms_rows(p.in[1], p.in[2], memn, NMEMROWS);
      rms_rows(x, p.in[3], hbuf, NTOK);
    } break;
    case 4: {
      const int l16 = lane & 15, l8 = lane & 7;
      float inv64[8], g_kn[8], g_kp[8];
#pragma unroll
      for (int j = 0; j < 8; ++j) inv64[j] = exp2f(-(float)(2 * ((l8 & 1) * 8 + j)) * (1.f / 32.f) * LOG2_THETA);
      load8(g_kn, p.in[17] + l16 * 8); load8(g_kp, p.in[17] + 128 + l8 * 8);
      const bool first64 = !(l8 & 2);
      const bool is_k = !((lane >> 4) & 1);
      for (int t = gw; t < NTOK; t += nw) {
        const int sq = t & (SEQ - 1); const float pos64 = (float)((l8 < 4) ? (sq >> 6) : (sq & 63));
        bf16_t* pr = proj + (size_t)t * 1280 + lane * 8; bf16_t* kvrow = kvbuf + (size_t)t * 2048 + lane * 8;
        const bool dry = ((REPMASK >> 4) & 1) && rep == 0; bf16_t* kvdst = dry ? (bf16_t*)p.out + (size_t)t * 2048 + lane * 8 : kvrow;
        u32x4 P2 = {0u, 0u, 0u, 0u}; if (lane >= 16 && lane < 24) P2 = *(const u32x4*)(pr + 1024);
        u32x4 KV0 = P2, KV1 = P2, KV2 = P2, KV3 = P2;
        if (is_k) { KV0 = *(const u32x4*)kvrow; KV1 = *(const u32x4*)(kvrow + 512); KV2 = *(const u32x4*)(kvrow + 1024); KV3 = *(const u32x4*)(kvrow + 1536); }
        float a[8], b[8];
        unpack8(P2, a);
        { const float s8 = group_sum<8>(sumsq8(a)); const float rsB = rsqrtf(s8 * (1.f / 64.f) + EPS);
#pragma unroll
          for (int j = 0; j < 8; ++j) b[j] = a[j] * rsB * g_kp[j];
          rope8<2>(b, inv64, pos64, first64);
          if (lane >= 16 && lane < 24 && !dry) *(u32x4*)(pr + 1024) = pack8(b); }
#define KCHUNK(W, OFF) do { unpack8(W, a); norm8<16>(a, g_kn); if (is_k) *(u32x4*)(kvdst + (OFF)) = pack8(a); } while (0)
        KCHUNK(KV0, 0); KCHUNK(KV1, 512); KCHUNK(KV2, 1024); KCHUNK(KV3, 1536);
#undef KCHUNK
      }
      if (!(((REPMASK >> 4) & 1) && rep == 0)) for (int r = gw; r < 2 * NMEMROWS; r += nw) {
        float g_mk[8]; load8(g_mk, p.in[8] + (r / NMEMROWS) * 128 + l16 * 8);
        bf16_t* row = memkv + (size_t)r * 1024 + lane * 8;
        float a[8]; unpack8(*(const u32x4*)row, a); norm8<16>(a, g_mk); *(u32x4*)row = pack8(a);
      }
    } break;
    case 7: case 15: rms_rows(p.out, p.in[4] + (ph == 7 ? 0 : 1024), hbuf, NTOK); break;
    case 10: rms_rows(p.out, p.in[3] + 1024, hbuf, NTOK); break;
    case 12: {
      const int l16 = lane & 15;
      float inv128[8], g_k[8];
#pragma unroll
      for (int j = 0; j < 8; ++j) inv128[j] = exp2f(-(float)(2 * ((l16 & 3) * 8 + j)) * (1.f / 64.f) * LOG2_THETA);
      load8(g_k, p.in[20] + l16 * 8);
      const bool first128 = !(l16 & 4);
      for (int t = gw; t < NTOK; t += nw) {
        const int sq = t & (SEQ - 1); const float pos128 = (float)((l16 < 8) ? (sq >> 6) : (sq & 63));
        bf16_t* row = proj + (size_t)t * 2048 + lane * 8;
        bf16_t* dst = (((REPMASK >> 12) & 1) && rep == 0) ? row + 128ull * MiB : row;
        const u32x4 W2 = *(const u32x4*)(row + 1024);
        float a[8];
        unpack8(W2, a); norm8<16>(a, g_k); rope8<4>(a, inv128, pos128, first128); if (lane < 32) *(u32x4*)(dst + 1024) = pack8(a);
      }
    } break;
    default: break;
    }
    if (PHMASK & 2) {
      GemmJob j; const int ng = gemm_jobs(p, ph, 0, j);
      for (int gi = 0; gi < ng; ++gi) {
        if (gi) gemm_jobs(p, ph, gi, j);
        if (j.kind == 0) pg8::run_gemm(glds, j.A, j.lda, j.Bt, j.M, j.N, j.K, pg8::EpiBf16{j.O, j.ldc, j.rs_in, j.inv_n, j.csq, j.ckv, j.nt}, j.coff, j.stag);
        else if (j.kind == 1) pg8::run_gemm(glds, j.A, j.lda, j.Bt, j.M, j.N, j.K, pg8::EpiResF32{p.out, j.res, j.rs_out ? j.O : nullptr, j.rs_out}, j.coff, j.stag);
        else pg8::run_gemm(glds, j.A, j.lda, j.Bt, j.M, j.N, j.K, pg8::EpiSwiGLU{j.O, j.rs_in}, j.coff, j.stag);
      }
    }
    if ((PHMASK & 12) && (ph == 5 || ph == 13)) {
      const int L = ph == 5 ? 0 : 1;
      att::AttnJob a; a.qgain = nullptr; a.rsq = nullptr; a.qrope = 1;
      if (L == 0) {
        a.Q = qbuf; a.Q2 = qbuf + 1024; a.ldq = 1536; a.qhs = 128; a.K = kvbuf; a.ldk = 2048; a.khs = 256; a.kbs = (long)SEQ * 2048; a.K2 = proj + 1152; a.ldk2 = 1280;
        a.V = kvbuf + 128; a.ldv = 2048; a.O = mix; a.H = 8; a.gshift = 0; a.seq = SEQ; a.nunits = 2048; a.scale = 0.072168783648703220f; a.qgain = p.in[16];
        if (PHMASK & 4) att::run_attn<192, 1>(a, alds, glds);
      } else {
        a.Q = proj; a.Q2 = proj; a.ldq = 2048; a.qhs = 128; a.K = proj + 1024; a.ldk = 2048; a.khs = 128; a.kbs = (long)SEQ * 2048; a.K2 = proj; a.ldk2 = 0;
        a.V = proj + 1280; a.ldv = 2048; a.O = mix; a.H = 8; a.gshift = 2; a.seq = SEQ; a.nunits = 2048; a.scale = 0.088388347648318440f; a.qgain = p.in[19];
      }
      for (int pass = (L == 0 ? 1 : 0); pass < 2; ++pass) {
        if (pass == 1) {
          a.Q = L == 0 ? proj + 640 : proj + 1536; a.Q2 = a.Q; a.ldq = L == 0 ? 1280 : 2048; a.qhs = 128;
          a.K = memkv + (size_t)L * NMEMROWS * 1024; a.ldk = 1024; a.khs = 128; a.kbs = 256 * 1024; a.K2 = a.K; a.ldk2 = 0;
          a.V = a.K + 512; a.ldv = 1024; a.O = mix + 1024; a.H = 4; a.gshift = 0; a.seq = 256; a.nunits = 1024; a.scale = 0.088388347648318440f; a.qgain = p.in[7] + L * 128; a.qrope = 0;
        }
        if (PHMASK & 8) att::run_attn<128, A128_SD>(a, alds, glds);
      }
    }
    }
    if (ph + 1 < ph_hi) xcd_barrier(xb);
  }
}

extern "C" void kernel_launch(void* const* d_in, const int* in_sizes, int n_in, void* d_out, int out_size, void* d_ws, size_t ws_size, hipStream_t stream) {
  static int grid = 0;
  if (grid == 0) {
    if (n_in != 21 || in_sizes[0] != NTOK * DM || out_size != NTOK * DM || ws_size < WS_END) {
      fprintf(stderr, "kernel_launch: shape/workspace mismatch (n_in %d, in0 %d, out %d, ws %zu, need %zu)\n", n_in, n_in > 0 ? in_sizes[0] : -1, out_size, ws_size, (size_t)WS_END);
      grid = -1; return; }
    int dev = 0, cus = 0, per_cu = 0;
    (void)hipGetDevice(&dev); (void)hipDeviceGetAttribute(&cus, hipDeviceAttributeMultiprocessorCount, dev);
    if (hipFuncSetAttribute((const void*)mega, hipFuncAttributeMaxDynamicSharedMemorySize, LDS_BYTES) != hipSuccess) { fprintf(stderr, "kernel_launch: hipFuncSetAttribute failed\n"); grid = -1; return; }
    if (hipOccupancyMaxActiveBlocksPerMultiprocessor(&per_cu, (const void*)mega, 512, LDS_BYTES) != hipSuccess || per_cu < 1) { fprintf(stderr, "kernel_launch: occupancy query says %d\n", per_cu); per_cu = 1; }
    (void)hipGetLastError();
    grid = cus * 1;
    if (grid <= 0) grid = 256;
  }
  if (grid < 0) return;
  if (hipMemsetAsync((char*)d_ws + WS_BAR, 0, XCD_BAR_WORDS * 4, stream) != hipSuccess) { fprintf(stderr, "kernel_launch: memset of barrier words failed\n"); return; }
  Params p{};
  for (int i = 0; i < 21; ++i) p.in[i] = (const float*)d_in[i];
  p.out = (float*)d_out; p.ws = (unsigned char*)d_ws;
#if MK_ONE_LAUNCH
  p.ph_lo = 0; p.ph_hi = NPHASE;
  void* args[] = {&p};
  hipError_t e = hipLaunchCooperativeKernel((const void*)mega, dim3(grid), dim3(512), args, LDS_BYTES, stream);
  if (e != hipSuccess) fprintf(stderr, "kernel_launch: cooperative launch failed: %s (grid %d)\n", hipGetErrorString(e), grid);
#else
  for (int ph = 0; ph < NPHASE; ++ph) {
    p.ph_lo = ph; p.ph_hi = ph + 1;
    hipLaunchKernelGGL(mega, dim3(grid), dim3(512), LDS_BYTES, stream, p);
  }
#endif
}
```

```cpp
#include <hip/hip_runtime.h>
#include <hip/hip_cooperative_groups.h>
#include <cstdio>
#include <cstdint>
namespace cg = cooperative_groups;

#ifndef MK_ONE_LAUNCH
#define MK_ONE_LAUNCH 1
#endif

typedef unsigned short bf16_t;
typedef short bf16x8 __attribute__((ext_vector_type(8)));
typedef short s16x4 __attribute__((ext_vector_type(4)));
typedef float f32x4 __attribute__((ext_vector_type(4)));
typedef float f32x16 __attribute__((ext_vector_type(16)));
typedef unsigned u32x4 __attribute__((ext_vector_type(4)));
typedef unsigned u32x2 __attribute__((ext_vector_type(2)));
#define LAS __attribute__((address_space(3)))

constexpr int NTOK = 65536, SEQ = 8192, DM = 1024, DFF = 2816, NMEMROWS = 2048;
constexpr float EPS = 1e-6f;
constexpr float LOG2_THETA = 13.287712379549449f;
constexpr float INV2PI = 0.15915494309189535f;
constexpr size_t MiB = 1ull << 20;
constexpr size_t WS_WT_IN0 = 0;
constexpr size_t WS_WT_QB = WS_WT_IN0 + 1280ull * 1024 * 2;
constexpr size_t WS_WT_KVB = WS_WT_QB + 1536ull * 384 * 2;
constexpr size_t WS_WT_OUT = WS_WT_KVB + 2048ull * 256 * 2;
constexpr size_t WS_WT_MEMKV = WS_WT_OUT + 2ull * 1024 * 1536 * 2;
constexpr size_t WS_WT_GU = WS_WT_MEMKV + 2ull * 1024 * 1024 * 2;
constexpr size_t WS_WT_DN = WS_WT_GU + 2ull * 5632 * 1024 * 2;
constexpr size_t WS_WT_IN1 = WS_WT_DN + 2ull * 1024 * 2816 * 2;
constexpr size_t WS_WT_END = WS_WT_IN1 + 2048ull * 1024 * 2;
static_assert(WS_WT_END <= 56 * MiB, "weights region");
constexpr size_t WS_MEMN = 56 * MiB;
constexpr size_t WS_MEMKV = 60 * MiB;
constexpr size_t WS_BAR = 70 * MiB;
constexpr size_t WS_ROWSS = 70 * MiB + 65536;
constexpr size_t WS_HM = 72 * MiB;
constexpr size_t WS_R = 264 * MiB;
constexpr size_t WS_Q = WS_R + 160 * MiB;
constexpr size_t WS_KV = WS_Q + 192 * MiB;
constexpr size_t WS_XB = WS_R + 352 * MiB;
constexpr size_t WS_END = WS_KV + 256 * MiB;

struct Params { const float* in[21]; float* out; unsigned char* ws; int ph_lo, ph_hi; };

__device__ __forceinline__ float bf2f(bf16_t v) { return __uint_as_float(((unsigned)v) << 16); }
__device__ __forceinline__ bf16_t f2bf(float f) { unsigned u = __float_as_uint(f); u += 0x7FFFu + ((u >> 16) & 1u); return (bf16_t)(u >> 16); }
__device__ __forceinline__ unsigned cvtpk(float lo, float hi) { unsigned r; asm volatile("v_cvt_pk_bf16_f32 %0, %1, %2" : "=v"(r) : "v"(lo), "v"(hi)); return r; }
__device__ __forceinline__ float wave_sum(float v) {
#pragma unroll
  for (int o = 32; o > 0; o >>= 1) v += __shfl_xor(v, o, 64);
  return v;
}

__device__ __forceinline__ int opaque_tid() { int t = threadIdx.x; asm volatile("" : "+v"(t)); return t; }

namespace pg8 {
constexpr int BM = 256, BK = 64, HALF = 128, HTB = HALF * BK * 2, STAGE_BYTES = 8 * HTB, NXCD = 8, WGM = 4;
__device__ __forceinline__ int lds_byte(int r, int c) { const int st = (r >> 4) * 2 + (c >> 5), rr = r & 15, cc = c & 31, ob = rr * 64 + cc * 2; return st * 1024 + (ob ^ (((ob >> 9) & 1) << 5)); }
__device__ __forceinline__ void stage_rc(int b, int& R, int& C) { const int st = b / 1024, sb = b % 1024, swz = sb ^ (((sb >> 9) & 1) << 5); R = (st >> 1) * 16 + swz / 64; C = (st & 1) * 32 + (swz % 64) / 2; }
__device__ __forceinline__ int perm32(int rho) { const int n = rho >> 4, i = rho & 15; return 8 * (i >> 2) + 4 * n + (i & 3); }
struct Unit { int pm, pn; };
struct Gemm { const bf16_t* A; const bf16_t* Bt; int M, N, K, lda; };
struct StaticOrder {
  int nM, nN, nwg, G, c;
  __device__ void init(int M, int N, int G_, int c_) { nM = M / BM; nN = N / BM; nwg = nM * nN; G = G_; c = c_; }
  __device__ bool next(int i, Unit& u) const {
    const long L = (long)i * G + c; if (L >= nwg) return false;
    int wgid = (int)L; { const int q = nwg / NXCD, r = nwg % NXCD, xcd = wgid % NXCD, off = wgid / NXCD; wgid = (xcd < r ? xcd * (q + 1) : r * (q + 1) + (xcd - r) * q) + off; }
    const int nig = WGM * nN, gid = wgid / nig, fm = gid * WGM, gsz = (nM - fm) < WGM ? (nM - fm) : WGM;
    u.pm = fm + ((wgid % nig) % gsz); u.pn = (wgid % nig) / gsz; return true;
  }
};

struct EpiBf16 {
  static constexpr bool PERM = true;
  bf16_t* O; int ldc; const float* rowss; float inv_n; float* csq; float* ckv;
  __device__ __forceinline__ void pre(const Unit& u, int wr, int fr, float (&rsv)[2][4]) const {
    const int row0 = u.pm * BM + wr * 64 + fr;
#pragma unroll
    for (int ai = 0; ai < 2; ++ai)
#pragma unroll
      for (int m = 0; m < 4; ++m) rsv[ai][m] = rowss ? rowss[row0 + ai * HALF + m * 16] : 0.f;
  }
  __device__ __forceinline__ void operator()(const f32x4 (&acc)[2][2][4][2], const Unit& u, int wr, int wc, int fr, int fq, const float (&rsv)[2][4]) const {
    const int row0 = u.pm * BM + wr * 64 + fr, col0 = u.pn * BM + wc * 32 + 8 * fq;
    float* tgt0 = nullptr; float* tgt1 = nullptr;
    if (csq) { if (u.pn == 0) { tgt0 = csq; tgt1 = csq; } else if (u.pn == 1) { tgt0 = csq; tgt1 = ckv; } else if (u.pn == 2) { tgt0 = ckv; } }
#pragma unroll
    for (int ai = 0; ai < 2; ++ai)
#pragma unroll
      for (int m = 0; m < 4; ++m) { const int row = row0 + ai * HALF + m * 16; bf16_t* rowp = O + (size_t)row * ldc + col0;
        const float rs = rowss ? rsqrtf(rsv[ai][m] * inv_n + EPS) : 1.f;
#pragma unroll
        for (int bj = 0; bj < 2; ++bj) { const f32x4 v0 = acc[ai][bj][m][0] * rs, v1 = acc[ai][bj][m][1] * rs;
          u32x4 w; w.x = cvtpk(v0[0], v0[1]); w.y = cvtpk(v0[2], v0[3]); w.z = cvtpk(v1[0], v1[1]); w.w = cvtpk(v1[2], v1[3]);
          *(u32x4*)(rowp + bj * HALF) = w;
          float* tg = bj ? tgt1 : tgt0;
          if (tg) { float ss = v0[0] * v0[0] + v0[1] * v0[1] + v0[2] * v0[2] + v0[3] * v0[3] + v1[0] * v1[0] + v1[1] * v1[1] + v1[2] * v1[2] + v1[3] * v1[3];
            ss += __shfl_xor(ss, 16, 64); ss += __shfl_xor(ss, 32, 64); if (fq == 0) unsafeAtomicAdd(tg + row, ss); } } }
  }
};
struct EpiResF32 {
  static constexpr bool PERM = false;
  float* out; const float* res; bf16_t* xb; float* rowss;
  __device__ __forceinline__ void pre(const Unit&, int, int, float (&)[2][4]) const {}
  __device__ __forceinline__ void operator()(const f32x4 (&acc)[2][2][4][2], const Unit& u, int wr, int wc, int fr, int fq, const float (&)[2][4]) const {
    const int row0 = u.pm * BM + wr * 64 + fr, col0 = u.pn * BM + wc * 32 + 4 * fq;
    f32x4 r[2][2][2][2];
#define ER_LOAD(buf, ai, mp) do { _Pragma("unroll") for (int mm = 0; mm < 2; ++mm) { const size_t off = (size_t)(row0 + (ai) * HALF + ((mp) + mm) * 16) * DM + col0; \
      _Pragma("unroll") for (int bj = 0; bj < 2; ++bj) _Pragma("unroll") for (int n = 0; n < 2; ++n) r[buf][mm][bj][n] = *(const f32x4*)(res + off + bj * HALF + n * 16); } } while (0)
#define ER_STORE(buf, ai, mp) do { _Pragma("unroll") for (int mm = 0; mm < 2; ++mm) { const int row = row0 + (ai) * HALF + ((mp) + mm) * 16; const size_t off = (size_t)row * DM + col0; float ss = 0.f; \
      _Pragma("unroll") for (int bj = 0; bj < 2; ++bj) _Pragma("unroll") for (int n = 0; n < 2; ++n) { const f32x4 v = r[buf][mm][bj][n] + acc[ai][bj][(mp) + mm][n]; \
        *(f32x4*)(out + off + bj * HALF + n * 16) = v; \
        if (xb) { u32x2 w; w.x = cvtpk(v[0], v[1]); w.y = cvtpk(v[2], v[3]); *(u32x2*)(xb + off + bj * HALF + n * 16) = w; ss += v[0] * v[0] + v[1] * v[1] + v[2] * v[2] + v[3] * v[3]; } } \
      if (xb) { ss += __shfl_xor(ss, 16, 64); ss += __shfl_xor(ss, 32, 64); if (fq == 0) unsafeAtomicAdd(rowss + row, ss); } } } while (0)
    ER_LOAD(0, 0, 0); ER_LOAD(1, 0, 2);
    ER_STORE(0, 0, 0); ER_LOAD(0, 1, 0);
    ER_STORE(1, 0, 2); ER_LOAD(1, 1, 2);
    ER_STORE(0, 1, 0); ER_STORE(1, 1, 2);
#undef ER_LOAD
#undef ER_STORE
  }
};
struct EpiSwiGLU {
  static constexpr bool PERM = true;
  bf16_t* O; const float* rowss;
  __device__ __forceinline__ void pre(const Unit& u, int wr, int fr, float (&rsv)[2][4]) const {
    const int row0 = u.pm * BM + wr * 64 + fr;
#pragma unroll
    for (int ai = 0; ai < 2; ++ai)
#pragma unroll
      for (int m = 0; m < 4; ++m) rsv[ai][m] = rowss[row0 + ai * HALF + m * 16];
  }
  __device__ __forceinline__ void operator()(const f32x4 (&acc)[2][2][4][2], const Unit& u, int wr, int wc, int fr, int fq, const float (&rsv)[2][4]) const {
    const int row0 = u.pm * BM + wr * 64 + fr, col0 = u.pn * HALF + wc * 32 + 8 * fq;
#pragma unroll
    for (int ai = 0; ai < 2; ++ai)
#pragma unroll
      for (int m = 0; m < 4; ++m) { const int row = row0 + ai * HALF + m * 16; bf16_t* rowp = O + (size_t)row * DFF + col0;
        const float rs = rsqrtf(rsv[ai][m] * (1.f / DM) + EPS);
        float y[8];
#pragma unroll
        for (int n = 0; n < 2; ++n)
#pragma unroll
          for (int j = 0; j < 4; ++j) { const float g = acc[ai][0][m][n][j] * rs, up = acc[ai][1][m][n][j] * rs;
            const float e = __builtin_amdgcn_exp2f(-g * 1.4426950408889634f);
            y[n * 4 + j] = g * __builtin_amdgcn_rcpf(1.0f + e) * up; }
        u32x4 w; w.x = cvtpk(y[0], y[1]); w.y = cvtpk(y[2], y[3]); w.z = cvtpk(y[4], y[5]); w.w = cvtpk(y[6], y[7]);
        __builtin_nontemporal_store(w, (u32x4*)rowp); }
  }
};

template <class Epi>
__device__ __forceinline__ void gemm_phase(LAS unsigned char* lds, const Gemm g, const StaticOrder& S, const Epi& E) {
  const int tid = opaque_tid(), wid = __builtin_amdgcn_readfirstlane(tid >> 6), lane = tid & 63, wr = wid >> 2, wc = wid & 3, fr = lane & 15, fq = lane >> 4;
  const int K = g.K, nt = K / BK, lda = g.lda;
  unsigned voffA[2], voffB[2];
#pragma unroll
  for (int i = 0; i < 2; ++i) { int R, C; stage_rc(tid * 16 + i * 8192, R, C); const int Rb = Epi::PERM ? ((R & ~31) + perm32(R & 31)) : R;
    voffA[i] = (unsigned)(R * lda + C) * 2u; voffB[i] = (unsigned)(Rb * K + C) * 2u; }
  const size_t kstep = (size_t)(BK * 2);
  const size_t hstepA = (size_t)HALF * lda * 2, hstepB = (size_t)HALF * K * 2;
  const size_t tstepA = 2 * hstepA, tstepB = 2 * hstepB;
  const unsigned ldsw = (unsigned)wid * 1024u;
  const int aoff = lds_byte(wr * 64 + fr, fq * 8), boff = lds_byte(wc * 32 + fr, fq * 8);
#define PG8_SA(b, h) (((b) * 2 + (h)) * HTB)
#define PG8_SB(b, h) ((4 + (b) * 2 + (h)) * HTB)
#define PG8_STAGE(bufoff, gbase, voff) do { _Pragma("unroll") for (int _i = 0; _i < 2; ++_i) \
    __builtin_amdgcn_global_load_lds((const unsigned*)((const char*)(gbase) + (voff)[_i]), (LAS unsigned*)(lds + (bufoff) + ldsw + _i * 8192), 16, 0, 0); } while (0)
#define PG8_LDA(dst, b, h) do { _Pragma("unroll") for (int m = 0; m < 4; ++m) _Pragma("unroll") for (int k = 0; k < 2; ++k) dst[m][k] = *(const LAS bf16x8*)(lds + PG8_SA(b, h) + aoff + m * 2048 + k * 1024); } while (0)
#define PG8_LDB(dst, b, h) do { _Pragma("unroll") for (int n = 0; n < 2; ++n) _Pragma("unroll") for (int k = 0; k < 2; ++k) dst[n][k] = *(const LAS bf16x8*)(lds + PG8_SB(b, h) + boff + n * 2048 + k * 1024); } while (0)
#define PG8_MMA(ai, bj, At, Bt) do { __builtin_amdgcn_s_setprio(1); _Pragma("unroll") for (int m = 0; m < 4; ++m) _Pragma("unroll") for (int n = 0; n < 2; ++n) _Pragma("unroll") for (int k = 0; k < 2; ++k) \
    acc[ai][bj][m][n] = __builtin_amdgcn_mfma_f32_16x16x32_bf16(Bt[n][k], At[m][k], acc[ai][bj][m][n], 0, 0, 0); __builtin_amdgcn_s_setprio(0); } while (0)
#define PG8_WAIT_V(n) asm volatile("s_waitcnt vmcnt(" #n ")" ::: "memory")
#define PG8_WAIT_L(n) asm volatile("s_waitcnt lgkmcnt(" #n ")" ::: "memory")
#define PG8_BAR __builtin_amdgcn_s_barrier()
#define PG8_SCHED __builtin_amdgcn_sched_barrier(0)
  Unit cur, nxt; int ui = 0;
  if (!S.next(0, cur)) return;
  f32x4 acc[2][2][4][2];
#pragma unroll
  for (int a = 0; a < 2; ++a)
#pragma unroll
    for (int b = 0; b < 2; ++b)
#pragma unroll
      for (int m = 0; m < 4; ++m)
#pragma unroll
        for (int n = 0; n < 2; ++n) acc[a][b][m][n] = (f32x4){0.f, 0.f, 0.f, 0.f};
  bf16x8 At[4][2], B0[2][2], B1[2][2];
  float rsv[2][4] = {};
  const char* cA = (const char*)g.A + (size_t)cur.pm * tstepA; const char* cB = (const char*)g.Bt + (size_t)cur.pn * tstepB;
  PG8_STAGE(PG8_SB(0, 0), cB, voffB); PG8_STAGE(PG8_SA(0, 0), cA, voffA); PG8_STAGE(PG8_SB(0, 1), cB + hstepB, voffB); PG8_STAGE(PG8_SA(0, 1), cA + hstepA, voffA);
  if (wr == 1) PG8_BAR;
  PG8_WAIT_V(4); PG8_BAR;
  PG8_STAGE(PG8_SB(1, 0), cB + kstep, voffB); PG8_STAGE(PG8_SA(1, 0), cA + kstep, voffA); PG8_STAGE(PG8_SB(1, 1), cB + hstepB + kstep, voffB);
  PG8_WAIT_V(6); PG8_BAR;
  for (;;) {
    const bool has_next = S.next(ui + 1, nxt);
    const char* nA = has_next ? (const char*)g.A + (size_t)nxt.pm * tstepA : cA; const char* nB = has_next ? (const char*)g.Bt + (size_t)nxt.pn * tstepB : cB;
    for (int t = 0; t < nt; t += 2) {
      const bool last = (t == nt - 2);
      if (last) E.pre(cur, wr, fr, rsv);
      const char* a1 = cA + (size_t)(t + 1) * kstep;
      const char* a2 = last ? nA : cA + (size_t)(t + 2) * kstep; const char* b2 = last ? nB : cB + (size_t)(t + 2) * kstep;
      const char* a3 = a2 + kstep; const char* b3 = b2 + kstep;
      PG8_LDB(B0, 0, 0); PG8_SCHED; PG8_LDA(At, 0, 0); PG8_STAGE(PG8_SA(1, 1), a1 + hstepA, voffA);
      PG8_WAIT_L(8); PG8_BAR; PG8_WAIT_L(0); PG8_MMA(0, 0, At, B0); PG8_BAR; PG8_SCHED;
      PG8_LDB(B1, 0, 1); PG8_STAGE(PG8_SB(0, 0), b2, voffB);
      PG8_BAR; PG8_WAIT_L(0); PG8_MMA(0, 1, At, B1); PG8_BAR;
      PG8_LDA(At, 0, 1); PG8_STAGE(PG8_SA(0, 0), a2, voffA);
      PG8_BAR; PG8_WAIT_L(0); PG8_MMA(1, 0, At, B0); PG8_BAR; PG8_SCHED;
      PG8_STAGE(PG8_SB(0, 1), b2 + hstepB, voffB);
      PG8_WAIT_V(6); PG8_BAR; PG8_MMA(1, 1, At, B1); PG8_BAR;
      PG8_LDB(B0, 1, 0); PG8_SCHED; PG8_LDA(At, 1, 0); PG8_STAGE(PG8_SA(0, 1), a2 + hstepA, voffA);
      PG8_WAIT_L(8); PG8_BAR; PG8_WAIT_L(0); PG8_MMA(0, 0, At, B0); PG8_BAR; PG8_SCHED;
      PG8_LDB(B1, 1, 1); PG8_STAGE(PG8_SB(1, 0), b3, voffB);
      PG8_BAR; PG8_WAIT_L(0); PG8_MMA(0, 1, At, B1); PG8_BAR;
      PG8_LDA(At, 1, 1); PG8_STAGE(PG8_SA(1, 0), a3, voffA);
      PG8_BAR; PG8_WAIT_L(0); PG8_MMA(1, 0, At, B0); PG8_BAR; PG8_SCHED;
      PG8_STAGE(PG8_SB(1, 1), b3 + hstepB, voffB);
      PG8_WAIT_V(6); PG8_BAR; PG8_MMA(1, 1, At, B1); PG8_BAR;
    }
    E(acc, cur, wr, wc, fr, fq, rsv);
    if (!has_next) break;
#pragma unroll
    for (int a = 0; a < 2; ++a)
#pragma unroll
      for (int b = 0; b < 2; ++b)
#pragma unroll
        for (int m = 0; m < 4; ++m)
#pragma unroll
          for (int n = 0; n < 2; ++n) acc[a][b][m][n] = (f32x4){0.f, 0.f, 0.f, 0.f};
    cur = nxt; cA = nA; cB = nB; ++ui;
  }
  PG8_WAIT_V(0);
  if (wr == 0) PG8_BAR;
  PG8_BAR;
#undef PG8_SA
#undef PG8_SB
#undef PG8_STAGE
#undef PG8_LDA
#undef PG8_LDB
#undef PG8_MMA
#undef PG8_WAIT_V
#undef PG8_WAIT_L
#undef PG8_BAR
#undef PG8_SCHED
}
template <class Epi>
__device__ __forceinline__ void run_gemm(LAS unsigned char* lds, const bf16_t* A, int lda, const bf16_t* Bt, int M, int N, int K, const Epi& E, int coff, int stagger_ticks) {
  if (stagger_ticks > 0) {
    const unsigned long long t0 = __builtin_amdgcn_s_memrealtime(); const unsigned long long d = (unsigned long long)(((blockIdx.x >> 3) & 7) * stagger_ticks) >> 3;
    while (__builtin_amdgcn_s_memrealtime() - t0 < d) __builtin_amdgcn_s_sleep(8);
  }
  Gemm g{A, Bt, M, N, K, lda};
  StaticOrder S; S.init(M, N, (int)gridDim.x, (int)((blockIdx.x + coff) % gridDim.x));
  gemm_phase<Epi>(lds, g, S, E);
}
}

namespace att {
constexpr int NW = 8, QBLK = 32, KVBLK = 64;
constexpr float THR = 8.f;
constexpr int SHM_V = KVBLK * 128 * 2, SHM_K = KVBLK * 128 * 2, SHM_K2 = KVBLK * 64 * 2;
constexpr int NBUF = 3;
constexpr int OFF_K = NBUF * SHM_V, OFF_K2 = OFF_K + NBUF * SHM_K, OFF_WS = OFF_K2 + NBUF * SHM_K2, OFF_Q2 = OFF_WS + NW * 64 * 4, SHM_ATTN = OFF_Q2 + 32768;
#define KSWZ(row, colB) ((row) * 256 + ((colB) ^ (((row) & 7) << 4)))
#define K2SWZ(row, colB) ((row) * 128 + ((colB) ^ ((((row) >> 1) & 7) << 4)))
#define SBAR() __builtin_amdgcn_sched_barrier(0)
__device__ __forceinline__ int crow(int r, int hi) { return (r & 3) + 8 * (r >> 2) + 4 * hi; }
__device__ __forceinline__ void partialSM(f32x16& p0, f32x16& p1, float& m_reg, float& mn, float& alpha, float C, float thr_s) {
  float pmax = p0[0];
#pragma unroll
  for (int r = 1; r < 16; ++r) pmax = fmaxf(pmax, p0[r]);
#pragma unroll
  for (int r = 0; r < 16; ++r) pmax = fmaxf(pmax, p1[r]);
  { auto rr = __builtin_amdgcn_permlane32_swap(__float_as_uint(pmax), __float_as_uint(pmax), false, false);
    pmax = fmaxf(__uint_as_float(rr[0]), __uint_as_float(rr[1])); }
  if (__builtin_expect(__all(pmax - m_reg <= thr_s), 1)) { mn = m_reg; alpha = 1.f; }
  else { mn = fmaxf(m_reg, pmax); alpha = __builtin_amdgcn_exp2f((m_reg - mn) * C); m_reg = mn; }
  float mnC = -mn * C;
#pragma unroll
  for (int r = 0; r < 16; ++r) p0[r] = fmaf(p0[r], C, mnC);
#pragma unroll
  for (int r = 0; r < 16; ++r) p1[r] = fmaf(p1[r], C, mnC);
#pragma unroll
  for (int r = 0; r < 16; ++r) p0[r] = __builtin_amdgcn_exp2f(p0[r]);
}
__device__ __forceinline__ void finishSM(f32x16& p0, f32x16& p1, float alpha, float& l_reg, bf16x8& pa0, bf16x8& pa1, bf16x8& pa2, bf16x8& pa3) {
#pragma unroll
  for (int r = 0; r < 16; ++r) p1[r] = __builtin_amdgcn_exp2f(p1[r]);
  float ps = 0;
#pragma unroll
  for (int r = 0; r < 16; ++r) ps += p0[r];
#pragma unroll
  for (int r = 0; r < 16; ++r) ps += p1[r];
  { auto rr = __builtin_amdgcn_permlane32_swap(__float_as_uint(ps), __float_as_uint(ps), false, false);
    ps = __uint_as_float(rr[0]) + __uint_as_float(rr[1]); }
  l_reg = l_reg * alpha + ps;
#define PK4(P, BASE, OUT) do { unsigned a0 = cvtpk(P[BASE + 0], P[BASE + 1]), a1 = cvtpk(P[BASE + 2], P[BASE + 3]);   \
    unsigned b0 = cvtpk(P[BASE + 4], P[BASE + 5]), b1 = cvtpk(P[BASE + 6], P[BASE + 7]);                              \
    auto r0 = __builtin_amdgcn_permlane32_swap(a0, b0, false, false); auto r1 = __builtin_amdgcn_permlane32_swap(a1, b1, false, false); \
    u32x4 w = {r0[0], r1[0], r0[1], r1[1]}; OUT = *reinterpret_cast<bf16x8*>(&w); } while (0)
  PK4(p0, 0, pa0); PK4(p0, 8, pa1); PK4(p1, 0, pa2); PK4(p1, 8, pa3);
#undef PK4
}
template <int DQK>
__device__ __forceinline__ void qkt(f32x16& p0, f32x16& p1, const char* Ks, const char* K2s, const bf16x8* qr, const char* q2l, int r32, int hi) {
#pragma unroll
  for (int r = 0; r < 16; ++r) { p0[r] = 0.f; p1[r] = 0.f; }
#pragma unroll
  for (int d0 = 0; d0 < 8; ++d0) { int cb = (d0 * 16 + hi * 8) * 2;
    bf16x8 b0 = *reinterpret_cast<const bf16x8*>(Ks + KSWZ(r32, cb));
    bf16x8 b1 = *reinterpret_cast<const bf16x8*>(Ks + KSWZ(32 + r32, cb));
    p0 = __builtin_amdgcn_mfma_f32_32x32x16_bf16(b0, qr[d0], p0, 0, 0, 0);
    p1 = __builtin_amdgcn_mfma_f32_32x32x16_bf16(b1, qr[d0], p1, 0, 0, 0); }
  if constexpr (DQK == 192) {
#pragma unroll
    for (int d0 = 0; d0 < 4; ++d0) { int cb = (d0 * 16 + hi * 8) * 2;
      bf16x8 b0 = *reinterpret_cast<const bf16x8*>(K2s + K2SWZ(r32, cb));
      bf16x8 b1 = *reinterpret_cast<const bf16x8*>(K2s + K2SWZ(32 + r32, cb));
      const bf16x8 q2 = *reinterpret_cast<const bf16x8*>(q2l + d0 * 1024);
      p0 = __builtin_amdgcn_mfma_f32_32x32x16_bf16(b0, q2, p0, 0, 0, 0);
      p1 = __builtin_amdgcn_mfma_f32_32x32x16_bf16(b1, q2, p1, 0, 0, 0); }
  }
}
__device__ __forceinline__ int v_st(int k, int c) { const int kk = (k & ~0xC) | ((k & 4) << 1) | ((k & 8) >> 1); return ((kk >> 3) * 4 + (c >> 5)) * 512 + ((kk & 7) * 32 + (c & 31)) * 2; }
__device__ __forceinline__ int v_rd_base(int lane) { return ((lane & 3) << 3) | (((lane >> 2) & 3) << 6) | (((lane >> 4) & 1) << 5) | (((lane >> 5) & 1) << 8); }
constexpr int v_rd_off(int d0, int ks, int half) { return d0 * 512 + ks * 4096 + half * 2048; }
template <int OFF> __device__ __forceinline__ s16x4 tr_read(int vb) {
  s16x4 r; asm volatile("ds_read_b64_tr_b16 %0, %1 offset:%2" : "=&v"(r) : "v"(vb), "i"(OFF) : "memory"); return r;
}
template <int D0> __device__ __forceinline__ void pv_one(f32x16& od, int vb, bf16x8 pa0, bf16x8 pa1, bf16x8 pa2, bf16x8 pa3) {
  const s16x4 l0 = tr_read<v_rd_off(D0, 0, 0)>(vb), h0 = tr_read<v_rd_off(D0, 0, 1)>(vb), l1 = tr_read<v_rd_off(D0, 1, 0)>(vb), h1 = tr_read<v_rd_off(D0, 1, 1)>(vb);
  const s16x4 l2 = tr_read<v_rd_off(D0, 2, 0)>(vb), h2 = tr_read<v_rd_off(D0, 2, 1)>(vb), l3 = tr_read<v_rd_off(D0, 3, 0)>(vb), h3 = tr_read<v_rd_off(D0, 3, 1)>(vb);
  asm volatile("s_waitcnt lgkmcnt(0)" ::: "memory"); SBAR();
#define PK(L, H) (bf16x8){L[0], L[1], L[2], L[3], H[0], H[1], H[2], H[3]}
  od = __builtin_amdgcn_mfma_f32_32x32x16_bf16(pa0, PK(l0, h0), od, 0, 0, 0);
  od = __builtin_amdgcn_mfma_f32_32x32x16_bf16(pa1, PK(l1, h1), od, 0, 0, 0);
  od = __builtin_amdgcn_mfma_f32_32x32x16_bf16(pa2, PK(l2, h2), od, 0, 0, 0);
  od = __builtin_amdgcn_mfma_f32_32x32x16_bf16(pa3, PK(l3, h3), od, 0, 0, 0);
#undef PK
}
__device__ __forceinline__ void pv_d0(f32x16* o, int vb, bf16x8 pa0, bf16x8 pa1, bf16x8 pa2, bf16x8 pa3) {
  pv_one<0>(o[0], vb, pa0, pa1, pa2, pa3); pv_one<1>(o[1], vb, pa0, pa1, pa2, pa3); pv_one<2>(o[2], vb, pa0, pa1, pa2, pa3); pv_one<3>(o[3], vb, pa0, pa1, pa2, pa3);
}

template <int DQK, int SDEPTH>
__device__ __forceinline__ void attn_body(const bf16_t* __restrict__ Qb, const bf16_t* __restrict__ Q2b, int ldq, const bf16_t* __restrict__ Kh, int ldk, const bf16_t* __restrict__ K2h, int ldk2,
                                          const bf16_t* __restrict__ Vh, int ldv, bf16_t* __restrict__ Ob, int ldo, int seq, float scale, char* lds, LAS unsigned char* ldsl,
                                          const float* __restrict__ qgain, int sq0, const float* __restrict__ rsq, int qrope) {
  constexpr int ND = 8;
  const int tid = opaque_tid(), wid = tid >> 6, lane = tid & 63, r32 = lane & 31, hi = lane >> 5;
  const float C = scale * 1.4426950408889634f, thr_s = THR / scale;
  char* V_lds = lds; char* K_lds = lds + OFF_K; char* K2_lds = lds + OFF_K2;
  float* ws = (float*)(lds + OFF_WS) + wid * 64; float* li_l = ws; float* al_l = ws + 32;
  float m_reg = -1e30f, l_reg = 0; f32x16 o[4]; bf16x8 qr[ND];
#pragma unroll
  for (int d = 0; d < 4; ++d)
#pragma unroll
    for (int r = 0; r < 16; ++r) o[d][r] = 0.f;
  const bf16_t* Qw = Qb + (long)(wid * QBLK + r32) * ldq + hi * 8;
#pragma unroll
  for (int d0 = 0; d0 < ND; ++d0) qr[d0] = *reinterpret_cast<const bf16x8*>(Qw + d0 * 16);
  float mla_rsq = 1.f;
  if (DQK == 192 && qgain != nullptr) {
    if (rsq) mla_rsq = rsq[wid * QBLK + r32];
    float ss = 0.f;
#pragma unroll
    for (int d0 = 0; d0 < 8; ++d0) { const u32x4 w = *reinterpret_cast<const u32x4*>(&qr[d0]);
#pragma unroll
      for (int i = 0; i < 4; ++i) { const float lo = __uint_as_float(w[i] << 16) * mla_rsq, hi_ = __uint_as_float(w[i] & 0xffff0000u) * mla_rsq; ss += lo * lo + hi_ * hi_; } }
    ss += __shfl_xor(ss, 32, 64);
    const float rs = rsqrtf(ss * (1.f / 128.f) + EPS);
#pragma unroll
    for (int d0 = 0; d0 < 8; ++d0) { const u32x4 w = *reinterpret_cast<const u32x4*>(&qr[d0]);
      const f32x4 g0 = *(const f32x4*)(qgain + d0 * 16 + hi * 8), g1 = *(const f32x4*)(qgain + d0 * 16 + hi * 8 + 4);
      float x[8];
#pragma unroll
      for (int i = 0; i < 4; ++i) { x[2 * i] = __uint_as_float(w[i] << 16) * mla_rsq; x[2 * i + 1] = __uint_as_float(w[i] & 0xffff0000u) * mla_rsq; }
#pragma unroll
      for (int j = 0; j < 8; ++j) x[j] *= rs * (j < 4 ? g0[j & 3] : g1[j & 3]);
      u32x4 ow; ow.x = cvtpk(x[0], x[1]); ow.y = cvtpk(x[2], x[3]); ow.z = cvtpk(x[4], x[5]); ow.w = cvtpk(x[6], x[7]);
      qr[d0] = *reinterpret_cast<bf16x8*>(&ow); }
  }
  if (DQK == 128 && qgain != nullptr) {
    float ss = 0.f;
#pragma unroll
    for (int d0 = 0; d0 < 8; ++d0) { const u32x4 w = *reinterpret_cast<const u32x4*>(&qr[d0]);
#pragma unroll
      for (int i = 0; i < 4; ++i) { const float lo = __uint_as_float(w[i] << 16), hi_ = __uint_as_float(w[i] & 0xffff0000u); ss += lo * lo + hi_ * hi_; } }
    ss += __shfl_xor(ss, 32, 64);
    const float rs = rsqrtf(ss * (1.f / 128.f) + EPS);
    const int sq = sq0 + wid * QBLK + r32;
#pragma unroll
    for (int part = 0; part < 2; ++part) { const float pos = (float)(part ? (sq & 63) : (sq >> 6));
#pragma unroll
      for (int dp = 0; dp < 2; ++dp) { const int da = part * 4 + dp, db = da + 2;
        const u32x4 wa = *reinterpret_cast<const u32x4*>(&qr[da]), wb = *reinterpret_cast<const u32x4*>(&qr[db]);
        float xa[8], xb_[8];
#pragma unroll
        for (int i = 0; i < 4; ++i) { xa[2 * i] = __uint_as_float(wa[i] << 16); xa[2 * i + 1] = __uint_as_float(wa[i] & 0xffff0000u); xb_[2 * i] = __uint_as_float(wb[i] << 16); xb_[2 * i + 1] = __uint_as_float(wb[i] & 0xffff0000u); }
        const f32x4 ga0 = *(const f32x4*)(qgain + da * 16 + hi * 8), ga1 = *(const f32x4*)(qgain + da * 16 + hi * 8 + 4), gb0 = *(const f32x4*)(qgain + db * 16 + hi * 8), gb1 = *(const f32x4*)(qgain + db * 16 + hi * 8 + 4);
#pragma unroll
        for (int j = 0; j < 8; ++j) { float c = 1.f, sn = 0.f;
          if (qrope) { const float inv = exp2f(-(float)(2 * (dp * 16 + hi * 8 + j)) * (1.f / 64.f) * LOG2_THETA);
            float rev = pos * inv * INV2PI; rev -= floorf(rev); c = __builtin_amdgcn_cosf(rev); sn = __builtin_amdgcn_sinf(rev); }
          const float x1 = xa[j] * rs * (j < 4 ? ga0[j & 3] : ga1[j & 3]), x2 = xb_[j] * rs * (j < 4 ? gb0[j & 3] : gb1[j & 3]);
          xa[j] = x1 * c - x2 * sn; xb_[j] = x2 * c + x1 * sn; }
        u32x4 oa, ob; oa.x = cvtpk(xa[0], xa[1]); oa.y = cvtpk(xa[2], xa[3]); oa.z = cvtpk(xa[4], xa[5]); oa.w = cvtpk(xa[6], xa[7]);
        ob.x = cvtpk(xb_[0], xb_[1]); ob.y = cvtpk(xb_[2], xb_[3]); ob.z = cvtpk(xb_[4], xb_[5]); ob.w = cvtpk(xb_[6], xb_[7]);
        qr[da] = *reinterpret_cast<bf16x8*>(&oa); qr[db] = *reinterpret_cast<bf16x8*>(&ob); } }
  }
  char* q2l = lds + OFF_Q2 + (wid * 4 * 64 + lane) * 16;
  __syncthreads();
  if constexpr (DQK == 192) {
    u32x4 qp[4];
#pragma unroll
    for (int d0 = 0; d0 < 4; ++d0) qp[d0] = *reinterpret_cast<const u32x4*>(Q2b + (long)(wid * QBLK + r32) * ldq + hi * 8 + d0 * 16);
    if (qgain != nullptr) {
      float ss = 0.f;
#pragma unroll
      for (int d = 0; d < 4; ++d)
#pragma unroll
        for (int i = 0; i < 4; ++i) { const float lo = __uint_as_float(qp[d][i] << 16) * mla_rsq, hi_ = __uint_as_float(qp[d][i] & 0xffff0000u) * mla_rsq; ss += lo * lo + hi_ * hi_; }
      ss += __shfl_xor(ss, 32, 64);
      const float rs = rsqrtf(ss * (1.f / 64.f) + EPS) * mla_rsq;
      const int sq = sq0 + wid * QBLK + r32;
#pragma unroll
      for (int part = 0; part < 2; ++part) { const float pos = (float)(part ? (sq & 63) : (sq >> 6)); const int da = 2 * part, db = da + 1;
        const f32x4 ga0 = *(const f32x4*)(qgain + 128 + da * 16 + hi * 8), ga1 = *(const f32x4*)(qgain + 128 + da * 16 + hi * 8 + 4);
        const f32x4 gb0 = *(const f32x4*)(qgain + 128 + db * 16 + hi * 8), gb1 = *(const f32x4*)(qgain + 128 + db * 16 + hi * 8 + 4);
        float xa[8], xb_[8];
#pragma unroll
        for (int i = 0; i < 4; ++i) { xa[2 * i] = __uint_as_float(qp[da][i] << 16); xa[2 * i + 1] = __uint_as_float(qp[da][i] & 0xffff0000u); xb_[2 * i] = __uint_as_float(qp[db][i] << 16); xb_[2 * i + 1] = __uint_as_float(qp[db][i] & 0xffff0000u); }
#pragma unroll
        for (int j = 0; j < 8; ++j) { const float inv = exp2f(-(float)(2 * (hi * 8 + j)) * (1.f / 32.f) * LOG2_THETA);
          float rev = pos * inv * INV2PI; rev -= floorf(rev);
          const float c = __builtin_amdgcn_cosf(rev), sn = __builtin_amdgcn_sinf(rev);
          const float x1 = xa[j] * rs * (j < 4 ? ga0[j & 3] : ga1[j & 3]), x2 = xb_[j] * rs * (j < 4 ? gb0[j & 3] : gb1[j & 3]);
          xa[j] = x1 * c - x2 * sn; xb_[j] = x2 * c + x1 * sn; }
        qp[da].x = cvtpk(xa[0], xa[1]); qp[da].y = cvtpk(xa[2], xa[3]); qp[da].z = cvtpk(xa[4], xa[5]); qp[da].w = cvtpk(xa[6], xa[7]);
        qp[db].x = cvtpk(xb_[0], xb_[1]); qp[db].y = cvtpk(xb_[2], xb_[3]); qp[db].z = cvtpk(xb_[4], xb_[5]); qp[db].w = cvtpk(xb_[6], xb_[7]); }
    }
#pragma unroll
    for (int d0 = 0; d0 < 4; ++d0) *reinterpret_cast<u32x4*>(q2l + d0 * 1024) = qp[d0];
  }
  const int wu = __builtin_amdgcn_readfirstlane(wid);
  unsigned voffK[2], voffV[2], voffK2;
#pragma unroll
  for (int i = 0; i < 2; ++i) {
    const int blk = i * 8 + wid;
    { const int row = blk * 4 + (lane >> 4), colB = ((lane & 15) << 4) ^ ((row & 7) << 4); voffK[i] = (unsigned)(row * ldk * 2 + colB); }
    { const int st = blk * 2 + (lane >> 5), kk = (st >> 2) * 8 + ((lane & 31) >> 2), c = (st & 3) * 32 + (lane & 3) * 8;
      const int k = (kk & ~0xC) | ((kk & 4) << 1) | ((kk & 8) >> 1); voffV[i] = (unsigned)((k * ldv + c) * 2); }
  }
  { const int row = wid * 8 + (lane >> 3), colB = ((lane & 7) << 4) ^ (((row >> 1) & 7) << 4); voffK2 = (unsigned)(row * ldk2 * 2 + colB); }
  const size_t tsV = (size_t)ldv * 2, tsK = (size_t)ldk * 2, tsK2 = (size_t)ldk2 * 2;
  const int vb0 = (int)(uintptr_t)V_lds + v_rd_base(lane);
  constexpr int NDMA = (DQK == 192) ? 5 : 4;
#define DMA_K(t) do { const int b_ = (t) % 3; const char* kb_ = (const char*)Kh + (size_t)(t) * KVBLK * tsK; \
    _Pragma("unroll") for (int i = 0; i < 2; ++i) __builtin_amdgcn_global_load_lds((const unsigned*)(kb_ + voffK[i]), (LAS unsigned*)(ldsl + OFF_K + b_ * SHM_K + (i * 8 + wu) * 1024), 16, 0, 0); \
    if constexpr (DQK == 192) __builtin_amdgcn_global_load_lds((const unsigned*)((const char*)K2h + (size_t)(t) * KVBLK * tsK2 + voffK2), (LAS unsigned*)(ldsl + OFF_K2 + b_ * SHM_K2 + wu * 1024), 16, 0, 0); } while (0)
#define DMA_V(t) do { const int b_ = (t) % 3; const char* vb_ = (const char*)Vh + (size_t)(t) * KVBLK * tsV; \
    _Pragma("unroll") for (int i = 0; i < 2; ++i) __builtin_amdgcn_global_load_lds((const unsigned*)(vb_ + voffV[i]), (LAS unsigned*)(ldsl + b_ * SHM_V + (i * 8 + wu) * 1024), 16, 0, 0); } while (0)
#define RAWBAR() do { asm volatile("" ::: "memory"); __builtin_amdgcn_s_barrier(); asm volatile("" ::: "memory"); } while (0)
#define RESC(a) do { if (__any((a) < 1.f)) { if (hi == 0) al_l[r32] = (a); asm volatile("s_waitcnt lgkmcnt(0)" ::: "memory"); \
    _Pragma("unroll") for (int d = 0; d < 4; ++d) _Pragma("unroll") for (int r = 0; r < 16; ++r) o[d][r] *= al_l[crow(r, hi)]; } } while (0)
  f32x16 pA0, pA1, pB0, pB1; float mnA, mnB, alA, alB; bf16x8 pa0, pa1, pa2, pa3; const int NT = seq / KVBLK;
  int ob_prev = 0, ob_cur = 1;
#define HALF_STEP(PN0, PN1, MNN, ALN, PO0, PO1, ALO, J, FULL) do { \
    if (FULL) { DMA_K((J) + 2); DMA_V((J) + 1); } else { if ((J) + 2 < NT) DMA_K((J) + 2); if ((J) + 1 < NT) DMA_V((J) + 1); } \
    SBAR(); qkt<DQK>(PN0, PN1, K_lds + ob_cur * SHM_K, K2_lds + ob_cur * SHM_K2, qr, q2l, r32, hi); \
    finishSM(PO0, PO1, ALO, l_reg, pa0, pa1, pa2, pa3); \
    pv_d0(o, vb0 + ob_prev * SHM_V, pa0, pa1, pa2, pa3); partialSM(PN0, PN1, m_reg, MNN, ALN, C, thr_s); SBAR(); \
    RESC(ALN); \
    if (FULL) { if constexpr (NDMA == 5) asm volatile("s_waitcnt vmcnt(5)" ::: "memory"); else asm volatile("s_waitcnt vmcnt(4)" ::: "memory"); } else asm volatile("s_waitcnt vmcnt(0)" ::: "memory"); \
    RAWBAR(); \
    ob_prev = ob_cur; ob_cur = (ob_cur == 2) ? 0 : ob_cur + 1; } while (0)
  DMA_K(0); DMA_V(0); DMA_K(1);
  asm volatile("s_waitcnt vmcnt(0)" ::: "memory"); RAWBAR();
  DMA_K(2); DMA_V(1);
  qkt<DQK>(pA0, pA1, K_lds, K2_lds, qr, q2l, r32, hi); partialSM(pA0, pA1, m_reg, mnA, alA, C, thr_s);
  if constexpr (NDMA == 5) asm volatile("s_waitcnt vmcnt(5)" ::: "memory"); else asm volatile("s_waitcnt vmcnt(4)" ::: "memory");
  RAWBAR();
  for (int j = 1; j + 3 < NT; j += 2) {
    HALF_STEP(pB0, pB1, mnB, alB, pA0, pA1, alA, j, true);
    HALF_STEP(pA0, pA1, mnA, alA, pB0, pB1, alB, j + 1, true);
  }
  HALF_STEP(pB0, pB1, mnB, alB, pA0, pA1, alA, NT - 3, false);
  HALF_STEP(pA0, pA1, mnA, alA, pB0, pB1, alB, NT - 2, false);
  HALF_STEP(pB0, pB1, mnB, alB, pA0, pA1, alA, NT - 1, false);
  finishSM(pB0, pB1, alB, l_reg, pa0, pa1, pa2, pa3); SBAR();
  pv_d0(o, vb0 + ob_prev * SHM_V, pa0, pa1, pa2, pa3);
#undef HALF_STEP
#undef DMA_K
#undef DMA_V
#undef RAWBAR
  if (hi == 0) li_l[r32] = l_reg; asm volatile("s_waitcnt lgkmcnt(0)" ::: "memory");
  float rli[16];
#pragma unroll
  for (int r = 0; r < 16; ++r) rli[r] = __builtin_amdgcn_rcpf(li_l[crow(r, hi)]);
  bf16_t* Ow = Ob + (long)(wid * QBLK) * ldo;
#pragma unroll
  for (int r = 0; r < 16; ++r) { int orow = crow(r, hi);
#pragma unroll
    for (int d0 = 0; d0 < 4; ++d0) Ow[(long)orow * ldo + d0 * 32 + r32] = f2bf(o[d0][r] * rli[r]); }
#undef RESC
}
struct AttnJob { const bf16_t* Q; const bf16_t* Q2; int ldq, qhs; const bf16_t* K; int ldk, khs; long kbs; const bf16_t* K2; int ldk2; const bf16_t* V; int ldv; bf16_t* O; int H, gshift, seq, nunits; float scale; const float* qgain; const float* rsq; int qrope; };
template <int DQK, int SDEPTH>
__device__ __forceinline__ void run_attn(const AttnJob& a, char* lds, LAS unsigned char* ldsl) {
  for (int u = blockIdx.x; u < a.nunits; u += gridDim.x) {
    const int per_b = a.H * 32, b = u / per_b, rest = u - b * per_b, h = rest % a.H, qb = rest / a.H, kh = h >> a.gshift;
    const long tok0 = (long)b * SEQ + qb * 256;
    attn_body<DQK, SDEPTH>(a.Q + tok0 * a.ldq + h * a.qhs, a.Q2 + tok0 * a.ldq + h * 64, a.ldq, a.K + (long)b * a.kbs + kh * a.khs, a.ldk, a.K2 + (long)b * SEQ * a.ldk2, a.ldk2,
                           a.V + (long)b * a.kbs + kh * a.khs, a.ldv, a.O + tok0 * 1536 + h * 128, 1536, a.seq, a.scale, lds, ldsl, a.qgain, qb * 256, a.rsq ? a.rsq + tok0 : nullptr, a.qrope);
  }
}
}

__device__ __forceinline__ void rms_rows(const float* __restrict__ src, const float* __restrict__ gain, bf16_t* __restrict__ dst, int nrows) {
  const int tid_ = opaque_tid(), wid = tid_ >> 6, lane = tid_ & 63;
  for (int row = blockIdx.x * 8 + wid; row < nrows; row += gridDim.x * 8) {
    const f32x4* s = (const f32x4*)(src + (size_t)row * DM);
    f32x4 v[4]; float ss = 0.f;
#pragma unroll
    for (int j = 0; j < 4; ++j) { v[j] = s[lane + 64 * j]; ss += v[j][0] * v[j][0] + v[j][1] * v[j][1] + v[j][2] * v[j][2] + v[j][3] * v[j][3]; }
    ss = wave_sum(ss);
    const float rs = rsqrtf(ss * (1.f / DM) + EPS);
#pragma unroll
    for (int j = 0; j < 4; ++j) { const f32x4 g = ((const f32x4*)gain)[lane + 64 * j];
      u32x2 w; w.x = cvtpk(v[j][0] * rs * g[0], v[j][1] * rs * g[1]); w.y = cvtpk(v[j][2] * rs * g[2], v[j][3] * rs * g[3]);
      *(u32x2*)(dst + (size_t)row * DM + (lane + 64 * j) * 4) = w; }
  }
}
template <int MODE>
__device__ __forceinline__ void prep_w(const float* __restrict__ src, int K, int Nsrc, bf16_t* __restrict__ dst, int Ndst, const float* __restrict__ kgain) {
  const long total = (long)Ndst * (K / 8);
  for (long i = (long)blockIdx.x * 512 + opaque_tid(); i < total; i += (long)gridDim.x * 512) {
    const long i8 = i >> 3; const int n = (int)(i8 % Ndst), k8 = (int)(i8 / Ndst) * 8 + (int)(i & 7);
    int ns = n;
    if (MODE == 1) { const int pn = n >> 8, r = n & 255, bj = r >> 7, ii = r & 127; ns = bj * DFF + pn * 128 + ii; }
    if (MODE == 2) { ns = n < 640 ? n : (n < 1152 ? n + 64 : (n < 1216 ? n - 512 : Nsrc)); }
    if (MODE == 3) { ns = n < 1024 ? (n >> 7) * 192 + (n & 127) : ((n - 1024) >> 6) * 192 + 128 + ((n - 1024) & 63); }
    float x[8];
#pragma unroll
    for (int j = 0; j < 8; ++j) x[j] = (ns < Nsrc) ? src[(size_t)(k8 * 8 + j) * Nsrc + ns] : 0.f;
    if (kgain) {
#pragma unroll
      for (int j = 0; j < 8; ++j) x[j] *= kgain[k8 * 8 + j];
    }
    u32x4 w; w.x = cvtpk(x[0], x[1]); w.y = cvtpk(x[2], x[3]); w.z = cvtpk(x[4], x[5]); w.w = cvtpk(x[6], x[7]);
    *(u32x4*)(dst + (size_t)n * K + k8 * 8) = w;
  }
}
__device__ __forceinline__ void unpack8(u32x4 w, float* v) {
#pragma unroll
  for (int i = 0; i < 4; ++i) { v[2 * i] = __uint_as_float(w[i] << 16); v[2 * i + 1] = __uint_as_float(w[i] & 0xffff0000u); }
}
__device__ __forceinline__ u32x4 pack8(const float* v) { u32x4 w; w.x = cvtpk(v[0], v[1]); w.y = cvtpk(v[2], v[3]); w.z = cvtpk(v[4], v[5]); w.w = cvtpk(v[6], v[7]); return w; }
__device__ __forceinline__ float sumsq8(const float* v) { float s = 0.f;
#pragma unroll
  for (int j = 0; j < 8; ++j) s += v[j] * v[j];
  return s; }
template <int GL> __device__ __forceinline__ float group_sum(float s) {
#pragma unroll
  for (int o = 1; o < GL; o <<= 1) s += __shfl_xor(s, o, 64);
  return s;
}
__device__ __forceinline__ void load8(float* g, const float* __restrict__ p) { const f32x4 a = *(const f32x4*)p, b = *(const f32x4*)(p + 4);
  g[0] = a[0]; g[1] = a[1]; g[2] = a[2]; g[3] = a[3]; g[4] = b[0]; g[5] = b[1]; g[6] = b[2]; g[7] = b[3]; }
template <int GL> __device__ __forceinline__ void norm8(float* v, const float* g) {
  const float ss = group_sum<GL>(sumsq8(v)); const float rs = rsqrtf(ss * (1.f / (GL * 8)) + EPS);
#pragma unroll
  for (int j = 0; j < 8; ++j) v[j] *= rs * g[j];
}
template <int XM> __device__ __forceinline__ void rope8(float* v, const float* inv, float pos, bool first) {
#pragma unroll
  for (int j = 0; j < 8; ++j) {
    const float partner = __shfl_xor(v[j], XM, 64);
    float rev = pos * inv[j] * INV2PI; rev -= floorf(rev);
    const float c = __builtin_amdgcn_cosf(rev), s = __builtin_amdgcn_sinf(rev);
    v[j] = first ? v[j] * c - partner * s : v[j] * c + partner * s;
  }
}
template <int NE> __device__ __forceinline__ void ld_seg(float* v, const bf16_t* p, int lane) {
#pragma unroll
  for (int j = 0; j < NE; ++j) v[j] = bf2f(p[lane + 64 * j]);
}
template <int NE> __device__ __forceinline__ void st_seg(const float* v, bf16_t* p, int lane) {
#pragma unroll
  for (int j = 0; j < NE; ++j) p[lane + 64 * j] = f2bf(v[j]);
}
template <int NE, int ROPE> __device__ __forceinline__ void norm_seg(float* v, const float* __restrict__ gain, int lane, int prow, int pcol) {
  float ss = 0.f;
#pragma unroll
  for (int j = 0; j < NE; ++j) ss += v[j] * v[j];
  ss = wave_sum(ss);
  const float rs = rsqrtf(ss * (1.f / (64 * NE)) + EPS);
#pragma unroll
  for (int j = 0; j < NE; ++j) v[j] = v[j] * rs * gain[lane + 64 * j];
  if constexpr (ROPE && NE == 2) {
    const int f = lane & 31; const float inv = exp2f(-(float)(2 * f) * (1.f / 64.f) * LOG2_THETA);
#pragma unroll
    for (int j = 0; j < 2; ++j) {
      const float partner = __shfl_xor(v[j], 32, 64);
      const float ang = (float)(j == 0 ? prow : pcol) * inv;
      float rev = ang * INV2PI; rev -= floorf(rev);
      const float c = __builtin_amdgcn_cosf(rev), s = __builtin_amdgcn_sinf(rev);
      v[j] = (lane < 32) ? v[j] * c - partner * s : v[j] * c + partner * s;
    }
  }
  if constexpr (ROPE && NE == 1) {
    const int f = lane & 15; const float inv = exp2f(-(float)(2 * f) * (1.f / 32.f) * LOG2_THETA);
    const float partner = __shfl_xor(v[0], 16, 64);
    const float ang = (float)(lane < 32 ? prow : pcol) * inv;
    float rev = ang * INV2PI; rev -= floorf(rev);
    const float c = __builtin_amdgcn_cosf(rev), s = __builtin_amdgcn_sinf(rev);
    v[0] = (lane & 16) ? v[0] * c + partner * s : v[0] * c - partner * s;
  }
}

#define XB_TMO      128
#define XB_XCNT(j)  (256  + 64 * (j))
#define XB_XSUB(j)  (1280 + 64 * (j))
#define XB_XGEN(j)  (2304 + 64 * (j))
#define XB_TOP      3328
#define XB_TOPGEN   3392
#define XCD_BAR_WORDS 3456
#define XB_SPIN_CAP (1u << 22)
__device__ __forceinline__ unsigned xb_ld(unsigned* p)              { return __hip_atomic_load(p, __ATOMIC_RELAXED, __HIP_MEMORY_SCOPE_AGENT); }
__device__ __forceinline__ unsigned xb_add(unsigned* p, unsigned v) { return __hip_atomic_fetch_add(p, v, __ATOMIC_RELAXED, __HIP_MEMORY_SCOPE_AGENT); }
__device__ __forceinline__ unsigned xb_xcc_id() { return (unsigned)__builtin_amdgcn_s_getreg((3 << 11) | 20) & 0xFu; }
#define XB_SPIN(cond, bar) do { unsigned _sp = 0; while (cond) { __builtin_amdgcn_s_sleep(1); \
    if ((++_sp & 255u) == 0u) { if (xb_ld(&(bar)[XB_TMO])) break; if (_sp > XB_SPIN_CAP) { atomicAdd(&(bar)[XB_TMO], 1u); break; } } } } while (0)
struct XcdBarrier { unsigned* bar; unsigned x; volatile LAS unsigned* st; };
__device__ __forceinline__ XcdBarrier xcd_barrier_post(unsigned* bar, volatile LAS unsigned* st) {
  XcdBarrier b; b.bar = bar; b.x = xb_xcc_id(); b.st = st;
  if (threadIdx.x == 0) (void)xb_add(&bar[XB_XCNT(b.x)], 1u);
  return b;
}
__device__ __forceinline__ void xcd_barrier_complete(unsigned* bar, unsigned x, unsigned& nloc, unsigned& nx) {
  const unsigned G = gridDim.x * gridDim.y * gridDim.z;
  unsigned sum, cnt, mine, sp = 0u;
  for (;;) {
    sum = 0u; cnt = 0u; mine = 0u;
#pragma unroll
    for (unsigned j = 0; j < 16; ++j) { const unsigned c = xb_ld(&bar[XB_XCNT(j)]); sum += c; cnt += (c > 0u) ? 1u : 0u; mine = (j == x) ? c : mine; }
    if (sum == G) break;
    __builtin_amdgcn_s_sleep(1);
    if ((++sp & 255u) == 0u) { if (xb_ld(&bar[XB_TMO])) break; if (sp > XB_SPIN_CAP) { atomicAdd(&bar[XB_TMO], 1u); break; } }
  }
  nloc = mine > 0u ? mine : 1u; nx = cnt > 0u ? cnt : 1u;
}
__device__ __forceinline__ void xcd_barrier(const XcdBarrier& b) {
  asm volatile("s_waitcnt vmcnt(0)" ::: "memory");
  __syncthreads();
  if (threadIdx.x == 0) {
    unsigned* bar = b.bar;
    __builtin_amdgcn_s_waitcnt(0);
    unsigned nloc = b.st[0], nx = b.st[1];
    if (nloc == 0u) { xcd_barrier_complete(bar, b.x, nloc, nx); b.st[0] = nloc; b.st[1] = nx; }
    const unsigned old = xb_add(&bar[XB_XSUB(b.x)], 1u);
    const unsigned gen = old / nloc;
    if (old + 1u == (gen + 1u) * nloc) {
      __builtin_amdgcn_fence(__ATOMIC_RELEASE, "agent");
      asm volatile("s_waitcnt vmcnt(0)" ::: "memory");
      const unsigned og = xb_add(&bar[XB_TOP], 1u);
      const unsigned tg = og / nx;
      if (og + 1u == (tg + 1u) * nx) xb_add(&bar[XB_TOPGEN], 1u);
      else XB_SPIN(xb_ld(&bar[XB_TOPGEN]) == tg, bar);
      __builtin_amdgcn_fence(__ATOMIC_ACQUIRE, "agent");
      xb_add(&bar[XB_XGEN(b.x)], 1u);
      asm volatile("s_waitcnt vmcnt(0)" ::: "memory");
    } else {
      XB_SPIN(xb_ld(&bar[XB_XGEN(b.x)]) == gen, bar);
      __builtin_amdgcn_fence(__ATOMIC_ACQUIRE, "agent");
      asm volatile("s_waitcnt vmcnt(0)" ::: "memory");
    }
  }
  __syncthreads();
}

constexpr int LDS_MAIN = att::SHM_ATTN > pg8::STAGE_BYTES ? att::SHM_ATTN : pg8::STAGE_BYTES;
constexpr int LDS_BYTES = LDS_MAIN + 16;
static_assert(att::SHM_ATTN <= LDS_MAIN, "lds");
constexpr int NPHASE = 18;
#ifndef PHMASK
#define PHMASK 0xf
#endif
#ifndef STAG_GU
#define STAG_GU 0
#endif
#ifndef REPMASK
#define REPMASK 0
#endif
#ifndef A128_SD
#define A128_SD 1
#endif
#ifndef KARG
#define KARG 0
#endif
#define wt_in0 ((bf16_t*)(p.ws + WS_WT_IN0))
#define wt_qb ((bf16_t*)(p.ws + WS_WT_QB))
#define wt_kvb ((bf16_t*)(p.ws + WS_WT_KVB))
#define wt_out ((bf16_t*)(p.ws + WS_WT_OUT))
#define wt_memkv ((bf16_t*)(p.ws + WS_WT_MEMKV))
#define wt_gu ((bf16_t*)(p.ws + WS_WT_GU))
#define wt_dn ((bf16_t*)(p.ws + WS_WT_DN))
#define wt_in1 ((bf16_t*)(p.ws + WS_WT_IN1))
#define memn ((bf16_t*)(p.ws + WS_MEMN))
#define memkv ((bf16_t*)(p.ws + WS_MEMKV))
#define hbuf ((bf16_t*)(p.ws + WS_HM))
#define mix ((bf16_t*)(p.ws + WS_HM))
#define proj ((bf16_t*)(p.ws + WS_R))
#define act ((bf16_t*)(p.ws + WS_R))
#define qbuf ((bf16_t*)(p.ws + WS_Q))
#define kvbuf ((bf16_t*)(p.ws + WS_KV))

struct GemmJob { const bf16_t* A; int lda; const bf16_t* Bt; int M, N, K; int kind; bf16_t* O; int ldc; const float* res; int coff; const float* rs_in; float* rs_out; int stag; float inv_n; float* csq; float* ckv; };

__device__ __forceinline__ int gemm_jobs(const Params& p, int ph, int gi, GemmJob& j) {
  const float* x = p.in[0];
  j.M = NTOK; j.res = nullptr; j.coff = 0; j.O = nullptr; j.ldc = 0; j.rs_in = nullptr; j.rs_out = nullptr; j.stag = 0; j.inv_n = 1.f / DM; j.csq = nullptr; j.ckv = nullptr;
  float* rowss = (float*)(p.ws + WS_ROWSS); bf16_t* xbuf = (bf16_t*)(p.ws + WS_XB);
  switch (ph) {
  case 1:
    if (gi == 0) { j.A = hbuf; j.lda = 1024; j.Bt = wt_in0; j.N = 1280; j.K = 1024; j.kind = 0; j.O = proj; j.ldc = 1280; j.csq = rowss + 3 * (size_t)NTOK; j.ckv = rowss + 4 * (size_t)NTOK; }
    else { j.A = memn; j.lda = 1024; j.Bt = wt_memkv + (size_t)(gi - 1) * 1024 * 1024; j.M = NMEMROWS; j.N = 1024; j.K = 1024; j.kind = 0; j.O = memkv + (size_t)(gi - 1) * NMEMROWS * 1024; j.ldc = 1024; j.coff = (gi - 1) * 128; }
    return 3;
  case 3:
    if (gi == 0) { j.A = proj; j.lda = 1280; j.Bt = wt_qb; j.N = 1536; j.K = 384; j.kind = 0; j.O = qbuf; j.ldc = 1536; j.rs_in = rowss + 3 * (size_t)NTOK; j.inv_n = 1.f / 384.f; }
    else { j.A = proj + 384; j.lda = 1280; j.Bt = wt_kvb; j.N = 2048; j.K = 256; j.kind = 0; j.O = kvbuf; j.ldc = 2048; j.rs_in = rowss + 4 * (size_t)NTOK; j.inv_n = 1.f / 256.f; }
    return 2;
  case 6: case 14: { const int L = ph == 6 ? 0 : 1;
    j.A = mix; j.lda = 1536; j.Bt = wt_out + (size_t)L * 1024 * 1536; j.N = 1024; j.K = 1536; j.kind = 1; j.res = L == 0 ? x : p.out; j.rs_out = rowss + (size_t)(L == 0 ? 0 : 2) * NTOK; j.O = xbuf; return 1; }
  case 8: case 16: { const int L = ph == 8 ? 0 : 1;
    j.A = xbuf; j.lda = 1024; j.Bt = wt_gu + (size_t)L * 5632 * 1024; j.N = 5632; j.K = 1024; j.kind = 2; j.O = act; j.rs_in = rowss + (size_t)(L == 0 ? 0 : 2) * NTOK; j.stag = STAG_GU; return 1; }
  case 9: case 17: { const int L = ph == 9 ? 0 : 1;
    j.A = act; j.lda = DFF; j.Bt = wt_dn + (size_t)L * 1024 * 2816; j.N = 1024; j.K = DFF; j.kind = 1; j.res = p.out; if (L == 0) { j.rs_out = rowss + (size_t)NTOK; j.O = xbuf; } return 1; }
  case 11:
    j.A = xbuf; j.lda = 1024; j.Bt = wt_in1; j.N = 2048; j.K = 1024; j.kind = 0; j.O = proj; j.ldc = 2048; j.rs_in = rowss + (size_t)NTOK; return 1;
  default: return 0;
  }
}

__global__ __launch_bounds__(512) void mega(Params p_) {
  extern __shared__ __attribute__((aligned(16))) unsigned char shm[];
  LAS unsigned char* glds = (LAS unsigned char*)shm;
  char* alds = (char*)shm;
  const Params* pp = (const Params*)__builtin_amdgcn_kernarg_segment_ptr();
  const int ph_lo = p_.ph_lo, ph_hi = p_.ph_hi;
  volatile LAS unsigned* bst = (volatile LAS unsigned*)(glds + LDS_MAIN);
  if (threadIdx.x == 0) { bst[0] = 0u; bst[1] = 0u; }
  __syncthreads();
  const XcdBarrier xb = xcd_barrier_post((unsigned*)(p_.ws + WS_BAR), bst);
  if (ph_lo < 0) cg::this_grid().sync();

  for (int ph = ph_lo; ph < ph_hi; ++ph) {
    if (ph == 2 || ph == 7 || ph == 10 || ph == 15) continue;
#if KARG
    asm volatile("" : "+s"(pp));
    const Params& p = *pp;
#else
    const Params& p = p_;
#endif
    const float* x = p.in[0];
    for (int rep = 0; rep < 1 + ((REPMASK >> ph) & 1); ++rep) {
    const int tid_ = opaque_tid(), wid = tid_ >> 6, lane = tid_ & 63;
    const int gw = blockIdx.x * 8 + wid, nw = gridDim.x * 8;
    if (PHMASK & 1) switch (ph) {
    case 0: {
      prep_w<2>(p.in[11], 1024, 1216, wt_in0, 1280, nullptr);
      prep_w<3>(p.in[13], 384, 1536, wt_qb, 1536, p.in[12]);
      prep_w<0>(p.in[15], 256, 2048, wt_kvb, 2048, p.in[14]);
      for (int i = 0; i < 2; ++i) {
        prep_w<0>(p.in[5] + (size_t)i * 1536 * 1024, 1536, 1024, wt_out + (size_t)i * 1024 * 1536, 1024, nullptr);
        prep_w<0>(p.in[6] + (size_t)i * 1024 * 1024, 1024, 1024, wt_memkv + (size_t)i * 1024 * 1024, 1024, nullptr);
        prep_w<1>(p.in[9] + (size_t)i * 1024 * 5632, 1024, 5632, wt_gu + (size_t)i * 5632 * 1024, 5632, p.in[4] + i * 1024);
        prep_w<0>(p.in[10] + (size_t)i * 2816 * 1024, 2816, 1024, wt_dn + (size_t)i * 1024 * 2816, 1024, nullptr);
      }
      prep_w<0>(p.in[18], 1024, 2048, wt_in1, 2048, p.in[3] + 1024);
      for (int i = blockIdx.x * 512 + tid_; i < 5 * NTOK; i += gridDim.x * 512) ((float*)(p.ws + WS_ROWSS))[i] = 0.f;
      rms_rows(p.in[1], p.in[2], memn, NMEMROWS);
      rms_rows(x, p.in[3], hbuf, NTOK);
    } break;
    case 4: {
      const int l16 = lane & 15, l8 = lane & 7;
      float inv64[8], g_kn[8], g_kp[8];
#pragma unroll
      for (int j = 0; j < 8; ++j) inv64[j] = exp2f(-(float)(2 * ((l8 & 1) * 8 + j)) * (1.f / 32.f) * LOG2_THETA);
      load8(g_kn, p.in[17] + l16 * 8); load8(g_kp, p.in[17] + 128 + l8 * 8);
      const bool first64 = !(l8 & 2);
      const bool is_k = !((lane >> 4) & 1);
      for (int t = gw; t < NTOK; t += nw) {
        const int sq = t & (SEQ - 1); const float pos64 = (float)((l8 < 4) ? (sq >> 6) : (sq & 63));
        bf16_t* pr = proj + (size_t)t * 1280 + lane * 8; bf16_t* kvrow = kvbuf + (size_t)t * 2048 + lane * 8;
        const bool dry = ((REPMASK >> 4) & 1) && rep == 0; bf16_t* kvdst = dry ? (bf16_t*)p.out + (size_t)t * 2048 + lane * 8 : kvrow;
        u32x4 P2 = {0u, 0u, 0u, 0u}; if (lane >= 16 && lane < 24) P2 = *(const u32x4*)(pr + 1024);
        u32x4 KV0 = P2, KV1 = P2, KV2 = P2, KV3 = P2;
        if (is_k) { KV0 = *(const u32x4*)kvrow; KV1 = *(const u32x4*)(kvrow + 512); KV2 = *(const u32x4*)(kvrow + 1024); KV3 = *(const u32x4*)(kvrow + 1536); }
        float a[8], b[8];
        unpack8(P2, a);
        { const float s8 = group_sum<8>(sumsq8(a)); const float rsB = rsqrtf(s8 * (1.f / 64.f) + EPS);
#pragma unroll
          for (int j = 0; j < 8; ++j) b[j] = a[j] * rsB * g_kp[j];
          rope8<2>(b, inv64, pos64, first64);
          if (lane >= 16 && lane < 24 && !dry) *(u32x4*)(pr + 1024) = pack8(b); }
#define KCHUNK(W, OFF) do { unpack8(W, a); norm8<16>(a, g_kn); if (is_k) *(u32x4*)(kvdst + (OFF)) = pack8(a); } while (0)
        KCHUNK(KV0, 0); KCHUNK(KV1, 512); KCHUNK(KV2, 1024); KCHUNK(KV3, 1536);
#undef KCHUNK
      }
      if (!(((REPMASK >> 4) & 1) && rep == 0)) for (int r = gw; r < 2 * NMEMROWS; r += nw) {
        float g_mk[8]; load8(g_mk, p.in[8] + (r / NMEMROWS) * 128 + l16 * 8);
        bf16_t* row = memkv + (size_t)r * 1024 + lane * 8;
        float a[8]; unpack8(*(const u32x4*)row, a); norm8<16>(a, g_mk); *(u32x4*)row = pack8(a);
      }
    } break;
    case 7: case 15: rms_rows(p.out, p.in[4] + (ph == 7 ? 0 : 1024), hbuf, NTOK); break;
    case 10: rms_rows(p.out, p.in[3] + 1024, hbuf, NTOK); break;
    case 12: {
      const int l16 = lane & 15;
      float inv128[8], g_k[8];
#pragma unroll
      for (int j = 0; j < 8; ++j) inv128[j] = exp2f(-(float)(2 * ((l16 & 3) * 8 + j)) * (1.f / 64.f) * LOG2_THETA);
      load8(g_k, p.in[20] + l16 * 8);
      const bool first128 = !(l16 & 4);
      for (int t = gw; t < NTOK; t += nw) {
        const int sq = t & (SEQ - 1); const float pos128 = (float)((l16 < 8) ? (sq >> 6) : (sq & 63));
        bf16_t* row = proj + (size_t)t * 2048 + lane * 8;
        bf16_t* dst = (((REPMASK >> 12) & 1) && rep == 0) ? row + 128ull * MiB : row;
        const u32x4 W2 = *(const u32x4*)(row + 1024);
        float a[8];
        unpack8(W2, a); norm8<16>(a, g_k); rope8<4>(a, inv128, pos128, first128); if (lane < 32) *(u32x4*)(dst + 1024) = pack8(a);
      }
    } break;
    default: break;
    }
    if (PHMASK & 2) {
      GemmJob j; const int ng = gemm_jobs(p, ph, 0, j);
      for (int gi = 0; gi < ng; ++gi) {
        if (gi) gemm_jobs(p, ph, gi, j);
        if (j.kind == 0) pg8::run_gemm(glds, j.A, j.lda, j.Bt, j.M, j.N, j.K, pg8::EpiBf16{j.O, j.ldc, j.rs_in, j.inv_n, j.csq, j.ckv}, j.coff, j.stag);
        else if (j.kind == 1) pg8::run_gemm(glds, j.A, j.lda, j.Bt, j.M, j.N, j.K, pg8::EpiResF32{p.out, j.res, j.rs_out ? j.O : nullptr, j.rs_out}, j.coff, j.stag);
        else pg8::run_gemm(glds, j.A, j.lda, j.Bt, j.M, j.N, j.K, pg8::EpiSwiGLU{j.O, j.rs_in}, j.coff, j.stag);
      }
    }
    if ((PHMASK & 12) && (ph == 5 || ph == 13)) {
      const int L = ph == 5 ? 0 : 1;
      att::AttnJob a; a.qgain = nullptr; a.rsq = nullptr; a.qrope = 1;
      if (L == 0) {
        a.Q = qbuf; a.Q2 = qbuf + 1024; a.ldq = 1536; a.qhs = 128; a.K = kvbuf; a.ldk = 2048; a.khs = 256; a.kbs = (long)SEQ * 2048; a.K2 = proj + 1152; a.ldk2 = 1280;
        a.V = kvbuf + 128; a.ldv = 2048; a.O = mix; a.H = 8; a.gshift = 0; a.seq = SEQ; a.nunits = 2048; a.scale = 0.072168783648703220f; a.qgain = p.in[16];
        if (PHMASK & 4) att::run_attn<192, 1>(a, alds, glds);
      } else {
        a.Q = proj; a.Q2 = proj; a.ldq = 2048; a.qhs = 128; a.K = proj + 1024; a.ldk = 2048; a.khs = 128; a.kbs = (long)SEQ * 2048; a.K2 = proj; a.ldk2 = 0;
        a.V = proj + 1280; a.ldv = 2048; a.O = mix; a.H = 8; a.gshift = 2; a.seq = SEQ; a.nunits = 2048; a.scale = 0.088388347648318440f; a.qgain = p.in[19];
      }
      for (int pass = (L == 0 ? 1 : 0); pass < 2; ++pass) {
        if (pass == 1) {
          a.Q = L == 0 ? proj + 640 : proj + 1536; a.Q2 = a.Q; a.ldq = L == 0 ? 1280 : 2048; a.qhs = 128;
          a.K = memkv + (size_t)L * NMEMROWS * 1024; a.ldk = 1024; a.khs = 128; a.kbs = 256 * 1024; a.K2 = a.K; a.ldk2 = 0;
          a.V = a.K + 512; a.ldv = 1024; a.O = mix + 1024; a.H = 4; a.gshift = 0; a.seq = 256; a.nunits = 1024; a.scale = 0.088388347648318440f; a.qgain = p.in[7] + L * 128; a.qrope = 0;
        }
        if (PHMASK & 8) att::run_attn<128, A128_SD>(a, alds, glds);
      }
    }
    }
    if (ph + 1 < ph_hi) xcd_barrier(xb);
  }
}

extern "C" void kernel_launch(void* const* d_in, const int* in_sizes, int n_in, void* d_out, int out_size, void* d_ws, size_t ws_size, hipStream_t stream) {
  static int grid = 0;
  if (grid == 0) {
    if (n_in != 21 || in_sizes[0] != NTOK * DM || out_size != NTOK * DM || ws_size < WS_END) {
      fprintf(stderr, "kernel_launch: shape/workspace mismatch (n_in %d, in0 %d, out %d, ws %zu, need %zu)\n", n_in, n_in > 0 ? in_sizes[0] : -1, out_size, ws_size, (size_t)WS_END);
      grid = -1; return; }
    int dev = 0, cus = 0, per_cu = 0;
    (void)hipGetDevice(&dev); (void)hipDeviceGetAttribute(&cus, hipDeviceAttributeMultiprocessorCount, dev);
    if (hipFuncSetAttribute((const void*)mega, hipFuncAttributeMaxDynamicSharedMemorySize, LDS_BYTES) != hipSuccess) { fprintf(stderr, "kernel_launch: hipFuncSetAttribute failed\n"); grid = -1; return; }
    if (hipOccupancyMaxActiveBlocksPerMultiprocessor(&per_cu, (const void*)mega, 512, LDS_BYTES) != hipSuccess || per_cu < 1) { fprintf(stderr, "kernel_launch: occupancy query says %d\n", per_cu); per_cu = 1; }
    (void)hipGetLastError();
    grid = cus * 1;
    if (grid <= 0) grid = 256;
  }
  if (grid < 0) return;
  if (hipMemsetAsync((char*)d_ws + WS_BAR, 0, XCD_BAR_WORDS * 4, stream) != hipSuccess) { fprintf(stderr, "kernel_launch: memset of barrier words failed\n"); return; }
  Params p{};
  for (int i = 0; i < 21; ++i) p.in[i] = (const float*)d_in[i];
  p.out = (float*)d_out; p.ws = (unsigned char*)d_ws;
#if MK_ONE_LAUNCH
  p.ph_lo = 0; p.ph_hi = NPHASE;
  void* args[] = {&p};
  hipError_t e = hipLaunchCooperativeKernel((const void*)mega, dim3(grid), dim3(512), args, LDS_BYTES, stream);
  if (e != hipSuccess) fprintf(stderr, "kernel_launch: cooperative launch failed: %s (grid %d)\n", hipGetErrorString(e), grid);
#else
  for (int ph = 0; ph < NPHASE; ++ph) {
    p.ph_lo = ph; p.ph_hi = ph + 1;
    hipLaunchKernelGGL(mega, dim3(grid), dim3(512), LDS_BYTES, stream, p);
  }
#endif
}
```

```cpp
#include <hip/hip_runtime.h>
#include <hip/hip_cooperative_groups.h>
#include <cstdio>
#include <cstdint>
namespace cg = cooperative_groups;

#ifndef MK_ONE_LAUNCH
#define MK_ONE_LAUNCH 1
#endif

typedef unsigned short bf16_t;
typedef short bf16x8 __attribute__((ext_vector_type(8)));
typedef short s16x4 __attribute__((ext_vector_type(4)));
typedef float f32x4 __attribute__((ext_vector_type(4)));
typedef float f32x16 __attribute__((ext_vector_type(16)));
typedef unsigned u32x4 __attribute__((ext_vector_type(4)));
typedef unsigned u32x2 __attribute__((ext_vector_type(2)));
#define LAS __attribute__((address_space(3)))

constexpr int NTOK = 65536, SEQ = 8192, DM = 1024, DFF = 2816, NMEMROWS = 2048;
constexpr float EPS = 1e-6f;
constexpr float LOG2_THETA = 13.287712379549449f;
constexpr float INV2PI = 0.15915494309189535f;
constexpr size_t MiB = 1ull << 20;
constexpr size_t WS_WT_IN0 = 0;
constexpr size_t WS_WT_QB = WS_WT_IN0 + 1280ull * 1024 * 2;
constexpr size_t WS_WT_KVB = WS_WT_QB + 1536ull * 384 * 2;
constexpr size_t WS_WT_OUT = WS_WT_KVB + 2048ull * 256 * 2;
constexpr size_t WS_WT_MEMKV = WS_WT_OUT + 2ull * 1024 * 1536 * 2;
constexpr size_t WS_WT_GU = WS_WT_MEMKV + 2ull * 1024 * 1024 * 2;
constexpr size_t WS_WT_DN = WS_WT_GU + 2ull * 5632 * 1024 * 2;
constexpr size_t WS_WT_IN1 = WS_WT_DN + 2ull * 1024 * 2816 * 2;
constexpr size_t WS_WT_END = WS_WT_IN1 + 2048ull * 1024 * 2;
static_assert(WS_WT_END <= 56 * MiB, "weights region");
constexpr size_t WS_MEMN = 56 * MiB;
constexpr size_t WS_MEMKV = 60 * MiB;
constexpr size_t WS_BAR = 70 * MiB;
constexpr size_t WS_ROWSS = 70 * MiB + 65536;
constexpr size_t WS_HM = 72 * MiB;
constexpr size_t WS_R = 264 * MiB;
constexpr size_t WS_Q = WS_R + 160 * MiB;
constexpr size_t WS_KV = WS_Q + 192 * MiB;
constexpr size_t WS_XB = WS_R + 352 * MiB;
constexpr size_t WS_END = WS_KV + 256 * MiB;

struct Params { const float* in[21]; float* out; unsigned char* ws; int ph_lo, ph_hi; };

__device__ __forceinline__ float bf2f(bf16_t v) { return __uint_as_float(((unsigned)v) << 16); }
__device__ __forceinline__ bf16_t f2bf(float f) { unsigned u = __float_as_uint(f); u += 0x7FFFu + ((u >> 16) & 1u); return (bf16_t)(u >> 16); }
__device__ __forceinline__ unsigned cvtpk(float lo, float hi) { unsigned r; asm volatile("v_cvt_pk_bf16_f32 %0, %1, %2" : "=v"(r) : "v"(lo), "v"(hi)); return r; }
__device__ __forceinline__ float wave_sum(float v) {
#pragma unroll
  for (int o = 32; o > 0; o >>= 1) v += __shfl_xor(v, o, 64);
  return v;
}

__device__ __forceinline__ int opaque_tid() { int t = threadIdx.x; asm volatile("" : "+v"(t)); return t; }

namespace pg8 {
constexpr int BM = 256, BK = 64, HALF = 128, HTB = HALF * BK * 2, STAGE_BYTES = 8 * HTB, NXCD = 8, WGM = 4;
__device__ __forceinline__ int lds_byte(int r, int c) { const int st = (r >> 4) * 2 + (c >> 5), rr = r & 15, cc = c & 31, ob = rr * 64 + cc * 2; return st * 1024 + (ob ^ (((ob >> 9) & 1) << 5)); }
__device__ __forceinline__ void stage_rc(int b, int& R, int& C) { const int st = b / 1024, sb = b % 1024, swz = sb ^ (((sb >> 9) & 1) << 5); R = (st >> 1) * 16 + swz / 64; C = (st & 1) * 32 + (swz % 64) / 2; }
__device__ __forceinline__ int perm32(int rho) { const int n = rho >> 4, i = rho & 15; return 8 * (i >> 2) + 4 * n + (i & 3); }
struct Unit { int pm, pn; };
struct Gemm { const bf16_t* A; const bf16_t* Bt; int M, N, K, lda; };
struct StaticOrder {
  int nM, nN, nwg, G, c;
  __device__ void init(int M, int N, int G_, int c_) { nM = M / BM; nN = N / BM; nwg = nM * nN; G = G_; c = c_; }
  __device__ bool next(int i, Unit& u) const {
    const long L = (long)i * G + c; if (L >= nwg) return false;
    int wgid = (int)L; { const int q = nwg / NXCD, r = nwg % NXCD, xcd = wgid % NXCD, off = wgid / NXCD; wgid = (xcd < r ? xcd * (q + 1) : r * (q + 1) + (xcd - r) * q) + off; }
    const int nig = WGM * nN, gid = wgid / nig, fm = gid * WGM, gsz = (nM - fm) < WGM ? (nM - fm) : WGM;
    u.pm = fm + ((wgid % nig) % gsz); u.pn = (wgid % nig) / gsz; return true;
  }
};

struct EpiBf16 {
  static constexpr bool PERM = true;
  bf16_t* O; int ldc; const float* rowss; float inv_n; float* csq; float* ckv;
  __device__ __forceinline__ void pre(const Unit& u, int wr, int fr, float (&rsv)[2][4]) const {
    const int row0 = u.pm * BM + wr * 64 + fr;
#pragma unroll
    for (int ai = 0; ai < 2; ++ai)
#pragma unroll
      for (int m = 0; m < 4; ++m) rsv[ai][m] = rowss ? rowss[row0 + ai * HALF + m * 16] : 0.f;
  }
  __device__ __forceinline__ void operator()(const f32x4 (&acc)[2][2][4][2], const Unit& u, int wr, int wc, int fr, int fq, const float (&rsv)[2][4]) const {
    const int row0 = u.pm * BM + wr * 64 + fr, col0 = u.pn * BM + wc * 32 + 8 * fq;
    float* tgt0 = nullptr; float* tgt1 = nullptr;
    if (csq) { if (u.pn == 0) { tgt0 = csq; tgt1 = csq; } else if (u.pn == 1) { tgt0 = csq; tgt1 = ckv; } else if (u.pn == 2) { tgt0 = ckv; } }
#pragma unroll
    for (int ai = 0; ai < 2; ++ai)
#pragma unroll
      for (int m = 0; m < 4; ++m) { const int row = row0 + ai * HALF + m * 16; bf16_t* rowp = O + (size_t)row * ldc + col0;
        const float rs = rowss ? rsqrtf(rsv[ai][m] * inv_n + EPS) : 1.f;
#pragma unroll
        for (int bj = 0; bj < 2; ++bj) { const f32x4 v0 = acc[ai][bj][m][0] * rs, v1 = acc[ai][bj][m][1] * rs;
          u32x4 w; w.x = cvtpk(v0[0], v0[1]); w.y = cvtpk(v0[2], v0[3]); w.z = cvtpk(v1[0], v1[1]); w.w = cvtpk(v1[2], v1[3]);
          *(u32x4*)(rowp + bj * HALF) = w;
          float* tg = bj ? tgt1 : tgt0;
          if (tg) { float ss = v0[0] * v0[0] + v0[1] * v0[1] + v0[2] * v0[2] + v0[3] * v0[3] + v1[0] * v1[0] + v1[1] * v1[1] + v1[2] * v1[2] + v1[3] * v1[3];
            ss += __shfl_xor(ss, 16, 64); ss += __shfl_xor(ss, 32, 64); if (fq == 0) unsafeAtomicAdd(tg + row, ss); } } }
  }
};
struct EpiResF32 {
  static constexpr bool PERM = false;
  const float* res32; const bf16_t* res16; float* out32; bf16_t* xb; float* rowss;
  __device__ __forceinline__ void pre(const Unit&, int, int, float (&)[2][4]) const {}
  __device__ __forceinline__ void operator()(const f32x4 (&acc)[2][2][4][2], const Unit& u, int wr, int wc, int fr, int fq, const float (&)[2][4]) const {
    const int row0 = u.pm * BM + wr * 64 + fr, col0 = u.pn * BM + wc * 32 + 4 * fq;
    u32x4 r[2][2][2][2];
#define ER_LOAD(buf, ai, mp) do { _Pragma("unroll") for (int mm = 0; mm < 2; ++mm) { const size_t off = (size_t)(row0 + (ai) * HALF + ((mp) + mm) * 16) * DM + col0; \
      _Pragma("unroll") for (int bj = 0; bj < 2; ++bj) _Pragma("unroll") for (int n = 0; n < 2; ++n) { \
        if (res32) r[buf][mm][bj][n] = *(const u32x4*)(res32 + off + bj * HALF + n * 16); \
        else { const u32x2 w_ = *(const u32x2*)(res16 + off + bj * HALF + n * 16); r[buf][mm][bj][n].x = w_.x; r[buf][mm][bj][n].y = w_.y; } } } } while (0)
#define ER_STORE(buf, ai, mp) do { _Pragma("unroll") for (int mm = 0; mm < 2; ++mm) { const int row = row0 + (ai) * HALF + ((mp) + mm) * 16; const size_t off = (size_t)row * DM + col0; float ss = 0.f; \
      _Pragma("unroll") for (int bj = 0; bj < 2; ++bj) _Pragma("unroll") for (int n = 0; n < 2; ++n) { const u32x4 q_ = r[buf][mm][bj][n]; f32x4 rv; \
        if (res32) { rv[0] = __uint_as_float(q_.x); rv[1] = __uint_as_float(q_.y); rv[2] = __uint_as_float(q_.z); rv[3] = __uint_as_float(q_.w); } \
        else { rv[0] = __uint_as_float(q_.x << 16); rv[1] = __uint_as_float(q_.x & 0xffff0000u); rv[2] = __uint_as_float(q_.y << 16); rv[3] = __uint_as_float(q_.y & 0xffff0000u); } \
        const f32x4 v = rv + acc[ai][bj][(mp) + mm][n]; \
        if (out32) *(f32x4*)(out32 + off + bj * HALF + n * 16) = v; \
        if (xb) { u32x2 w; w.x = cvtpk(v[0], v[1]); w.y = cvtpk(v[2], v[3]); *(u32x2*)(xb + off + bj * HALF + n * 16) = w; ss += v[0] * v[0] + v[1] * v[1] + v[2] * v[2] + v[3] * v[3]; } } \
      if (xb) { ss += __shfl_xor(ss, 16, 64); ss += __shfl_xor(ss, 32, 64); if (fq == 0) unsafeAtomicAdd(rowss + row, ss); } } } while (0)
    ER_LOAD(0, 0, 0); ER_LOAD(1, 0, 2);
    ER_STORE(0, 0, 0); ER_LOAD(0, 1, 0);
    ER_STORE(1, 0, 2); ER_LOAD(1, 1, 2);
    ER_STORE(0, 1, 0); ER_STORE(1, 1, 2);
#undef ER_LOAD
#undef ER_STORE
  }
};
struct EpiSwiGLU {
  static constexpr bool PERM = true;
  bf16_t* O; const float* rowss;
  __device__ __forceinline__ void pre(const Unit& u, int wr, int fr, float (&rsv)[2][4]) const {
    const int row0 = u.pm * BM + wr * 64 + fr;
#pragma unroll
    for (int ai = 0; ai < 2; ++ai)
#pragma unroll
      for (int m = 0; m < 4; ++m) rsv[ai][m] = rowss[row0 + ai * HALF + m * 16];
  }
  __device__ __forceinline__ void operator()(const f32x4 (&acc)[2][2][4][2], const Unit& u, int wr, int wc, int fr, int fq, const float (&rsv)[2][4]) const {
    const int row0 = u.pm * BM + wr * 64 + fr, col0 = u.pn * HALF + wc * 32 + 8 * fq;
#pragma unroll
    for (int ai = 0; ai < 2; ++ai)
#pragma unroll
      for (int m = 0; m < 4; ++m) { const int row = row0 + ai * HALF + m * 16; bf16_t* rowp = O + (size_t)row * DFF + col0;
        const float rs = rsqrtf(rsv[ai][m] * (1.f / DM) + EPS);
        float y[8];
#pragma unroll
        for (int n = 0; n < 2; ++n)
#pragma unroll
          for (int j = 0; j < 4; ++j) { const float g = acc[ai][0][m][n][j] * rs, up = acc[ai][1][m][n][j] * rs;
            const float e = __builtin_amdgcn_exp2f(-g * 1.4426950408889634f);
            y[n * 4 + j] = g * __builtin_amdgcn_rcpf(1.0f + e) * up; }
        u32x4 w; w.x = cvtpk(y[0], y[1]); w.y = cvtpk(y[2], y[3]); w.z = cvtpk(y[4], y[5]); w.w = cvtpk(y[6], y[7]);
        __builtin_nontemporal_store(w, (u32x4*)rowp); }
  }
};

template <class Epi>
__device__ __forceinline__ void gemm_phase(LAS unsigned char* lds, const Gemm g, const StaticOrder& S, const Epi& E) {
  const int tid = opaque_tid(), wid = __builtin_amdgcn_readfirstlane(tid >> 6), lane = tid & 63, wr = wid >> 2, wc = wid & 3, fr = lane & 15, fq = lane >> 4;
  const int K = g.K, nt = K / BK, lda = g.lda;
  unsigned voffA[2], voffB[2];
#pragma unroll
  for (int i = 0; i < 2; ++i) { int R, C; stage_rc(tid * 16 + i * 8192, R, C); const int Rb = Epi::PERM ? ((R & ~31) + perm32(R & 31)) : R;
    voffA[i] = (unsigned)(R * lda + C) * 2u; voffB[i] = (unsigned)(Rb * K + C) * 2u; }
  const size_t kstep = (size_t)(BK * 2);
  const size_t hstepA = (size_t)HALF * lda * 2, hstepB = (size_t)HALF * K * 2;
  const size_t tstepA = 2 * hstepA, tstepB = 2 * hstepB;
  const unsigned ldsw = (unsigned)wid * 1024u;
  const int aoff = lds_byte(wr * 64 + fr, fq * 8), boff = lds_byte(wc * 32 + fr, fq * 8);
#define PG8_SA(b, h) (((b) * 2 + (h)) * HTB)
#define PG8_SB(b, h) ((4 + (b) * 2 + (h)) * HTB)
#define PG8_STAGE(bufoff, gbase, voff) do { _Pragma("unroll") for (int _i = 0; _i < 2; ++_i) \
    __builtin_amdgcn_global_load_lds((const unsigned*)((const char*)(gbase) + (voff)[_i]), (LAS unsigned*)(lds + (bufoff) + ldsw + _i * 8192), 16, 0, 0); } while (0)
#define PG8_LDA(dst, b, h) do { _Pragma("unroll") for (int m = 0; m < 4; ++m) _Pragma("unroll") for (int k = 0; k < 2; ++k) dst[m][k] = *(const LAS bf16x8*)(lds + PG8_SA(b, h) + aoff + m * 2048 + k * 1024); } while (0)
#define PG8_LDB(dst, b, h) do { _Pragma("unroll") for (int n = 0; n < 2; ++n) _Pragma("unroll") for (int k = 0; k < 2; ++k) dst[n][k] = *(const LAS bf16x8*)(lds + PG8_SB(b, h) + boff + n * 2048 + k * 1024); } while (0)
#define PG8_MMA(ai, bj, At, Bt) do { __builtin_amdgcn_s_setprio(1); _Pragma("unroll") for (int m = 0; m < 4; ++m) _Pragma("unroll") for (int n = 0; n < 2; ++n) _Pragma("unroll") for (int k = 0; k < 2; ++k) \
    acc[ai][bj][m][n] = __builtin_amdgcn_mfma_f32_16x16x32_bf16(Bt[n][k], At[m][k], acc[ai][bj][m][n], 0, 0, 0); __builtin_amdgcn_s_setprio(0); } while (0)
#define PG8_WAIT_V(n) asm volatile("s_waitcnt vmcnt(" #n ")" ::: "memory")
#define PG8_WAIT_L(n) asm volatile("s_waitcnt lgkmcnt(" #n ")" ::: "memory")
#define PG8_BAR __builtin_amdgcn_s_barrier()
#define PG8_SCHED __builtin_amdgcn_sched_barrier(0)
  Unit cur, nxt; int ui = 0;
  if (!S.next(0, cur)) return;
  f32x4 acc[2][2][4][2];
#pragma unroll
  for (int a = 0; a < 2; ++a)
#pragma unroll
    for (int b = 0; b < 2; ++b)
#pragma unroll
      for (int m = 0; m < 4; ++m)
#pragma unroll
        for (int n = 0; n < 2; ++n) acc[a][b][m][n] = (f32x4){0.f, 0.f, 0.f, 0.f};
  bf16x8 At[4][2], B0[2][2], B1[2][2];
  float rsv[2][4] = {};
  const char* cA = (const char*)g.A + (size_t)cur.pm * tstepA; const char* cB = (const char*)g.Bt + (size_t)cur.pn * tstepB;
  PG8_STAGE(PG8_SB(0, 0), cB, voffB); PG8_STAGE(PG8_SA(0, 0), cA, voffA); PG8_STAGE(PG8_SB(0, 1), cB + hstepB, voffB); PG8_STAGE(PG8_SA(0, 1), cA + hstepA, voffA);
  if (wr == 1) PG8_BAR;
  PG8_WAIT_V(4); PG8_BAR;
  PG8_STAGE(PG8_SB(1, 0), cB + kstep, voffB); PG8_STAGE(PG8_SA(1, 0), cA + kstep, voffA); PG8_STAGE(PG8_SB(1, 1), cB + hstepB + kstep, voffB);
  PG8_WAIT_V(6); PG8_BAR;
  for (;;) {
    const bool has_next = S.next(ui + 1, nxt);
    const char* nA = has_next ? (const char*)g.A + (size_t)nxt.pm * tstepA : cA; const char* nB = has_next ? (const char*)g.Bt + (size_t)nxt.pn * tstepB : cB;
    for (int t = 0; t < nt; t += 2) {
      const bool last = (t == nt - 2);
      if (last) E.pre(cur, wr, fr, rsv);
      const char* a1 = cA + (size_t)(t + 1) * kstep;
      const char* a2 = last ? nA : cA + (size_t)(t + 2) * kstep; const char* b2 = last ? nB : cB + (size_t)(t + 2) * kstep;
      const char* a3 = a2 + kstep; const char* b3 = b2 + kstep;
      PG8_LDB(B0, 0, 0); PG8_SCHED; PG8_LDA(At, 0, 0); PG8_STAGE(PG8_SA(1, 1), a1 + hstepA, voffA);
      PG8_WAIT_L(8); PG8_BAR; PG8_WAIT_L(0); PG8_MMA(0, 0, At, B0); PG8_BAR; PG8_SCHED;
      PG8_LDB(B1, 0, 1); PG8_STAGE(PG8_SB(0, 0), b2, voffB);
      PG8_BAR; PG8_WAIT_L(0); PG8_MMA(0, 1, At, B1); PG8_BAR;
      PG8_LDA(At, 0, 1); PG8_STAGE(PG8_SA(0, 0), a2, voffA);
      PG8_BAR; PG8_WAIT_L(0); PG8_MMA(1, 0, At, B0); PG8_BAR; PG8_SCHED;
      PG8_STAGE(PG8_SB(0, 1), b2 + hstepB, voffB);
      PG8_WAIT_V(6); PG8_BAR; PG8_MMA(1, 1, At, B1); PG8_BAR;
      PG8_LDB(B0, 1, 0); PG8_SCHED; PG8_LDA(At, 1, 0); PG8_STAGE(PG8_SA(0, 1), a2 + hstepA, voffA);
      PG8_WAIT_L(8); PG8_BAR; PG8_WAIT_L(0); PG8_MMA(0, 0, At, B0); PG8_BAR; PG8_SCHED;
      PG8_LDB(B1, 1, 1); PG8_STAGE(PG8_SB(1, 0), b3, voffB);
      PG8_BAR; PG8_WAIT_L(0); PG8_MMA(0, 1, At, B1); PG8_BAR;
      PG8_LDA(At, 1, 1); PG8_STAGE(PG8_SA(1, 0), a3, voffA);
      PG8_BAR; PG8_WAIT_L(0); PG8_MMA(1, 0, At, B0); PG8_BAR; PG8_SCHED;
      PG8_STAGE(PG8_SB(1, 1), b3 + hstepB, voffB);
      PG8_WAIT_V(6); PG8_BAR; PG8_MMA(1, 1, At, B1); PG8_BAR;
    }
    E(acc, cur, wr, wc, fr, fq, rsv);
    if (!has_next) break;
#pragma unroll
    for (int a = 0; a < 2; ++a)
#pragma unroll
      for (int b = 0; b < 2; ++b)
#pragma unroll
        for (int m = 0; m < 4; ++m)
#pragma unroll
          for (int n = 0; n < 2; ++n) acc[a][b][m][n] = (f32x4){0.f, 0.f, 0.f, 0.f};
    cur = nxt; cA = nA; cB = nB; ++ui;
  }
  PG8_WAIT_V(0);
  if (wr == 0) PG8_BAR;
  PG8_BAR;
#undef PG8_SA
#undef PG8_SB
#undef PG8_STAGE
#undef PG8_LDA
#undef PG8_LDB
#undef PG8_MMA
#undef PG8_WAIT_V
#undef PG8_WAIT_L
#undef PG8_BAR
#undef PG8_SCHED
}
template <class Epi>
__device__ __forceinline__ void run_gemm(LAS unsigned char* lds, const bf16_t* A, int lda, const bf16_t* Bt, int M, int N, int K, const Epi& E, int coff, int stagger_ticks) {
  if (stagger_ticks > 0) {
    const unsigned long long t0 = __builtin_amdgcn_s_memrealtime(); const unsigned long long d = (unsigned long long)(((blockIdx.x >> 3) & 7) * stagger_ticks) >> 3;
    while (__builtin_amdgcn_s_memrealtime() - t0 < d) __builtin_amdgcn_s_sleep(8);
  }
  Gemm g{A, Bt, M, N, K, lda};
  StaticOrder S; S.init(M, N, (int)gridDim.x, (int)((blockIdx.x + coff) % gridDim.x));
  gemm_phase<Epi>(lds, g, S, E);
}
}

namespace att {
constexpr int NW = 8, QBLK = 32, KVBLK = 64;
constexpr float THR = 8.f;
constexpr int SHM_V = KVBLK * 128 * 2, SHM_K = KVBLK * 128 * 2, SHM_K2 = KVBLK * 64 * 2;
constexpr int NBUF = 3;
constexpr int OFF_K = NBUF * SHM_V, OFF_K2 = OFF_K + NBUF * SHM_K, OFF_WS = OFF_K2 + NBUF * SHM_K2, OFF_Q2 = OFF_WS + NW * 64 * 4, SHM_ATTN = OFF_Q2 + 32768;
#define KSWZ(row, colB) ((row) * 256 + ((colB) ^ (((row) & 7) << 4)))
#define K2SWZ(row, colB) ((row) * 128 + ((colB) ^ ((((row) >> 1) & 7) << 4)))
#define SBAR() __builtin_amdgcn_sched_barrier(0)
__device__ __forceinline__ int crow(int r, int hi) { return (r & 3) + 8 * (r >> 2) + 4 * hi; }
__device__ __forceinline__ void partialSM(f32x16& p0, f32x16& p1, float& m_reg, float& mn, float& alpha, float C, float thr_s) {
  float pmax = p0[0];
#pragma unroll
  for (int r = 1; r < 16; ++r) pmax = fmaxf(pmax, p0[r]);
#pragma unroll
  for (int r = 0; r < 16; ++r) pmax = fmaxf(pmax, p1[r]);
  { auto rr = __builtin_amdgcn_permlane32_swap(__float_as_uint(pmax), __float_as_uint(pmax), false, false);
    pmax = fmaxf(__uint_as_float(rr[0]), __uint_as_float(rr[1])); }
  if (__builtin_expect(__all(pmax - m_reg <= thr_s), 1)) { mn = m_reg; alpha = 1.f; }
  else { mn = fmaxf(m_reg, pmax); alpha = __builtin_amdgcn_exp2f((m_reg - mn) * C); m_reg = mn; }
  float mnC = -mn * C;
#pragma unroll
  for (int r = 0; r < 16; ++r) p0[r] = fmaf(p0[r], C, mnC);
#pragma unroll
  for (int r = 0; r < 16; ++r) p1[r] = fmaf(p1[r], C, mnC);
#pragma unroll
  for (int r = 0; r < 16; ++r) p0[r] = __builtin_amdgcn_exp2f(p0[r]);
}
__device__ __forceinline__ void finishSM(f32x16& p0, f32x16& p1, float alpha, float& l_reg, bf16x8& pa0, bf16x8& pa1, bf16x8& pa2, bf16x8& pa3) {
#pragma unroll
  for (int r = 0; r < 16; ++r) p1[r] = __builtin_amdgcn_exp2f(p1[r]);
  float ps = 0;
#pragma unroll
  for (int r = 0; r < 16; ++r) ps += p0[r];
#pragma unroll
  for (int r = 0; r < 16; ++r) ps += p1[r];
  { auto rr = __builtin_amdgcn_permlane32_swap(__float_as_uint(ps), __float_as_uint(ps), false, false);
    ps = __uint_as_float(rr[0]) + __uint_as_float(rr[1]); }
  l_reg = l_reg * alpha + ps;
#define PK4(P, BASE, OUT) do { unsigned a0 = cvtpk(P[BASE + 0], P[BASE + 1]), a1 = cvtpk(P[BASE + 2], P[BASE + 3]);   \
    unsigned b0 = cvtpk(P[BASE + 4], P[BASE + 5]), b1 = cvtpk(P[BASE + 6], P[BASE + 7]);                              \
    auto r0 = __builtin_amdgcn_permlane32_swap(a0, b0, false, false); auto r1 = __builtin_amdgcn_permlane32_swap(a1, b1, false, false); \
    u32x4 w = {r0[0], r1[0], r0[1], r1[1]}; OUT = *reinterpret_cast<bf16x8*>(&w); } while (0)
  PK4(p0, 0, pa0); PK4(p0, 8, pa1); PK4(p1, 0, pa2); PK4(p1, 8, pa3);
#undef PK4
}
template <int DQK>
__device__ __forceinline__ void qkt(f32x16& p0, f32x16& p1, const char* Ks, const char* K2s, const bf16x8* qr, const char* q2l, int r32, int hi) {
#pragma unroll
  for (int r = 0; r < 16; ++r) { p0[r] = 0.f; p1[r] = 0.f; }
#pragma unroll
  for (int d0 = 0; d0 < 8; ++d0) { int cb = (d0 * 16 + hi * 8) * 2;
    bf16x8 b0 = *reinterpret_cast<const bf16x8*>(Ks + KSWZ(r32, cb));
    bf16x8 b1 = *reinterpret_cast<const bf16x8*>(Ks + KSWZ(32 + r32, cb));
    p0 = __builtin_amdgcn_mfma_f32_32x32x16_bf16(b0, qr[d0], p0, 0, 0, 0);
    p1 = __builtin_amdgcn_mfma_f32_32x32x16_bf16(b1, qr[d0], p1, 0, 0, 0); }
  if constexpr (DQK == 192) {
#pragma unroll
    for (int d0 = 0; d0 < 4; ++d0) { int cb = (d0 * 16 + hi * 8) * 2;
      bf16x8 b0 = *reinterpret_cast<const bf16x8*>(K2s + K2SWZ(r32, cb));
      bf16x8 b1 = *reinterpret_cast<const bf16x8*>(K2s + K2SWZ(32 + r32, cb));
      const bf16x8 q2 = *reinterpret_cast<const bf16x8*>(q2l + d0 * 1024);
      p0 = __builtin_amdgcn_mfma_f32_32x32x16_bf16(b0, q2, p0, 0, 0, 0);
      p1 = __builtin_amdgcn_mfma_f32_32x32x16_bf16(b1, q2, p1, 0, 0, 0); }
  }
}
__device__ __forceinline__ int v_st(int k, int c) { const int kk = (k & ~0xC) | ((k & 4) << 1) | ((k & 8) >> 1); return ((kk >> 3) * 4 + (c >> 5)) * 512 + ((kk & 7) * 32 + (c & 31)) * 2; }
__device__ __forceinline__ int v_rd_base(int lane) { return ((lane & 3) << 3) | (((lane >> 2) & 3) << 6) | (((lane >> 4) & 1) << 5) | (((lane >> 5) & 1) << 8); }
constexpr int v_rd_off(int d0, int ks, int half) { return d0 * 512 + ks * 4096 + half * 2048; }
template <int OFF> __device__ __forceinline__ s16x4 tr_read(int vb) {
  s16x4 r; asm volatile("ds_read_b64_tr_b16 %0, %1 offset:%2" : "=&v"(r) : "v"(vb), "i"(OFF) : "memory"); return r;
}
template <int D0> __device__ __forceinline__ void pv_one(f32x16& od, int vb, bf16x8 pa0, bf16x8 pa1, bf16x8 pa2, bf16x8 pa3) {
  const s16x4 l0 = tr_read<v_rd_off(D0, 0, 0)>(vb), h0 = tr_read<v_rd_off(D0, 0, 1)>(vb), l1 = tr_read<v_rd_off(D0, 1, 0)>(vb), h1 = tr_read<v_rd_off(D0, 1, 1)>(vb);
  const s16x4 l2 = tr_read<v_rd_off(D0, 2, 0)>(vb), h2 = tr_read<v_rd_off(D0, 2, 1)>(vb), l3 = tr_read<v_rd_off(D0, 3, 0)>(vb), h3 = tr_read<v_rd_off(D0, 3, 1)>(vb);
  asm volatile("s_waitcnt lgkmcnt(0)" ::: "memory"); SBAR();
#define PK(L, H) (bf16x8){L[0], L[1], L[2], L[3], H[0], H[1], H[2], H[3]}
  od = __builtin_amdgcn_mfma_f32_32x32x16_bf16(pa0, PK(l0, h0), od, 0, 0, 0);
  od = __builtin_amdgcn_mfma_f32_32x32x16_bf16(pa1, PK(l1, h1), od, 0, 0, 0);
  od = __builtin_amdgcn_mfma_f32_32x32x16_bf16(pa2, PK(l2, h2), od, 0, 0, 0);
  od = __builtin_amdgcn_mfma_f32_32x32x16_bf16(pa3, PK(l3, h3), od, 0, 0, 0);
#undef PK
}
__device__ __forceinline__ void pv_d0(f32x16* o, int vb, bf16x8 pa0, bf16x8 pa1, bf16x8 pa2, bf16x8 pa3) {
  pv_one<0>(o[0], vb, pa0, pa1, pa2, pa3); pv_one<1>(o[1], vb, pa0, pa1, pa2, pa3); pv_one<2>(o[2], vb, pa0, pa1, pa2, pa3); pv_one<3>(o[3], vb, pa0, pa1, pa2, pa3);
}

template <int DQK, int SDEPTH>
__device__ __forceinline__ void attn_body(const bf16_t* __restrict__ Qb, const bf16_t* __restrict__ Q2b, int ldq, const bf16_t* __restrict__ Kh, int ldk, const bf16_t* __restrict__ K2h, int ldk2,
                                          const bf16_t* __restrict__ Vh, int ldv, bf16_t* __restrict__ Ob, int ldo, int seq, float scale, char* lds, LAS unsigned char* ldsl,
                                          const float* __restrict__ qgain, int sq0, const float* __restrict__ rsq, int qrope) {
  constexpr int ND = 8;
  const int tid = opaque_tid(), wid = tid >> 6, lane = tid & 63, r32 = lane & 31, hi = lane >> 5;
  const float C = scale * 1.4426950408889634f, thr_s = THR / scale;
  char* V_lds = lds; char* K_lds = lds + OFF_K; char* K2_lds = lds + OFF_K2;
  float* ws = (float*)(lds + OFF_WS) + wid * 64; float* li_l = ws; float* al_l = ws + 32;
  float m_reg = -1e30f, l_reg = 0; f32x16 o[4]; bf16x8 qr[ND];
#pragma unroll
  for (int d = 0; d < 4; ++d)
#pragma unroll
    for (int r = 0; r < 16; ++r) o[d][r] = 0.f;
  const bf16_t* Qw = Qb + (long)(wid * QBLK + r32) * ldq + hi * 8;
#pragma unroll
  for (int d0 = 0; d0 < ND; ++d0) qr[d0] = *reinterpret_cast<const bf16x8*>(Qw + d0 * 16);
  float mla_rsq = 1.f;
  if (DQK == 192 && qgain != nullptr) {
    if (rsq) mla_rsq = rsq[wid * QBLK + r32];
    float ss = 0.f;
#pragma unroll
    for (int d0 = 0; d0 < 8; ++d0) { const u32x4 w = *reinterpret_cast<const u32x4*>(&qr[d0]);
#pragma unroll
      for (int i = 0; i < 4; ++i) { const float lo = __uint_as_float(w[i] << 16) * mla_rsq, hi_ = __uint_as_float(w[i] & 0xffff0000u) * mla_rsq; ss += lo * lo + hi_ * hi_; } }
    ss += __shfl_xor(ss, 32, 64);
    const float rs = rsqrtf(ss * (1.f / 128.f) + EPS);
#pragma unroll
    for (int d0 = 0; d0 < 8; ++d0) { const u32x4 w = *reinterpret_cast<const u32x4*>(&qr[d0]);
      const f32x4 g0 = *(const f32x4*)(qgain + d0 * 16 + hi * 8), g1 = *(const f32x4*)(qgain + d0 * 16 + hi * 8 + 4);
      float x[8];
#pragma unroll
      for (int i = 0; i < 4; ++i) { x[2 * i] = __uint_as_float(w[i] << 16) * mla_rsq; x[2 * i + 1] = __uint_as_float(w[i] & 0xffff0000u) * mla_rsq; }
#pragma unroll
      for (int j = 0; j < 8; ++j) x[j] *= rs * (j < 4 ? g0[j & 3] : g1[j & 3]);
      u32x4 ow; ow.x = cvtpk(x[0], x[1]); ow.y = cvtpk(x[2], x[3]); ow.z = cvtpk(x[4], x[5]); ow.w = cvtpk(x[6], x[7]);
      qr[d0] = *reinterpret_cast<bf16x8*>(&ow); }
  }
  if (DQK == 128 && qgain != nullptr) {
    float ss = 0.f;
#pragma unroll
    for (int d0 = 0; d0 < 8; ++d0) { const u32x4 w = *reinterpret_cast<const u32x4*>(&qr[d0]);
#pragma unroll
      for (int i = 0; i < 4; ++i) { const float lo = __uint_as_float(w[i] << 16), hi_ = __uint_as_float(w[i] & 0xffff0000u); ss += lo * lo + hi_ * hi_; } }
    ss += __shfl_xor(ss, 32, 64);
    const float rs = rsqrtf(ss * (1.f / 128.f) + EPS);
    const int sq = sq0 + wid * QBLK + r32;
#pragma unroll
    for (int part = 0; part < 2; ++part) { const float pos = (float)(part ? (sq & 63) : (sq >> 6));
#pragma unroll
      for (int dp = 0; dp < 2; ++dp) { const int da = part * 4 + dp, db = da + 2;
        const u32x4 wa = *reinterpret_cast<const u32x4*>(&qr[da]), wb = *reinterpret_cast<const u32x4*>(&qr[db]);
        float xa[8], xb_[8];
#pragma unroll
        for (int i = 0; i < 4; ++i) { xa[2 * i] = __uint_as_float(wa[i] << 16); xa[2 * i + 1] = __uint_as_float(wa[i] & 0xffff0000u); xb_[2 * i] = __uint_as_float(wb[i] << 16); xb_[2 * i + 1] = __uint_as_float(wb[i] & 0xffff0000u); }
        const f32x4 ga0 = *(const f32x4*)(qgain + da * 16 + hi * 8), ga1 = *(const f32x4*)(qgain + da * 16 + hi * 8 + 4), gb0 = *(const f32x4*)(qgain + db * 16 + hi * 8), gb1 = *(const f32x4*)(qgain + db * 16 + hi * 8 + 4);
#pragma unroll
        for (int j = 0; j < 8; ++j) { float c = 1.f, sn = 0.f;
          if (qrope) { const float inv = exp2f(-(float)(2 * (dp * 16 + hi * 8 + j)) * (1.f / 64.f) * LOG2_THETA);
            float rev = pos * inv * INV2PI; rev -= floorf(rev); c = __builtin_amdgcn_cosf(rev); sn = __builtin_amdgcn_sinf(rev); }
          const float x1 = xa[j] * rs * (j < 4 ? ga0[j & 3] : ga1[j & 3]), x2 = xb_[j] * rs * (j < 4 ? gb0[j & 3] : gb1[j & 3]);
          xa[j] = x1 * c - x2 * sn; xb_[j] = x2 * c + x1 * sn; }
        u32x4 oa, ob; oa.x = cvtpk(xa[0], xa[1]); oa.y = cvtpk(xa[2], xa[3]); oa.z = cvtpk(xa[4], xa[5]); oa.w = cvtpk(xa[6], xa[7]);
        ob.x = cvtpk(xb_[0], xb_[1]); ob.y = cvtpk(xb_[2], xb_[3]); ob.z = cvtpk(xb_[4], xb_[5]); ob.w = cvtpk(xb_[6], xb_[7]);
        qr[da] = *reinterpret_cast<bf16x8*>(&oa); qr[db] = *reinterpret_cast<bf16x8*>(&ob); } }
  }
  char* q2l = lds + OFF_Q2 + (wid * 4 * 64 + lane) * 16;
  __syncthreads();
  if constexpr (DQK == 192) {
    u32x4 qp[4];
#pragma unroll
    for (int d0 = 0; d0 < 4; ++d0) qp[d0] = *reinterpret_cast<const u32x4*>(Q2b + (long)(wid * QBLK + r32) * ldq + hi * 8 + d0 * 16);
    if (qgain != nullptr) {
      float ss = 0.f;
#pragma unroll
      for (int d = 0; d < 4; ++d)
#pragma unroll
        for (int i = 0; i < 4; ++i) { const float lo = __uint_as_float(qp[d][i] << 16) * mla_rsq, hi_ = __uint_as_float(qp[d][i] & 0xffff0000u) * mla_rsq; ss += lo * lo + hi_ * hi_; }
      ss += __shfl_xor(ss, 32, 64);
      const float rs = rsqrtf(ss * (1.f / 64.f) + EPS) * mla_rsq;
      const int sq = sq0 + wid * QBLK + r32;
#pragma unroll
      for (int part = 0; part < 2; ++part) { const float pos = (float)(part ? (sq & 63) : (sq >> 6)); const int da = 2 * part, db = da + 1;
        const f32x4 ga0 = *(const f32x4*)(qgain + 128 + da * 16 + hi * 8), ga1 = *(const f32x4*)(qgain + 128 + da * 16 + hi * 8 + 4);
        const f32x4 gb0 = *(const f32x4*)(qgain + 128 + db * 16 + hi * 8), gb1 = *(const f32x4*)(qgain + 128 + db * 16 + hi * 8 + 4);
        float xa[8], xb_[8];
#pragma unroll
        for (int i = 0; i < 4; ++i) { xa[2 * i] = __uint_as_float(qp[da][i] << 16); xa[2 * i + 1] = __uint_as_float(qp[da][i] & 0xffff0000u); xb_[2 * i] = __uint_as_float(qp[db][i] << 16); xb_[2 * i + 1] = __uint_as_float(qp[db][i] & 0xffff0000u); }
#pragma unroll
        for (int j = 0; j < 8; ++j) { const float inv = exp2f(-(float)(2 * (hi * 8 + j)) * (1.f / 32.f) * LOG2_THETA);
          float rev = pos * inv * INV2PI; rev -= floorf(rev);
          const float c = __builtin_amdgcn_cosf(rev), sn = __builtin_amdgcn_sinf(rev);
          const float x1 = xa[j] * rs * (j < 4 ? ga0[j & 3] : ga1[j & 3]), x2 = xb_[j] * rs * (j < 4 ? gb0[j & 3] : gb1[j & 3]);
          xa[j] = x1 * c - x2 * sn; xb_[j] = x2 * c + x1 * sn; }
        qp[da].x = cvtpk(xa[0], xa[1]); qp[da].y = cvtpk(xa[2], xa[3]); qp[da].z = cvtpk(xa[4], xa[5]); qp[da].w = cvtpk(xa[6], xa[7]);
        qp[db].x = cvtpk(xb_[0], xb_[1]); qp[db].y = cvtpk(xb_[2], xb_[3]); qp[db].z = cvtpk(xb_[4], xb_[5]); qp[db].w = cvtpk(xb_[6], xb_[7]); }
    }
#pragma unroll
    for (int d0 = 0; d0 < 4; ++d0) *reinterpret_cast<u32x4*>(q2l + d0 * 1024) = qp[d0];
  }
  const int wu = __builtin_amdgcn_readfirstlane(wid);
  unsigned voffK[2], voffV[2], voffK2;
#pragma unroll
  for (int i = 0; i < 2; ++i) {
    const int blk = i * 8 + wid;
    { const int row = blk * 4 + (lane >> 4), colB = ((lane & 15) << 4) ^ ((row & 7) << 4); voffK[i] = (unsigned)(row * ldk * 2 + colB); }
    { const int st = blk * 2 + (lane >> 5), kk = (st >> 2) * 8 + ((lane & 31) >> 2), c = (st & 3) * 32 + (lane & 3) * 8;
      const int k = (kk & ~0xC) | ((kk & 4) << 1) | ((kk & 8) >> 1); voffV[i] = (unsigned)((k * ldv + c) * 2); }
  }
  { const int row = wid * 8 + (lane >> 3), colB = ((lane & 7) << 4) ^ (((row >> 1) & 7) << 4); voffK2 = (unsigned)(row * ldk2 * 2 + colB); }
  const size_t tsV = (size_t)ldv * 2, tsK = (size_t)ldk * 2, tsK2 = (size_t)ldk2 * 2;
  const int vb0 = (int)(uintptr_t)V_lds + v_rd_base(lane);
  constexpr int NDMA = (DQK == 192) ? 5 : 4;
#define DMA_K(t) do { const int b_ = (t) % 3; const char* kb_ = (const char*)Kh + (size_t)(t) * KVBLK * tsK; \
    _Pragma("unroll") for (int i = 0; i < 2; ++i) __builtin_amdgcn_global_load_lds((const unsigned*)(kb_ + voffK[i]), (LAS unsigned*)(ldsl + OFF_K + b_ * SHM_K + (i * 8 + wu) * 1024), 16, 0, 0); \
    if constexpr (DQK == 192) __builtin_amdgcn_global_load_lds((const unsigned*)((const char*)K2h + (size_t)(t) * KVBLK * tsK2 + voffK2), (LAS unsigned*)(ldsl + OFF_K2 + b_ * SHM_K2 + wu * 1024), 16, 0, 0); } while (0)
#define DMA_V(t) do { const int b_ = (t) % 3; const char* vb_ = (const char*)Vh + (size_t)(t) * KVBLK * tsV; \
    _Pragma("unroll") for (int i = 0; i < 2; ++i) __builtin_amdgcn_global_load_lds((const unsigned*)(vb_ + voffV[i]), (LAS unsigned*)(ldsl + b_ * SHM_V + (i * 8 + wu) * 1024), 16, 0, 0); } while (0)
#define RAWBAR() do { asm volatile("" ::: "memory"); __builtin_amdgcn_s_barrier(); asm volatile("" ::: "memory"); } while (0)
#define RESC(a) do { if (__any((a) < 1.f)) { if (hi == 0) al_l[r32] = (a); asm volatile("s_waitcnt lgkmcnt(0)" ::: "memory"); \
    _Pragma("unroll") for (int d = 0; d < 4; ++d) _Pragma("unroll") for (int r = 0; r < 16; ++r) o[d][r] *= al_l[crow(r, hi)]; } } while (0)
  f32x16 pA0, pA1, pB0, pB1; float mnA, mnB, alA, alB; bf16x8 pa0, pa1, pa2, pa3; const int NT = seq / KVBLK;
  int ob_prev = 0, ob_cur = 1;
#define HALF_STEP(PN0, PN1, MNN, ALN, PO0, PO1, ALO, J, FULL) do { \
    if (FULL) { DMA_K((J) + 2); DMA_V((J) + 1); } else { if ((J) + 2 < NT) DMA_K((J) + 2); if ((J) + 1 < NT) DMA_V((J) + 1); } \
    qkt<DQK>(PN0, PN1, K_lds + ob_cur * SHM_K, K2_lds + ob_cur * SHM_K2, qr, q2l, r32, hi); \
    finishSM(PO0, PO1, ALO, l_reg, pa0, pa1, pa2, pa3); \
    pv_d0(o, vb0 + ob_prev * SHM_V, pa0, pa1, pa2, pa3); partialSM(PN0, PN1, m_reg, MNN, ALN, C, thr_s); \
    RESC(ALN); \
    if (FULL) { if constexpr (NDMA == 5) asm volatile("s_waitcnt vmcnt(5)" ::: "memory"); else asm volatile("s_waitcnt vmcnt(4)" ::: "memory"); } else asm volatile("s_waitcnt vmcnt(0)" ::: "memory"); \
    RAWBAR(); \
    ob_prev = ob_cur; ob_cur = (ob_cur == 2) ? 0 : ob_cur + 1; } while (0)
  DMA_K(0); DMA_V(0); DMA_K(1);
  asm volatile("s_waitcnt vmcnt(0)" ::: "memory"); RAWBAR();
  DMA_K(2); DMA_V(1);
  qkt<DQK>(pA0, pA1, K_lds, K2_lds, qr, q2l, r32, hi); partialSM(pA0, pA1, m_reg, mnA, alA, C, thr_s);
  if constexpr (NDMA == 5) asm volatile("s_waitcnt vmcnt(5)" ::: "memory"); else asm volatile("s_waitcnt vmcnt(4)" ::: "memory");
  RAWBAR();
  for (int j = 1; j + 3 < NT; j += 2) {
    HALF_STEP(pB0, pB1, mnB, alB, pA0, pA1, alA, j, true);
    HALF_STEP(pA0, pA1, mnA, alA, pB0, pB1, alB, j + 1, true);
  }
  HALF_STEP(pB0, pB1, mnB, alB, pA0, pA1, alA, NT - 3, false);
  HALF_STEP(pA0, pA1, mnA, alA, pB0, pB1, alB, NT - 2, false);
  HALF_STEP(pB0, pB1, mnB, alB, pA0, pA1, alA, NT - 1, false);
  finishSM(pB0, pB1, alB, l_reg, pa0, pa1, pa2, pa3); SBAR();
  pv_d0(o, vb0 + ob_prev * SHM_V, pa0, pa1, pa2, pa3);
#undef HALF_STEP
#undef DMA_K
#undef DMA_V
#undef RAWBAR
  if (hi == 0) li_l[r32] = l_reg; asm volatile("s_waitcnt lgkmcnt(0)" ::: "memory");
  float rli[16];
#pragma unroll
  for (int r = 0; r < 16; ++r) rli[r] = __builtin_amdgcn_rcpf(li_l[crow(r, hi)]);
  bf16_t* Ow = Ob + (long)(wid * QBLK) * ldo;
#pragma unroll
  for (int r = 0; r < 16; ++r) { int orow = crow(r, hi);
#pragma unroll
    for (int d0 = 0; d0 < 4; ++d0) Ow[(long)orow * ldo + d0 * 32 + r32] = f2bf(o[d0][r] * rli[r]); }
#undef RESC
}
struct AttnJob { const bf16_t* Q; const bf16_t* Q2; int ldq, qhs; const bf16_t* K; int ldk, khs; long kbs; const bf16_t* K2; int ldk2; const bf16_t* V; int ldv; bf16_t* O; int H, gshift, seq, nunits; float scale; const float* qgain; const float* rsq; int qrope; };
template <int DQK, int SDEPTH>
__device__ __forceinline__ void run_attn(const AttnJob& a, char* lds, LAS unsigned char* ldsl) {
  for (int u = blockIdx.x; u < a.nunits; u += gridDim.x) {
    const int per_b = a.H * 32, b = u / per_b, rest = u - b * per_b, h = rest % a.H, qb = rest / a.H, kh = h >> a.gshift;
    const long tok0 = (long)b * SEQ + qb * 256;
    attn_body<DQK, SDEPTH>(a.Q + tok0 * a.ldq + h * a.qhs, a.Q2 + tok0 * a.ldq + h * 64, a.ldq, a.K + (long)b * a.kbs + kh * a.khs, a.ldk, a.K2 + (long)b * SEQ * a.ldk2, a.ldk2,
                           a.V + (long)b * a.kbs + kh * a.khs, a.ldv, a.O + tok0 * 1536 + h * 128, 1536, a.seq, a.scale, lds, ldsl, a.qgain, qb * 256, a.rsq ? a.rsq + tok0 : nullptr, a.qrope);
  }
}
}

__device__ __forceinline__ void rms_rows(const float* __restrict__ src, const float* __restrict__ gain, bf16_t* __restrict__ dst, int nrows) {
  const int tid_ = opaque_tid(), wid = tid_ >> 6, lane = tid_ & 63;
  for (int row = blockIdx.x * 8 + wid; row < nrows; row += gridDim.x * 8) {
    const f32x4* s = (const f32x4*)(src + (size_t)row * DM);
    f32x4 v[4]; float ss = 0.f;
#pragma unroll
    for (int j = 0; j < 4; ++j) { v[j] = s[lane + 64 * j]; ss += v[j][0] * v[j][0] + v[j][1] * v[j][1] + v[j][2] * v[j][2] + v[j][3] * v[j][3]; }
    ss = wave_sum(ss);
    const float rs = rsqrtf(ss * (1.f / DM) + EPS);
#pragma unroll
    for (int j = 0; j < 4; ++j) { const f32x4 g = ((const f32x4*)gain)[lane + 64 * j];
      u32x2 w; w.x = cvtpk(v[j][0] * rs * g[0], v[j][1] * rs * g[1]); w.y = cvtpk(v[j][2] * rs * g[2], v[j][3] * rs * g[3]);
      *(u32x2*)(dst + (size_t)row * DM + (lane + 64 * j) * 4) = w; }
  }
}
template <int MODE>
__device__ __forceinline__ void prep_w(const float* __restrict__ src, int K, int Nsrc, bf16_t* __restrict__ dst, int Ndst, const float* __restrict__ kgain) {
  const long total = (long)Ndst * (K / 8);
  for (long i = (long)blockIdx.x * 512 + opaque_tid(); i < total; i += (long)gridDim.x * 512) {
    const long i8 = i >> 3; const int n = (int)(i8 % Ndst), k8 = (int)(i8 / Ndst) * 8 + (int)(i & 7);
    int ns = n;
    if (MODE == 1) { const int pn = n >> 8, r = n & 255, bj = r >> 7, ii = r & 127; ns = bj * DFF + pn * 128 + ii; }
    if (MODE == 2) { ns = n < 640 ? n : (n < 1152 ? n + 64 : (n < 1216 ? n - 512 : Nsrc)); }
    if (MODE == 3) { ns = n < 1024 ? (n >> 7) * 192 + (n & 127) : ((n - 1024) >> 6) * 192 + 128 + ((n - 1024) & 63); }
    float x[8];
#pragma unroll
    for (int j = 0; j < 8; ++j) x[j] = (ns < Nsrc) ? src[(size_t)(k8 * 8 + j) * Nsrc + ns] : 0.f;
    if (kgain) {
#pragma unroll
      for (int j = 0; j < 8; ++j) x[j] *= kgain[k8 * 8 + j];
    }
    u32x4 w; w.x = cvtpk(x[0], x[1]); w.y = cvtpk(x[2], x[3]); w.z = cvtpk(x[4], x[5]); w.w = cvtpk(x[6], x[7]);
    *(u32x4*)(dst + (size_t)n * K + k8 * 8) = w;
  }
}
__device__ __forceinline__ void unpack8(u32x4 w, float* v) {
#pragma unroll
  for (int i = 0; i < 4; ++i) { v[2 * i] = __uint_as_float(w[i] << 16); v[2 * i + 1] = __uint_as_float(w[i] & 0xffff0000u); }
}
__device__ __forceinline__ u32x4 pack8(const float* v) { u32x4 w; w.x = cvtpk(v[0], v[1]); w.y = cvtpk(v[2], v[3]); w.z = cvtpk(v[4], v[5]); w.w = cvtpk(v[6], v[7]); return w; }
__device__ __forceinline__ float sumsq8(const float* v) { float s = 0.f;
#pragma unroll
  for (int j = 0; j < 8; ++j) s += v[j] * v[j];
  return s; }
template <int GL> __device__ __forceinline__ float group_sum(float s) {
#pragma unroll
  for (int o = 1; o < GL; o <<= 1) s += __shfl_xor(s, o, 64);
  return s;
}
__device__ __forceinline__ void load8(float* g, const float* __restrict__ p) { const f32x4 a = *(const f32x4*)p, b = *(const f32x4*)(p + 4);
  g[0] = a[0]; g[1] = a[1]; g[2] = a[2]; g[3] = a[3]; g[4] = b[0]; g[5] = b[1]; g[6] = b[2]; g[7] = b[3]; }
template <int GL> __device__ __forceinline__ void norm8(float* v, const float* g) {
  const float ss = group_sum<GL>(sumsq8(v)); const float rs = rsqrtf(ss * (1.f / (GL * 8)) + EPS);
#pragma unroll
  for (int j = 0; j < 8; ++j) v[j] *= rs * g[j];
}
template <int XM> __device__ __forceinline__ void rope8(float* v, const float* inv, float pos, bool first) {
#pragma unroll
  for (int j = 0; j < 8; ++j) {
    const float partner = __shfl_xor(v[j], XM, 64);
    float rev = pos * inv[j] * INV2PI; rev -= floorf(rev);
    const float c = __builtin_amdgcn_cosf(rev), s = __builtin_amdgcn_sinf(rev);
    v[j] = first ? v[j] * c - partner * s : v[j] * c + partner * s;
  }
}
template <int NE> __device__ __forceinline__ void ld_seg(float* v, const bf16_t* p, int lane) {
#pragma unroll
  for (int j = 0; j < NE; ++j) v[j] = bf2f(p[lane + 64 * j]);
}
template <int NE> __device__ __forceinline__ void st_seg(const float* v, bf16_t* p, int lane) {
#pragma unroll
  for (int j = 0; j < NE; ++j) p[lane + 64 * j] = f2bf(v[j]);
}
template <int NE, int ROPE> __device__ __forceinline__ void norm_seg(float* v, const float* __restrict__ gain, int lane, int prow, int pcol) {
  float ss = 0.f;
#pragma unroll
  for (int j = 0; j < NE; ++j) ss += v[j] * v[j];
  ss = wave_sum(ss);
  const float rs = rsqrtf(ss * (1.f / (64 * NE)) + EPS);
#pragma unroll
  for (int j = 0; j < NE; ++j) v[j] = v[j] * rs * gain[lane + 64 * j];
  if constexpr (ROPE && NE == 2) {
    const int f = lane & 31; const float inv = exp2f(-(float)(2 * f) * (1.f / 64.f) * LOG2_THETA);
#pragma unroll
    for (int j = 0; j < 2; ++j) {
      const float partner = __shfl_xor(v[j], 32, 64);
      const float ang = (float)(j == 0 ? prow : pcol) * inv;
      float rev = ang * INV2PI; rev -= floorf(rev);
      const float c = __builtin_amdgcn_cosf(rev), s = __builtin_amdgcn_sinf(rev);
      v[j] = (lane < 32) ? v[j] * c - partner * s : v[j] * c + partner * s;
    }
  }
  if constexpr (ROPE && NE == 1) {
    const int f = lane & 15; const float inv = exp2f(-(float)(2 * f) * (1.f / 32.f) * LOG2_THETA);
    const float partner = __shfl_xor(v[0], 16, 64);
    const float ang = (float)(lane < 32 ? prow : pcol) * inv;
    float rev = ang * INV2PI; rev -= floorf(rev);
    const float c = __builtin_amdgcn_cosf(rev), s = __builtin_amdgcn_sinf(rev);
    v[0] = (lane & 16) ? v[0] * c + partner * s : v[0] * c - partner * s;
  }
}

#define XB_TMO      128
#define XB_XCNT(j)  (256  + 64 * (j))
#define XB_XSUB(j)  (1280 + 64 * (j))
#define XB_XGEN(j)  (2304 + 64 * (j))
#define XB_TOP      3328
#define XB_TOPGEN   3392
#define XCD_BAR_WORDS 3456
#define XB_SPIN_CAP (1u << 22)
__device__ __forceinline__ unsigned xb_ld(unsigned* p)              { return __hip_atomic_load(p, __ATOMIC_RELAXED, __HIP_MEMORY_SCOPE_AGENT); }
__device__ __forceinline__ unsigned xb_add(unsigned* p, unsigned v) { return __hip_atomic_fetch_add(p, v, __ATOMIC_RELAXED, __HIP_MEMORY_SCOPE_AGENT); }
__device__ __forceinline__ unsigned xb_xcc_id() { return (unsigned)__builtin_amdgcn_s_getreg((3 << 11) | 20) & 0xFu; }
#define XB_SPIN(cond, bar) do { unsigned _sp = 0; while (cond) { __builtin_amdgcn_s_sleep(1); \
    if ((++_sp & 255u) == 0u) { if (xb_ld(&(bar)[XB_TMO])) break; if (_sp > XB_SPIN_CAP) { atomicAdd(&(bar)[XB_TMO], 1u); break; } } } } while (0)
struct XcdBarrier { unsigned* bar; unsigned x; volatile LAS unsigned* st; };
__device__ __forceinline__ XcdBarrier xcd_barrier_post(unsigned* bar, volatile LAS unsigned* st) {
  XcdBarrier b; b.bar = bar; b.x = xb_xcc_id(); b.st = st;
  if (threadIdx.x == 0) (void)xb_add(&bar[XB_XCNT(b.x)], 1u);
  return b;
}
__device__ __forceinline__ void xcd_barrier_complete(unsigned* bar, unsigned x, unsigned& nloc, unsigned& nx) {
  const unsigned G = gridDim.x * gridDim.y * gridDim.z;
  unsigned sum, cnt, mine, sp = 0u;
  for (;;) {
    sum = 0u; cnt = 0u; mine = 0u;
#pragma unroll
    for (unsigned j = 0; j < 16; ++j) { const unsigned c = xb_ld(&bar[XB_XCNT(j)]); sum += c; cnt += (c > 0u) ? 1u : 0u; mine = (j == x) ? c : mine; }
    if (sum == G) break;
    __builtin_amdgcn_s_sleep(1);
    if ((++sp & 255u) == 0u) { if (xb_ld(&bar[XB_TMO])) break; if (sp > XB_SPIN_CAP) { atomicAdd(&bar[XB_TMO], 1u); break; } }
  }
  nloc = mine > 0u ? mine : 1u; nx = cnt > 0u ? cnt : 1u;
}
__device__ __forceinline__ void xcd_barrier(const XcdBarrier& b) {
  asm volatile("s_waitcnt vmcnt(0)" ::: "memory");
  __syncthreads();
  if (threadIdx.x == 0) {
    unsigned* bar = b.bar;
    __builtin_amdgcn_s_waitcnt(0);
    unsigned nloc = b.st[0], nx = b.st[1];
    if (nloc == 0u) { xcd_barrier_complete(bar, b.x, nloc, nx); b.st[0] = nloc; b.st[1] = nx; }
    const unsigned old = xb_add(&bar[XB_XSUB(b.x)], 1u);
    const unsigned gen = old / nloc;
    if (old + 1u == (gen + 1u) * nloc) {
      __builtin_amdgcn_fence(__ATOMIC_RELEASE, "agent");
      asm volatile("s_waitcnt vmcnt(0)" ::: "memory");
      const unsigned og = xb_add(&bar[XB_TOP], 1u);
      const unsigned tg = og / nx;
      if (og + 1u == (tg + 1u) * nx) xb_add(&bar[XB_TOPGEN], 1u);
      else XB_SPIN(xb_ld(&bar[XB_TOPGEN]) == tg, bar);
      __builtin_amdgcn_fence(__ATOMIC_ACQUIRE, "agent");
      xb_add(&bar[XB_XGEN(b.x)], 1u);
      asm volatile("s_waitcnt vmcnt(0)" ::: "memory");
    } else {
      XB_SPIN(xb_ld(&bar[XB_XGEN(b.x)]) == gen, bar);
      __builtin_amdgcn_fence(__ATOMIC_ACQUIRE, "agent");
      asm volatile("s_waitcnt vmcnt(0)" ::: "memory");
    }
  }
  __syncthreads();
}

constexpr int LDS_MAIN = att::SHM_ATTN > pg8::STAGE_BYTES ? att::SHM_ATTN : pg8::STAGE_BYTES;
constexpr int LDS_BYTES = LDS_MAIN + 16;
static_assert(att::SHM_ATTN <= LDS_MAIN, "lds");
constexpr int NPHASE = 18;
#ifndef PHMASK
#define PHMASK 0xf
#endif
#ifndef STAG_GU
#define STAG_GU 0
#endif
#ifndef REPMASK
#define REPMASK 0
#endif
#ifndef A128_SD
#define A128_SD 1
#endif
#ifndef KARG
#define KARG 0
#endif
#define wt_in0 ((bf16_t*)(p.ws + WS_WT_IN0))
#define wt_qb ((bf16_t*)(p.ws + WS_WT_QB))
#define wt_kvb ((bf16_t*)(p.ws + WS_WT_KVB))
#define wt_out ((bf16_t*)(p.ws + WS_WT_OUT))
#define wt_memkv ((bf16_t*)(p.ws + WS_WT_MEMKV))
#define wt_gu ((bf16_t*)(p.ws + WS_WT_GU))
#define wt_dn ((bf16_t*)(p.ws + WS_WT_DN))
#define wt_in1 ((bf16_t*)(p.ws + WS_WT_IN1))
#define memn ((bf16_t*)(p.ws + WS_MEMN))
#define memkv ((bf16_t*)(p.ws + WS_MEMKV))
#define hbuf ((bf16_t*)(p.ws + WS_HM))
#define mix ((bf16_t*)(p.ws + WS_HM))
#define proj ((bf16_t*)(p.ws + WS_R))
#define act ((bf16_t*)(p.ws + WS_R))
#define qbuf ((bf16_t*)(p.ws + WS_Q))
#define kvbuf ((bf16_t*)(p.ws + WS_KV))

struct GemmJob { const bf16_t* A; int lda; const bf16_t* Bt; int M, N, K; int kind; bf16_t* O; int ldc; const float* res; int coff; const float* rs_in; float* rs_out; int stag; float inv_n; float* csq; float* ckv; };

__device__ __forceinline__ int gemm_jobs(const Params& p, int ph, int gi, GemmJob& j) {
  const float* x = p.in[0];
  j.M = NTOK; j.res = nullptr; j.coff = 0; j.O = nullptr; j.ldc = 0; j.rs_in = nullptr; j.rs_out = nullptr; j.stag = 0; j.inv_n = 1.f / DM; j.csq = nullptr; j.ckv = nullptr;
  float* rowss = (float*)(p.ws + WS_ROWSS); bf16_t* xbuf = (bf16_t*)(p.ws + WS_XB);
  switch (ph) {
  case 1:
    if (gi == 0) { j.A = hbuf; j.lda = 1024; j.Bt = wt_in0; j.N = 1280; j.K = 1024; j.kind = 0; j.O = proj; j.ldc = 1280; j.csq = rowss + 3 * (size_t)NTOK; j.ckv = rowss + 4 * (size_t)NTOK; }
    else { j.A = memn; j.lda = 1024; j.Bt = wt_memkv + (size_t)(gi - 1) * 1024 * 1024; j.M = NMEMROWS; j.N = 1024; j.K = 1024; j.kind = 0; j.O = memkv + (size_t)(gi - 1) * NMEMROWS * 1024; j.ldc = 1024; j.coff = (gi - 1) * 128; }
    return 3;
  case 3:
    if (gi == 0) { j.A = proj; j.lda = 1280; j.Bt = wt_qb; j.N = 1536; j.K = 384; j.kind = 0; j.O = qbuf; j.ldc = 1536; j.rs_in = rowss + 3 * (size_t)NTOK; j.inv_n = 1.f / 384.f; }
    else { j.A = proj + 384; j.lda = 1280; j.Bt = wt_kvb; j.N = 2048; j.K = 256; j.kind = 0; j.O = kvbuf; j.ldc = 2048; j.rs_in = rowss + 4 * (size_t)NTOK; j.inv_n = 1.f / 256.f; }
    return 2;
  case 6: case 14: { const int L = ph == 6 ? 0 : 1;
    j.A = mix; j.lda = 1536; j.Bt = wt_out + (size_t)L * 1024 * 1536; j.N = 1024; j.K = 1536; j.kind = 1; j.res = L == 0 ? x : nullptr; j.rs_out = rowss + (size_t)(L == 0 ? 0 : 2) * NTOK; j.O = xbuf; return 1; }
  case 8: case 16: { const int L = ph == 8 ? 0 : 1;
    j.A = xbuf; j.lda = 1024; j.Bt = wt_gu + (size_t)L * 5632 * 1024; j.N = 5632; j.K = 1024; j.kind = 2; j.O = act; j.rs_in = rowss + (size_t)(L == 0 ? 0 : 2) * NTOK; j.stag = STAG_GU; return 1; }
  case 9: case 17: { const int L = ph == 9 ? 0 : 1;
    j.A = act; j.lda = DFF; j.Bt = wt_dn + (size_t)L * 1024 * 2816; j.N = 1024; j.K = DFF; j.kind = 1; j.res = nullptr; if (L == 0) { j.rs_out = rowss + (size_t)NTOK; j.O = xbuf; } return 1; }
  case 11:
    j.A = xbuf; j.lda = 1024; j.Bt = wt_in1; j.N = 2048; j.K = 1024; j.kind = 0; j.O = proj; j.ldc = 2048; j.rs_in = rowss + (size_t)NTOK; return 1;
  default: return 0;
  }
}

__global__ __launch_bounds__(512) void mega(Params p_) {
  extern __shared__ __attribute__((aligned(16))) unsigned char shm[];
  LAS unsigned char* glds = (LAS unsigned char*)shm;
  char* alds = (char*)shm;
  const Params* pp = (const Params*)__builtin_amdgcn_kernarg_segment_ptr();
  const int ph_lo = p_.ph_lo, ph_hi = p_.ph_hi;
  volatile LAS unsigned* bst = (volatile LAS unsigned*)(glds + LDS_MAIN);
  if (threadIdx.x == 0) { bst[0] = 0u; bst[1] = 0u; }
  __syncthreads();
  const XcdBarrier xb = xcd_barrier_post((unsigned*)(p_.ws + WS_BAR), bst);
  if (ph_lo < 0) cg::this_grid().sync();

  for (int ph = ph_lo; ph < ph_hi; ++ph) {
    if (ph == 2 || ph == 7 || ph == 10 || ph == 15) continue;
#if KARG
    asm volatile("" : "+s"(pp));
    const Params& p = *pp;
#else
    const Params& p = p_;
#endif
    const float* x = p.in[0];
    for (int rep = 0; rep < 1 + ((REPMASK >> ph) & 1); ++rep) {
    const int tid_ = opaque_tid(), wid = tid_ >> 6, lane = tid_ & 63;
    const int gw = blockIdx.x * 8 + wid, nw = gridDim.x * 8;
    if (PHMASK & 1) switch (ph) {
    case 0: {
      prep_w<2>(p.in[11], 1024, 1216, wt_in0, 1280, nullptr);
      prep_w<3>(p.in[13], 384, 1536, wt_qb, 1536, p.in[12]);
      prep_w<0>(p.in[15], 256, 2048, wt_kvb, 2048, p.in[14]);
      for (int i = 0; i < 2; ++i) {
        prep_w<0>(p.in[5] + (size_t)i * 1536 * 1024, 1536, 1024, wt_out + (size_t)i * 1024 * 1536, 1024, nullptr);
        prep_w<0>(p.in[6] + (size_t)i * 1024 * 1024, 1024, 1024, wt_memkv + (size_t)i * 1024 * 1024, 1024, nullptr);
        prep_w<1>(p.in[9] + (size_t)i * 1024 * 5632, 1024, 5632, wt_gu + (size_t)i * 5632 * 1024, 5632, p.in[4] + i * 1024);
        prep_w<0>(p.in[10] + (size_t)i * 2816 * 1024, 2816, 1024, wt_dn + (size_t)i * 1024 * 2816, 1024, nullptr);
      }
      prep_w<0>(p.in[18], 1024, 2048, wt_in1, 2048, p.in[3] + 1024);
      for (int i = blockIdx.x * 512 + tid_; i < 5 * NTOK; i += gridDim.x * 512) ((float*)(p.ws + WS_ROWSS))[i] = 0.f;
      rms_rows(p.in[1], p.in[2], memn, NMEMROWS);
      rms_rows(x, p.in[3], hbuf, NTOK);
    } break;
    case 4: {
      const int l16 = lane & 15, l8 = lane & 7;
      float inv64[8], g_kn[8], g_kp[8];
#pragma unroll
      for (int j = 0; j < 8; ++j) inv64[j] = exp2f(-(float)(2 * ((l8 & 1) * 8 + j)) * (1.f / 32.f) * LOG2_THETA);
      load8(g_kn, p.in[17] + l16 * 8); load8(g_kp, p.in[17] + 128 + l8 * 8);
      const bool first64 = !(l8 & 2);
      const bool is_k = !((lane >> 4) & 1);
      for (int t = gw; t < NTOK; t += nw) {
        const int sq = t & (SEQ - 1); const float pos64 = (float)((l8 < 4) ? (sq >> 6) : (sq & 63));
        bf16_t* pr = proj + (size_t)t * 1280 + lane * 8; bf16_t* kvrow = kvbuf + (size_t)t * 2048 + lane * 8;
        const bool dry = ((REPMASK >> 4) & 1) && rep == 0; bf16_t* kvdst = dry ? (bf16_t*)p.out + (size_t)t * 2048 + lane * 8 : kvrow;
        u32x4 P2 = {0u, 0u, 0u, 0u}; if (lane >= 16 && lane < 24) P2 = *(const u32x4*)(pr + 1024);
        u32x4 KV0 = P2, KV1 = P2, KV2 = P2, KV3 = P2;
        if (is_k) { KV0 = *(const u32x4*)kvrow; KV1 = *(const u32x4*)(kvrow + 512); KV2 = *(const u32x4*)(kvrow + 1024); KV3 = *(const u32x4*)(kvrow + 1536); }
        float a[8], b[8];
        unpack8(P2, a);
        { const float s8 = group_sum<8>(sumsq8(a)); const float rsB = rsqrtf(s8 * (1.f / 64.f) + EPS);
#pragma unroll
          for (int j = 0; j < 8; ++j) b[j] = a[j] * rsB * g_kp[j];
          rope8<2>(b, inv64, pos64, first64);
          if (lane >= 16 && lane < 24 && !dry) *(u32x4*)(pr + 1024) = pack8(b); }
#define KCHUNK(W, OFF) do { unpack8(W, a); norm8<16>(a, g_kn); if (is_k) *(u32x4*)(kvdst + (OFF)) = pack8(a); } while (0)
        KCHUNK(KV0, 0); KCHUNK(KV1, 512); KCHUNK(KV2, 1024); KCHUNK(KV3, 1536);
#undef KCHUNK
      }
      if (!(((REPMASK >> 4) & 1) && rep == 0)) for (int r = gw; r < 2 * NMEMROWS; r += nw) {
        float g_mk[8]; load8(g_mk, p.in[8] + (r / NMEMROWS) * 128 + l16 * 8);
        bf16_t* row = memkv + (size_t)r * 1024 + lane * 8;
        float a[8]; unpack8(*(const u32x4*)row, a); norm8<16>(a, g_mk); *(u32x4*)row = pack8(a);
      }
    } break;
    case 7: case 15: rms_rows(p.out, p.in[4] + (ph == 7 ? 0 : 1024), hbuf, NTOK); break;
    case 10: rms_rows(p.out, p.in[3] + 1024, hbuf, NTOK); break;
    case 12: {
      const int l16 = lane & 15;
      float inv128[8], g_k[8];
#pragma unroll
      for (int j = 0; j < 8; ++j) inv128[j] = exp2f(-(float)(2 * ((l16 & 3) * 8 + j)) * (1.f / 64.f) * LOG2_THETA);
      load8(g_k, p.in[20] + l16 * 8);
      const bool first128 = !(l16 & 4);
      for (int t = gw; t < NTOK; t += nw) {
        const int sq = t & (SEQ - 1); const float pos128 = (float)((l16 < 8) ? (sq >> 6) : (sq & 63));
        bf16_t* row = proj + (size_t)t * 2048 + lane * 8;
        bf16_t* dst = (((REPMASK >> 12) & 1) && rep == 0) ? row + 128ull * MiB : row;
        const u32x4 W2 = *(const u32x4*)(row + 1024);
        float a[8];
        unpack8(W2, a); norm8<16>(a, g_k); rope8<4>(a, inv128, pos128, first128); if (lane < 32) *(u32x4*)(dst + 1024) = pack8(a);
      }
    } break;
    default: break;
    }
    if (PHMASK & 2) {
      GemmJob j; const int ng = gemm_jobs(p, ph, 0, j);
      for (int gi = 0; gi < ng; ++gi) {
        if (gi) gemm_jobs(p, ph, gi, j);
        if (j.kind == 0) pg8::run_gemm(glds, j.A, j.lda, j.Bt, j.M, j.N, j.K, pg8::EpiBf16{j.O, j.ldc, j.rs_in, j.inv_n, j.csq, j.ckv}, j.coff, j.stag);
        else if (j.kind == 1) pg8::run_gemm(glds, j.A, j.lda, j.Bt, j.M, j.N, j.K, pg8::EpiResF32{j.res, (const bf16_t*)(p.ws + WS_XB), j.rs_out ? nullptr : p.out, j.rs_out ? j.O : nullptr, j.rs_out}, j.coff, j.stag);
        else pg8::run_gemm(glds, j.A, j.lda, j.Bt, j.M, j.N, j.K, pg8::EpiSwiGLU{j.O, j.rs_in}, j.coff, j.stag);
      }
    }
    if ((PHMASK & 12) && (ph == 5 || ph == 13)) {
      const int L = ph == 5 ? 0 : 1;
      att::AttnJob a; a.qgain = nullptr; a.rsq = nullptr; a.qrope = 1;
      if (L == 0) {
        a.Q = qbuf; a.Q2 = qbuf + 1024; a.ldq = 1536; a.qhs = 128; a.K = kvbuf; a.ldk = 2048; a.khs = 256; a.kbs = (long)SEQ * 2048; a.K2 = proj + 1152; a.ldk2 = 1280;
        a.V = kvbuf + 128; a.ldv = 2048; a.O = mix; a.H = 8; a.gshift = 0; a.seq = SEQ; a.nunits = 2048; a.scale = 0.072168783648703220f; a.qgain = p.in[16];
        if (PHMASK & 4) att::run_attn<192, 1>(a, alds, glds);
      } else {
        a.Q = proj; a.Q2 = proj; a.ldq = 2048; a.qhs = 128; a.K = proj + 1024; a.ldk = 2048; a.khs = 128; a.kbs = (long)SEQ * 2048; a.K2 = proj; a.ldk2 = 0;
        a.V = proj + 1280; a.ldv = 2048; a.O = mix; a.H = 8; a.gshift = 2; a.seq = SEQ; a.nunits = 2048; a.scale = 0.088388347648318440f; a.qgain = p.in[19];
      }
      for (int pass = (L == 0 ? 1 : 0); pass < 2; ++pass) {
        if (pass == 1) {
          a.Q = L == 0 ? proj + 640 : proj + 1536; a.Q2 = a.Q; a.ldq = L == 0 ? 1280 : 2048; a.qhs = 128;
          a.K = memkv + (size_t)L * NMEMROWS * 1024; a.ldk = 1024; a.khs = 128; a.kbs = 256 * 1024; a.K2 = a.K; a.ldk2 = 0;
          a.V = a.K + 512; a.ldv = 1024; a.O = mix + 1024; a.H = 4; a.gshift = 0; a.seq = 256; a.nunits = 1024; a.scale = 0.088388347648318440f; a.qgain = p.in[7] + L * 128; a.qrope = 0;
        }
        if (PHMASK & 8) att::run_attn<128, A128_SD>(a, alds, glds);
      }
    }
    }
    if (ph + 1 < ph_hi) xcd_barrier(xb);
  }
}

extern "C" void kernel_launch(void* const* d_in, const int* in_sizes, int n_in, void* d_out, int out_size, void* d_ws, size_t ws_size, hipStream_t stream) {
  static int grid = 0;
  if (grid == 0) {
    if (n_in != 21 || in_sizes[0] != NTOK * DM || out_size != NTOK * DM || ws_size < WS_END) {
      fprintf(stderr, "kernel_launch: shape/workspace mismatch (n_in %d, in0 %d, out %d, ws %zu, need %zu)\n", n_in, n_in > 0 ? in_sizes[0] : -1, out_size, ws_size, (size_t)WS_END);
      grid = -1; return; }
    int dev = 0, cus = 0, per_cu = 0;
    (void)hipGetDevice(&dev); (void)hipDeviceGetAttribute(&cus, hipDeviceAttributeMultiprocessorCount, dev);
    if (hipFuncSetAttribute((const void*)mega, hipFuncAttributeMaxDynamicSharedMemorySize, LDS_BYTES) != hipSuccess) { fprintf(stderr, "kernel_launch: hipFuncSetAttribute failed\n"); grid = -1; return; }
    if (hipOccupancyMaxActiveBlocksPerMultiprocessor(&per_cu, (const void*)mega, 512, LDS_BYTES) != hipSuccess || per_cu < 1) { fprintf(stderr, "kernel_launch: occupancy query says %d\n", per_cu); per_cu = 1; }
    (void)hipGetLastError();
    grid = cus * 1;
    if (grid <= 0) grid = 256;
  }
  if (grid < 0) return;
  if (hipMemsetAsync((char*)d_ws + WS_BAR, 0, XCD_BAR_WORDS * 4, stream) != hipSuccess) { fprintf(stderr, "kernel_launch: memset of barrier words failed\n"); return; }
  Params p{};
  for (int i = 0; i < 21; ++i) p.in[i] = (const float*)d_in[i];
  p.out = (float*)d_out; p.ws = (unsigned char*)d_ws;
#if MK_ONE_LAUNCH
  p.ph_lo = 0; p.ph_hi = NPHASE;
  void* args[] = {&p};
  hipError_t e = hipLaunchCooperativeKernel((const void*)mega, dim3(grid), dim3(512), args, LDS_BYTES, stream);
  if (e != hipSuccess) fprintf(stderr, "kernel_launch: cooperative launch failed: %s (grid %d)\n", hipGetErrorString(e), grid);
#else
  for (int ph = 0; ph < NPHASE; ++ph) {
    p.ph_lo = ph; p.ph_hi = ph + 1;
    hipLaunchKernelGGL(mega, dim3(grid), dim3(512), LDS_BYTES, stream, p);
  }
#endif
}
```
